# Optimizing an MI355X kernel written in HIP

```python
import math
import jax, jax.numpy as jnp
from jax import lax
import numpy as np

D_MODEL = 1024
BATCH = 8
SEQ = 2048
DEPTH = 2

BRANCH_WIDTH = D_MODEL
N_BRANCH = 3
EPS = 1e-6
NEG_INF = -1e30
FORCED = 1e4

LRU_WIDTH = BRANCH_WIDTH
LRU_BLOCKS = 8
LRU_BLOCK = LRU_WIDTH // LRU_BLOCKS
CONV_WIDTH = 4
LRU_C = 8.0

NSA_HEADS = 16
NSA_KV_HEADS = 4
NSA_GROUP = NSA_HEADS // NSA_KV_HEADS
NSA_HEAD_DIM = BRANCH_WIDTH // NSA_HEADS
NSA_WIDTH = NSA_HEADS * NSA_HEAD_DIM
CMP_BLOCK = 32
CMP_STRIDE = 16
CMP_HIDDEN = 256
SLC_BLOCK = 64
SLC_TOP_N = 8
SLC_Q_BLOCK = 64
WINDOW = 256
Q_BLOCK = 128

GLA_HEADS = 4
GLA_KEY_WIDTH = D_MODEL // 2
GLA_VALUE_WIDTH = BRANCH_WIDTH
GLA_DK = GLA_KEY_WIDTH // GLA_HEADS
GLA_DV = GLA_VALUE_WIDTH // GLA_HEADS
GLA_GATE_RANK = 16
GLA_TAU = 16.0
GLA_CHUNK = 32

REL_BUCKETS = 32
REL_MAX_EXACT = 16
REL_MAX_DIST = 128

D_FF = -(-8 * D_MODEL // (3 * 256)) * 256

IN_SIZES = (
    LRU_WIDTH,
    LRU_WIDTH,
    NSA_WIDTH,
    6 * NSA_KV_HEADS * NSA_HEAD_DIM,
    3 * NSA_HEADS,
    GLA_KEY_WIDTH,
    GLA_KEY_WIDTH,
    GLA_VALUE_WIDTH,
    GLA_VALUE_WIDTH,
    GLA_GATE_RANK,
    N_BRANCH * D_MODEL,
)
IN_WIDTH = sum(IN_SIZES)

kernel_name = "hybrid_rglru_nsa_gla_block"


def rms_norm(x, g):
    xf = x.astype(jnp.float32)
    y = xf * lax.rsqrt(jnp.mean(xf * xf, axis=-1, keepdims=True) + EPS)
    return (y * g.astype(jnp.float32)).astype(x.dtype)


def rel_bucket(dist):
    n = jnp.maximum(dist, 0)
    nf = jnp.maximum(n, REL_MAX_EXACT).astype(jnp.float32)
    large = REL_MAX_EXACT + (jnp.log(nf / REL_MAX_EXACT) / math.log(REL_MAX_DIST / REL_MAX_EXACT)
                             * (REL_BUCKETS - REL_MAX_EXACT)).astype(jnp.int32)
    large = jnp.minimum(large, REL_BUCKETS - 1)
    return jnp.where(n < REL_MAX_EXACT, n, large)


def rglru_mixer(xa, ga, conv_w, conv_b, w_gates, b_gates, lam):
    B_, S_, _ = xa.shape
    f32 = jnp.float32
    xc = lax.conv_general_dilated(
        xa, conv_w[:, None, :].astype(xa.dtype), window_strides=(1,),
        padding=[(CONV_WIDTH - 1, 0)], dimension_numbers=("NWC", "WIO", "NWC"),
        feature_group_count=LRU_WIDTH) + conv_b
    xb = xc.reshape(B_, S_, LRU_BLOCKS, LRU_BLOCK)
    gates = jnp.einsum("bsnc,knce->kbsne", xb, w_gates).reshape(2, B_, S_, LRU_WIDTH) + b_gates[:, None, None, :]
    r = jax.nn.sigmoid(gates[0].astype(f32))
    i = jax.nn.sigmoid(gates[1].astype(f32))
    log_a = -LRU_C * r * jax.nn.softplus(-lam.astype(f32))
    a = jnp.exp(log_a)
    u = jnp.sqrt(-jnp.expm1(2.0 * log_a)) * (i * xc.astype(f32))

    def combine(left, right):
        a1, b1 = left
        a2, b2 = right
        return a1 * a2, a2 * b1 + b2

    _, h = lax.associative_scan(combine, (a, u), axis=1)
    return h.astype(xa.dtype) * jax.nn.gelu(ga)


def compress_blocks(t, pos_emb, w1, w2):
    B_, G_, S_, hd = t.shape
    r = CMP_BLOCK // CMP_STRIDE
    n_cmp = S_ // CMP_STRIDE - r + 1
    ch = t.reshape(B_, G_, S_ // CMP_STRIDE, CMP_STRIDE, hd)
    blocks = jnp.concatenate([ch[:, :, j:j + n_cmp] for j in range(r)], axis=3) + pos_emb
    return jax.nn.gelu(blocks.reshape(B_, G_, n_cmp, CMP_BLOCK * hd) @ w1) @ w2


def nsa_mixer(q, kv, gate, rel_table, cmp_pos, cmp_w1, cmp_w2):
    B_, S_, _ = q.shape
    G, R, hd = NSA_KV_HEADS, NSA_GROUP, NSA_HEAD_DIM
    f32 = jnp.float32
    q = q.reshape(B_, S_, G, R, hd).transpose(0, 2, 3, 1, 4) * (hd ** -0.5)
    kv = kv.reshape(B_, S_, 6, G, hd).transpose(2, 0, 3, 1, 4)
    k_cmp, v_cmp, k_slc, v_slc, k_win, v_win = kv[0], kv[1], kv[2], kv[3], kv[4], kv[5]
    tbl = rel_table.reshape(REL_BUCKETS, G, R)
    pos = jnp.arange(S_)

    kc = compress_blocks(k_cmp, cmp_pos[0], cmp_w1[0], cmp_w2[0])
    vc = compress_blocks(v_cmp, cmp_pos[1], cmp_w1[1], cmp_w2[1])
    n_cmp = kc.shape[2]
    cmp_end = jnp.arange(n_cmp) * CMP_STRIDE + CMP_BLOCK - 1
    valid_c = cmp_end[None, :] <= pos[:, None]
    bias_c = tbl[rel_bucket(pos[:, None] - cmp_end[None, :])].transpose(2, 3, 0, 1)
    logit_c = jnp.einsum("bgrsd,bgcd->bgrsc", q, kc).astype(f32) + bias_c
    p_c = jax.nn.softmax(jnp.where(valid_c, logit_c, NEG_INF), axis=-1) * valid_c
    o_cmp = jnp.einsum("bgrsc,bgcd->bgrsd", p_c.astype(q.dtype), vc)

    n_slc = S_ // SLC_BLOCK
    top_n = min(SLC_TOP_N, n_slc)
    slc_start = jnp.arange(n_slc) * SLC_BLOCK
    cmp_start = cmp_end - (CMP_BLOCK - 1)
    overlap = jnp.clip(jnp.minimum(cmp_start[:, None] + CMP_BLOCK, slc_start[None, :] + SLC_BLOCK)
                       - jnp.maximum(cmp_start[:, None], slc_start[None, :]), 0).astype(f32) / CMP_BLOCK
    imp = jnp.einsum("bgrsc,cj->bgsj", p_c, overlap)
    blk = jnp.arange(n_slc)[None, :]
    cur = (pos // SLC_BLOCK)[:, None]
    forced = (blk == 0) | (blk == cur) | (blk == cur - 1)
    score = jnp.where(forced, FORCED, jnp.where(blk <= cur, imp, -FORCED))
    _, sel = lax.top_k(score, top_n)

    kb = k_slc.reshape(B_, G, n_slc, SLC_BLOCK, hd)
    vb = v_slc.reshape(B_, G, n_slc, SLC_BLOCK, hd)
    nqs = S_ // SLC_Q_BLOCK
    q_blk = q.reshape(B_, G, R, nqs, SLC_Q_BLOCK, hd).transpose(3, 0, 1, 2, 4, 5)
    sel_blk = sel.reshape(B_, G, nqs, SLC_Q_BLOCK, top_n).transpose(2, 0, 1, 3, 4)
    bi = jnp.arange(B_)[:, None, None, None]
    gi = jnp.arange(G)[None, :, None, None]
    gi5 = jnp.arange(G)[None, :, None, None, None]
    tbl_g = tbl.transpose(1, 0, 2)

    def slc_block(args):
        qb, sb, start = args
        ks = kb[bi, gi, sb]
        vs = vb[bi, gi, sb]
        tq = start + jnp.arange(SLC_Q_BLOCK)
        tk = sb[..., None] * SLC_BLOCK + jnp.arange(SLC_BLOCK)
        dist = tq[:, None, None] - tk
        bias = tbl_g[gi5, rel_bucket(dist)].transpose(0, 1, 5, 2, 3, 4)
        logit = jnp.einsum("bgrqd,bgqnld->bgrqnl", qb, ks).astype(f32) + bias
        logit = jnp.where((dist >= 0)[:, :, None], logit, NEG_INF)
        p = jax.nn.softmax(logit.reshape(B_, G, R, SLC_Q_BLOCK, top_n * SLC_BLOCK), axis=-1)
        p = p.reshape(B_, G, R, SLC_Q_BLOCK, top_n, SLC_BLOCK)
        return jnp.einsum("bgrqnl,bgqnld->bgrqd", p.astype(qb.dtype), vs)

    o_slc = lax.map(slc_block, (q_blk, sel_blk, jnp.arange(nqs) * SLC_Q_BLOCK))
    o_slc = o_slc.transpose(1, 2, 3, 0, 4, 5).reshape(B_, G, R, S_, hd)

    nqb = S_ // Q_BLOCK
    nband = WINDOW // Q_BLOCK + 1

    def band(t):
        tp = jnp.pad(t, ((0, 0), (0, 0), ((nband - 1) * Q_BLOCK, 0), (0, 0)))
        tb = tp.reshape(B_, G, nqb + nband - 1, Q_BLOCK, hd)
        return jnp.concatenate([tb[:, :, j:j + nqb] for j in range(nband)], axis=3)

    kw, vw = band(k_win), band(v_win)
    qi = jnp.arange(Q_BLOCK)
    kj = jnp.arange(nband * Q_BLOCK)
    dist_w = (nband - 1) * Q_BLOCK + qi[:, None] - kj[None, :]
    key_pos = jnp.arange(nqb)[:, None] * Q_BLOCK - (nband - 1) * Q_BLOCK + kj[None, :]
    mask_w = ((dist_w >= 0) & (dist_w < WINDOW))[None] & (key_pos >= 0)[:, None, :]
    bias_w = tbl[rel_bucket(dist_w)].transpose(2, 3, 0, 1)[:, :, None]
    qw = q.reshape(B_, G, R, nqb, Q_BLOCK, hd)
    logit_w = jnp.einsum("bgrnqd,bgnkd->bgrnqk", qw, kw).astype(f32) + bias_w
    p_w = jax.nn.softmax(jnp.where(mask_w, logit_w, NEG_INF), axis=-1)
    o_win = jnp.einsum("bgrnqk,bgnkd->bgrnqd", p_w.astype(q.dtype), vw).reshape(B_, G, R, S_, hd)

    g = jax.nn.sigmoid(gate).reshape(B_, S_, 3, G, R).transpose(2, 0, 3, 4, 1)[..., None]
    o = g[0] * o_cmp + g[1] * o_slc + g[2] * o_win
    return o.transpose(0, 3, 1, 2, 4).reshape(B_, S_, NSA_WIDTH)


def gla_mixer(q, k, v, og, lr, wa2, ba, norm_g):
    B_, S_, _ = q.shape
    f32 = jnp.float32
    nc = S_ // GLA_CHUNK
    log_alpha = jax.nn.log_sigmoid((lr @ wa2 + ba).astype(f32)) / GLA_TAU

    def heads(t, d):
        return t.reshape(B_, nc, GLA_CHUNK, GLA_HEADS, d).transpose(1, 0, 3, 2, 4).astype(f32)

    qh = heads(q, GLA_DK) * (GLA_DK ** -0.5)
    kh = heads(k, GLA_DK)
    vh = heads(v, GLA_DV)
    b = jnp.cumsum(heads(log_alpha, GLA_DK), axis=3)
    q_t = qh * jnp.exp(b)
    k_t = kh * jnp.exp(-b)
    b_last = b[:, :, :, -1:]
    k_end = kh * jnp.exp(b_last - b)
    decay = jnp.exp(b_last[:, :, :, 0])
    causal = jnp.tril(jnp.ones((GLA_CHUNK, GLA_CHUNK), bool))
    att = jnp.where(causal, jnp.einsum("nbhcd,nbhsd->nbhcs", q_t, k_t), 0.0)
    o_intra = jnp.einsum("nbhcs,nbhse->nbhce", att, vh)

    def step(state, xs):
        q_c, ke_c, v_c, dec_c = xs
        o = jnp.einsum("bhcd,bhde->bhce", q_c, state)
        state = state * dec_c[..., None] + jnp.einsum("bhcd,bhce->bhde", ke_c, v_c)
        return state, o

    s0 = jnp.zeros((B_, GLA_HEADS, GLA_DK, GLA_DV), f32)
    _, o_inter = lax.scan(step, s0, (q_t, k_end, vh, decay))
    o = rms_norm(o_intra + o_inter, norm_g)
    o = o.transpose(1, 0, 3, 2, 4).reshape(B_, S_, GLA_VALUE_WIDTH)
    return o.astype(og.dtype) * jax.nn.silu(og)


def hybrid_layer(x, rel_table, norm_g, w_in, conv_w, conv_b, lru_w_gates, lru_b_gates, lru_lambda,
                 cmp_pos, cmp_w1, cmp_w2, gla_wa2, gla_ba, gla_norm, w_branch, w_out, w_ffn_in, w_ffn_out):
    B_, S_, D_ = x.shape
    h = rms_norm(x, norm_g[0])
    proj = h @ w_in
    cuts, acc = [], 0
    for size in IN_SIZES[:-1]:
        acc += size
        cuts.append(acc)
    (lru_x, lru_g, nsa_q, nsa_kv, nsa_gate, gla_q, gla_k, gla_v, gla_og, gla_lr,
     merge_logit) = jnp.split(proj, cuts, axis=-1)
    y_a = rglru_mixer(lru_x, lru_g, conv_w, conv_b, lru_w_gates, lru_b_gates, lru_lambda)
    y_b = nsa_mixer(nsa_q, nsa_kv, nsa_gate, rel_table, cmp_pos, cmp_w1, cmp_w2)
    y_c = gla_mixer(gla_q, gla_k, gla_v, gla_og, gla_lr, gla_wa2, gla_ba, gla_norm)
    gates = jax.nn.sigmoid(merge_logit.reshape(B_, S_, N_BRANCH, D_))
    merged = (gates[:, :, 0] * (y_a @ w_branch[0])
              + gates[:, :, 1] * (y_b @ w_branch[1])
              + gates[:, :, 2] * (y_c @ w_branch[2]))
    x = x + rms_norm(merged @ w_out, norm_g[1])
    h = rms_norm(x, norm_g[2])
    gt, up = jnp.split(h @ w_ffn_in, 2, axis=-1)
    x = x + rms_norm((jax.nn.silu(gt) * up) @ w_ffn_out, norm_g[3])
    return x


def setup_inputs(seed: int = 0) -> dict:
    key = jax.random.key(seed)
    ks = jax.random.split(key, 20)
    f32 = jnp.float32

    def nrm(k, shape, scale):
        return jax.random.normal(k, shape, f32) * scale

    u = jax.random.uniform(ks[8], (DEPTH, LRU_WIDTH), f32, 0.9, 0.999)
    s = u ** (1.0 / LRU_C)
    return {
        "x": nrm(ks[0], (BATCH, SEQ, D_MODEL), 1.0),
        "rel_table": nrm(ks[1], (REL_BUCKETS, NSA_HEADS), 0.5),
        "norm_g": 1.0 + nrm(ks[2], (DEPTH, 4, D_MODEL), 0.05),
        "w_in": nrm(ks[3], (DEPTH, D_MODEL, IN_WIDTH), D_MODEL ** -0.5),
        "conv_w": nrm(ks[4], (DEPTH, CONV_WIDTH, LRU_WIDTH), CONV_WIDTH ** -0.5),
        "conv_b": nrm(ks[5], (DEPTH, LRU_WIDTH), 0.01),
        "lru_w_gates": nrm(ks[6], (DEPTH, 2, LRU_BLOCKS, LRU_BLOCK, LRU_BLOCK), LRU_BLOCK ** -0.5),
        "lru_b_gates": nrm(ks[7], (DEPTH, 2, LRU_WIDTH), 0.01),
        "lru_lambda": jnp.log(s) - jnp.log1p(-s),
        "cmp_pos": nrm(ks[9], (DEPTH, 2, CMP_BLOCK, NSA_HEAD_DIM), 0.1),
        "cmp_w1": nrm(ks[10], (DEPTH, 2, CMP_BLOCK * NSA_HEAD_DIM, CMP_HIDDEN), (CMP_BLOCK * NSA_HEAD_DIM) ** -0.5),
        "cmp_w2": nrm(ks[11], (DEPTH, 2, CMP_HIDDEN, NSA_HEAD_DIM), CMP_HIDDEN ** -0.5),
        "gla_wa2": nrm(ks[12], (DEPTH, GLA_GATE_RANK, GLA_KEY_WIDTH), GLA_GATE_RANK ** -0.5),
        "gla_ba": 1.0 + nrm(ks[13], (DEPTH, GLA_KEY_WIDTH), 0.5),
        "gla_norm": 1.0 + nrm(ks[14], (DEPTH, GLA_DV), 0.05),
        "w_branch": nrm(ks[15], (DEPTH, N_BRANCH, BRANCH_WIDTH, D_MODEL), BRANCH_WIDTH ** -0.5),
        "w_out": nrm(ks[16], (DEPTH, D_MODEL, D_MODEL), D_MODEL ** -0.5),
        "w_ffn_in": nrm(ks[17], (DEPTH, D_MODEL, 2 * D_FF), D_MODEL ** -0.5),
        "w_ffn_out": nrm(ks[18], (DEPTH, D_FF, D_MODEL), D_FF ** -0.5),
    }


def reference(x, rel_table, norm_g, w_in, conv_w, conv_b, lru_w_gates, lru_b_gates, lru_lambda,
              cmp_pos, cmp_w1, cmp_w2, gla_wa2, gla_ba, gla_norm, w_branch, w_out, w_ffn_in, w_ffn_out):
    for l in range(DEPTH):
        x = hybrid_layer(x, rel_table, norm_g[l], w_in[l], conv_w[l], conv_b[l], lru_w_gates[l],
                         lru_b_gates[l], lru_lambda[l], cmp_pos[l], cmp_w1[l], cmp_w2[l],
                         gla_wa2[l], gla_ba[l], gla_norm[l], w_branch[l], w_out[l],
                         w_ffn_in[l], w_ffn_out[l])
    return x
```

```cpp
#include <hip/hip_runtime.h>
#include <hip/hip_cooperative_groups.h>
#include <cstdio>
#include <cstdint>
namespace cg = cooperative_groups;

#ifndef MK_COOP
#define MK_COOP 0
#endif
#ifndef MK_PM
#define MK_PM 0xFFFFFFFFu
#endif
#define PH_ON(p) (((MK_PM) >> (p)) & 1u)

#define LAS __attribute__((address_space(3)))
typedef unsigned short bf16_t;
typedef short bf16x8 __attribute__((ext_vector_type(8)));
typedef float f32x4 __attribute__((ext_vector_type(4)));
typedef float f32x2 __attribute__((ext_vector_type(2)));
typedef unsigned u32x4 __attribute__((ext_vector_type(4)));
typedef unsigned u32x2 __attribute__((ext_vector_type(2)));

constexpr int NB_ = 8, NS = 2048, ND = 1024, NT = NB_ * NS;
constexpr int IN_W = 10816, DFF = 2816;
constexpr int LD_NB = 2816, LD_GB = 3072;
constexpr float EPS = 1e-6f;
constexpr int NTHR = 512, NWAVES = 8;

constexpr size_t MiB = 1u << 20;
constexpr size_t WS_CTL = 0;
constexpr size_t WS_W = 1 * MiB;
constexpr size_t W_G1 = WS_W;
constexpr size_t W_G23 = W_G1 + 4 * MiB;
constexpr size_t W_G4 = W_G23 + 5888ull * 1024 * 2;
constexpr size_t W_LRU = W_G4 + 6 * MiB;
constexpr size_t W_BR = W_LRU + 4 * MiB;
constexpr size_t W_OUT = W_BR + 6 * MiB;
constexpr size_t W_FI = W_OUT + 2 * MiB;
constexpr size_t W_FO = W_FI + 11 * MiB;
constexpr size_t W_END = W_FO + 1024ull * 2816 * 2;
constexpr size_t WS_H = 52 * MiB;
constexpr size_t WS_XA = 84 * MiB;
constexpr size_t WS_GA = 116 * MiB;
constexpr size_t WS_NB = 148 * MiB;
constexpr size_t WS_GB = 236 * MiB;
constexpr size_t WS_END = 332 * MiB;
static_assert(W_END <= WS_H, "weights region");
constexpr size_t WS_XC = WS_NB, WS_LA = WS_NB + 32 * MiB, WS_U = WS_NB + 64 * MiB;
constexpr size_t WS_HID = WS_XA;
constexpr size_t WS_KC = WS_XA + 8 * MiB;
constexpr size_t WS_SEL = WS_XA + 10 * MiB;
constexpr int CT_C8 = 0;
constexpr int CT_RB = 1024;

__device__ __forceinline__ unsigned f2bf(float f) { unsigned u = __float_as_uint(f); return (u + 0x7fffu + ((u >> 16) & 1u)) >> 16; }
__device__ __forceinline__ unsigned pk2(float lo, float hi) { return f2bf(lo) | (f2bf(hi) << 16); }
__device__ __forceinline__ float bflo(unsigned w) { return __uint_as_float(w << 16); }
__device__ __forceinline__ float bfhi(unsigned w) { return __uint_as_float(w & 0xffff0000u); }
__device__ __forceinline__ float bf1(bf16_t h) { return __uint_as_float((unsigned)h << 16); }
__device__ __forceinline__ float sigmoidf_(float x) { return __builtin_amdgcn_rcpf(1.f + __expf(-x)); }
__device__ __forceinline__ float gelu_tanh(float x) { const float u = 1.5957691216057308f * (x + 0.044715f * x * x * x); return x * sigmoidf_(u); }
__device__ __forceinline__ float wave_sum(float v) {
    v += __int_as_float(__builtin_amdgcn_ds_swizzle(__float_as_int(v), 0x041f));
    v += __int_as_float(__builtin_amdgcn_ds_swizzle(__float_as_int(v), 0x081f));
    v += __int_as_float(__builtin_amdgcn_ds_swizzle(__float_as_int(v), 0x101f));
    v += __int_as_float(__builtin_amdgcn_ds_swizzle(__float_as_int(v), 0x201f));
    v += __int_as_float(__builtin_amdgcn_ds_swizzle(__float_as_int(v), 0x401f));
    auto rr = __builtin_amdgcn_permlane32_swap(__float_as_uint(v), __float_as_uint(v), false, false);
    return __uint_as_float(rr[0]) + __uint_as_float(rr[1]);
}
__device__ __forceinline__ int rel_bucket(int n) {
    if (n < 16) return n;
    int b = 16;
    b += (n >= 19) + (n >= 21) + (n >= 24) + (n >= 27) + (n >= 31) + (n >= 35) + (n >= 40) + (n >= 46) + (n >= 52) + (n >= 59) + (n >= 67) + (n >= 77) + (n >= 87) + (n >= 99) + (n >= 113);
    return b;
}

namespace pg8 {
constexpr int BM = 256, BK = 64, HALF = 128, HTB = HALF * BK * 2, STAGE_BYTES = 8 * HTB, NXCD = 8, WGM = 8;
__device__ __forceinline__ int lds_byte(int r, int c) { const int st = (r >> 4) * 2 + (c >> 5), rr = r & 15, cc = c & 31, ob = rr * 64 + cc * 2; return st * 1024 + (ob ^ (((ob >> 9) & 1) << 5)); }
__device__ __forceinline__ void stage_rc(int b, int& R, int& C) { const int st = b / 1024, sb = b % 1024, swz = sb ^ (((sb >> 9) & 1) << 5); R = (st >> 1) * 16 + swz / 64; C = (st & 1) * 32 + (swz % 64) / 2; }
__device__ __forceinline__ int perm32(int rho) { const int n = rho >> 4, i = rho & 15; return 8 * (i >> 2) + 4 * n + (i & 3); }

struct Unit { int pm, pn; };
struct Gemm { const bf16_t* A; const bf16_t* Bt; int lda, ldb, K, akw; };

struct StaticOrder {
    int nM, nN, nwg, G, c;
    __device__ void init(int nM_, int nN_, int G_, int c_) { nM = nM_; nN = nN_; nwg = nM * nN; G = G_; c = c_; }
    __device__ bool next(int i, Unit& u) const {
        const long L = (long)i * G + c; if (L >= nwg) return false;
        int wgid = (int)L; { const int q = nwg / NXCD, r = nwg % NXCD, xcd = wgid % NXCD, off = wgid / NXCD; wgid = (xcd < r ? xcd * (q + 1) : r * (q + 1) + (xcd - r) * q) + off; }
        const int nig = WGM * nN, gid = wgid / nig, fm = gid * WGM, gsz = (nM - fm) < WGM ? (nM - fm) : WGM;
        u.pm = fm + ((wgid % nig) % gsz); u.pn = (wgid % nig) / gsz; return true;
    }
};

typedef __bf16 bf16x2_t __attribute__((ext_vector_type(2)));
__device__ __forceinline__ unsigned cvt_pk_bf16(float lo, float hi) { const f32x2 v = {lo, hi}; const bf16x2_t b = __builtin_convertvector(v, bf16x2_t); return __builtin_bit_cast(unsigned, b); }

struct Seg { bf16_t* base; int ld; int tile0; };
template <int ACT  > struct EpiStore {
    static constexpr bool PERM = true;
    Seg s0, s1, s2; int t1, t2; int nscale; float scale;
    __device__ __forceinline__ void operator()(const f32x4 (&acc)[2][2][4][2], const Unit& u, int wr, int wc, int fr, int fq) const {
        const bool c1_ = u.pn < t1, c2_ = u.pn < t2;
        bf16_t* const pb0 = s0.base; bf16_t* const pb1 = s1.base; bf16_t* const pb2 = s2.base; const int l0 = s0.ld, l1 = s1.ld, l2 = s2.ld, q0 = s0.tile0, q1 = s1.tile0, q2 = s2.tile0;
        bf16_t* base = c1_ ? pb0 : (c2_ ? pb1 : pb2); const int ld = c1_ ? l0 : (c2_ ? l1 : l2), t0 = c1_ ? q0 : (c2_ ? q1 : q2);
        const float sc = u.pn < nscale ? scale : 1.f;
        const int row0 = u.pm * BM + wr * 64 + fr, col0 = (u.pn - t0) * BM + wc * 32 + 8 * fq;
#pragma unroll
        for (int ai = 0; ai < 2; ++ai)
#pragma unroll
            for (int m = 0; m < 4; ++m) { bf16_t* rowp = base + (size_t)(row0 + ai * HALF + m * 16) * ld + col0;
#pragma unroll
                for (int bj = 0; bj < 2; ++bj) { f32x4 v0 = acc[ai][bj][m][0] * sc, v1 = acc[ai][bj][m][1] * sc;
                    if (ACT == 2) {
#pragma unroll
                        for (int j = 0; j < 4; ++j) { v0[j] = sigmoidf_(v0[j]); v1[j] = sigmoidf_(v1[j]); } }
                    u32x4 w; w.x = cvt_pk_bf16(v0[0], v0[1]); w.y = cvt_pk_bf16(v0[2], v0[3]); w.z = cvt_pk_bf16(v1[0], v1[1]); w.w = cvt_pk_bf16(v1[2], v1[3]);
                    *(u32x4*)(rowp + bj * HALF) = w; }
                if (ACT != 0) __builtin_amdgcn_sched_barrier(0); }
    }
};
struct EpiLru {
    static constexpr bool PERM = false;
    const bf16_t* XC; bf16_t* LA; bf16_t* U; const float* bg; const float* c8;
    __device__ __forceinline__ void operator()(const f32x4 (&acc)[2][2][4][2], const Unit& u, int wr, int wc, int fr, int fq) const {
        const int row0 = u.pm * BM + wr * 64 + fr, ch0 = u.pn * HALF + wc * 32 + 4 * fq;
#pragma unroll
        for (int n = 0; n < 2; ++n) { const int ch = ch0 + n * 16;
            const f32x4 br = *(const f32x4*)(bg + ch), bi = *(const f32x4*)(bg + 1024 + ch), cc = *(const f32x4*)(c8 + ch);
            u32x2 xw = *(const u32x2*)(XC + (size_t)row0 * 1024 + ch);
#pragma unroll
            for (int it = 0; it < 8; ++it) { const int ai = it >> 2, m = it & 3; const size_t off = (size_t)(row0 + ai * HALF + m * 16) * 1024 + ch;
                u32x2 xn = xw; if (it < 7) xn = *(const u32x2*)(XC + (size_t)(row0 + ((it + 1) >> 2) * HALF + ((it + 1) & 3) * 16) * 1024 + ch);
                const float xv[4] = {bflo(xw.x), bfhi(xw.x), bflo(xw.y), bfhi(xw.y)};
                float la[4], uu[4];
#pragma unroll
                for (int j = 0; j < 4; ++j) { const float r = sigmoidf_(acc[ai][0][m][n][j] + br[j]), ig = sigmoidf_(acc[ai][1][m][n][j] + bi[j]);
                    la[j] = cc[j] * r; uu[j] = __builtin_amdgcn_sqrtf(fmaxf(1.f - __expf(2.f * la[j]), 0.f)) * (ig * xv[j]); }
                u32x2 wl, wu; wl.x = cvt_pk_bf16(la[0], la[1]); wl.y = cvt_pk_bf16(la[2], la[3]); wu.x = cvt_pk_bf16(uu[0], uu[1]); wu.y = cvt_pk_bf16(uu[2], uu[3]);
                *(u32x2*)(LA + off) = wl; *(u32x2*)(U + off) = wu; xw = xn;
                __builtin_amdgcn_sched_barrier(0); } }
    }
};
__device__ __forceinline__ u32x4 ld16_agent(const void* p) {
    const unsigned long long* q = (const unsigned long long*)p;
    const unsigned long long a = __hip_atomic_load(q, __ATOMIC_RELAXED, __HIP_MEMORY_SCOPE_AGENT), b = __hip_atomic_load(q + 1, __ATOMIC_RELAXED, __HIP_MEMORY_SCOPE_AGENT);
    return (u32x4){(unsigned)a, (unsigned)(a >> 32), (unsigned)b, (unsigned)(b >> 32)};
}
template <bool FIRST> struct EpiBranch {
    static constexpr bool PERM = true;
    const bf16_t* G; int ldg; bf16_t* O; int ldo;
    __device__ __forceinline__ void operator()(const f32x4 (&acc)[2][2][4][2], const Unit& u, int wr, int wc, int fr, int fq) const {
        const int row0 = u.pm * BM + wr * 64 + fr, col0 = u.pn * BM + wc * 32 + 8 * fq;
        u32x4 gw[2], ow[2];
#pragma unroll
        for (int bj = 0; bj < 2; ++bj) { gw[bj] = *(const u32x4*)(G + (size_t)row0 * ldg + col0 + bj * HALF); if (!FIRST) ow[bj] = *(const u32x4*)(O + (size_t)row0 * ldo + col0 + bj * HALF); }
#pragma unroll
        for (int it = 0; it < 8; ++it) { const int ai = it >> 2, m = it & 3; const size_t r = (size_t)(row0 + ai * HALF + m * 16);
            u32x4 gn[2], on[2];
#pragma unroll
            for (int bj = 0; bj < 2; ++bj) { gn[bj] = gw[bj]; on[bj] = ow[bj]; }
            if (it < 7) { const size_t rn = (size_t)(row0 + ((it + 1) >> 2) * HALF + ((it + 1) & 3) * 16);
#pragma unroll
                for (int bj = 0; bj < 2; ++bj) { gn[bj] = *(const u32x4*)(G + rn * ldg + col0 + bj * HALF); if (!FIRST) on[bj] = *(const u32x4*)(O + rn * ldo + col0 + bj * HALF); } }
#pragma unroll
            for (int bj = 0; bj < 2; ++bj) { const u32x4 g4 = gw[bj];
                float v[8] = {acc[ai][bj][m][0][0] * bflo(g4.x), acc[ai][bj][m][0][1] * bfhi(g4.x), acc[ai][bj][m][0][2] * bflo(g4.y), acc[ai][bj][m][0][3] * bfhi(g4.y),
                              acc[ai][bj][m][1][0] * bflo(g4.z), acc[ai][bj][m][1][1] * bfhi(g4.z), acc[ai][bj][m][1][2] * bflo(g4.w), acc[ai][bj][m][1][3] * bfhi(g4.w)};
                if (!FIRST) { const u32x4 o4 = ow[bj]; v[0] += bflo(o4.x); v[1] += bfhi(o4.x); v[2] += bflo(o4.y); v[3] += bfhi(o4.y); v[4] += bflo(o4.z); v[5] += bfhi(o4.z); v[6] += bflo(o4.w); v[7] += bfhi(o4.w); }
                u32x4 w; w.x = cvt_pk_bf16(v[0], v[1]); w.y = cvt_pk_bf16(v[2], v[3]); w.z = cvt_pk_bf16(v[4], v[5]); w.w = cvt_pk_bf16(v[6], v[7]);
                *(u32x4*)(O + r * ldo + col0 + bj * HALF) = w; }
#pragma unroll
            for (int bj = 0; bj < 2; ++bj) { gw[bj] = gn[bj]; ow[bj] = on[bj]; }
            __builtin_amdgcn_sched_barrier(0); }
    }
};
struct EpiF32 {
    static constexpr bool PERM = false;
    float* O; int ldc;
    __device__ __forceinline__ void operator()(const f32x4 (&acc)[2][2][4][2], const Unit& u, int wr, int wc, int fr, int fq) const {
        const int row0 = u.pm * BM + wr * 64 + fr, col0 = u.pn * BM + wc * 32 + 4 * fq;
#pragma unroll
        for (int ai = 0; ai < 2; ++ai)
#pragma unroll
            for (int m = 0; m < 4; ++m) { float* rowp = O + (size_t)(row0 + ai * HALF + m * 16) * ldc + col0;
#pragma unroll
                for (int bj = 0; bj < 2; ++bj)
#pragma unroll
                    for (int n = 0; n < 2; ++n) *(f32x4*)(rowp + bj * HALF + n * 16) = acc[ai][bj][m][n]; }
    }
};
struct EpiSwiGLU {
    static constexpr bool PERM = true;
    bf16_t* O; int ldc;
    __device__ __forceinline__ void operator()(const f32x4 (&acc)[2][2][4][2], const Unit& u, int wr, int wc, int fr, int fq) const {
        const int row0 = u.pm * BM + wr * 64 + fr, col0 = u.pn * HALF + wc * 32 + 8 * fq;
#pragma unroll
        for (int ai = 0; ai < 2; ++ai)
#pragma unroll
            for (int m = 0; m < 4; ++m) { bf16_t* rowp = O + (size_t)(row0 + ai * HALF + m * 16) * ldc + col0;
                float v[8];
#pragma unroll
                for (int n = 0; n < 2; ++n)
#pragma unroll
                    for (int j = 0; j < 4; ++j) { const float g = acc[ai][0][m][n][j], up = acc[ai][1][m][n][j]; v[n * 4 + j] = g * sigmoidf_(g) * up; }
                u32x4 w; w.x = cvt_pk_bf16(v[0], v[1]); w.y = cvt_pk_bf16(v[2], v[3]); w.z = cvt_pk_bf16(v[4], v[5]); w.w = cvt_pk_bf16(v[6], v[7]);
                *(u32x4*)rowp = w; }
    }
};

template <class Epi, bool ALIGN_EPI>
__device__ __forceinline__ void gemm_phase(LAS unsigned char* lds, const Gemm g, const StaticOrder& S, const Epi& E, const int tid) {
    const int wid = __builtin_amdgcn_readfirstlane(tid >> 6), lane = tid & 63, wr = wid >> 2, wc = wid & 3, fr = lane & 15, fq = lane >> 4;
    const int K = g.K, nt = K / BK;
    unsigned voffA[2], voffB[2];
#pragma unroll
    for (int i = 0; i < 2; ++i) { int R, C; stage_rc(tid * 16 + i * 8192, R, C); const int Rb = Epi::PERM ? ((R & ~31) + perm32(R & 31)) : R;
        voffA[i] = (unsigned)(R * g.lda + C) * 2u; voffB[i] = (unsigned)(Rb * g.ldb + C) * 2u; }
    const size_t kstep = (size_t)(BK * 2);
    const size_t hstepA = (size_t)HALF * g.lda * 2, hstepB = (size_t)HALF * g.ldb * 2;
    const size_t tstepA = 2 * hstepA, tstepB = 2 * hstepB;
    const unsigned ldsw = (unsigned)wid * 1024u;
    const int aoff = lds_byte(wr * 64 + fr, fq * 8), boff = lds_byte(wc * 32 + fr, fq * 8);
#define PG8_SA(b, h) (((b) * 2 + (h)) * HTB)
#define PG8_SB(b, h) ((4 + (b) * 2 + (h)) * HTB)
#define PG8_STAGE(bufoff, gbase, voff) do { _Pragma("unroll") for (int _i = 0; _i < 2; ++_i) \
        __builtin_amdgcn_global_load_lds((const unsigned*)((const char*)(gbase) + (voff)[_i]), (LAS unsigned*)(lds + (bufoff) + ldsw + _i * 8192), 16, 0, 0); } while (0)
#define PG8_LDA(dst, b, h) do { _Pragma("unroll") for (int m = 0; m < 4; ++m) _Pragma("unroll") for (int k = 0; k < 2; ++k) dst[m][k] = *(const LAS bf16x8*)(lds + PG8_SA(b, h) + aoff + m * 2048 + k * 1024); } while (0)
#define PG8_LDB(dst, b, h) do { _Pragma("unroll") for (int n = 0; n < 2; ++n) _Pragma("unroll") for (int k = 0; k < 2; ++k) dst[n][k] = *(const LAS bf16x8*)(lds + PG8_SB(b, h) + boff + n * 2048 + k * 1024); } while (0)
#define PG8_MMA(ai, bj, At, Bt) do { __builtin_amdgcn_s_setprio(1); _Pragma("unroll") for (int m = 0; m < 4; ++m) _Pragma("unroll") for (int n = 0; n < 2; ++n) _Pragma("unroll") for (int k = 0; k < 2; ++k) \
        acc[ai][bj][m][n] = __builtin_amdgcn_mfma_f32_16x16x32_bf16(Bt[n][k], At[m][k], acc[ai][bj][m][n], 0, 0, 0); __builtin_amdgcn_s_setprio(0); } while (0)
#define PG8_WAIT_V(n) asm volatile("s_waitcnt vmcnt(" #n ")" ::: "memory")
#define PG8_WAIT_L(n) asm volatile("s_waitcnt lgkmcnt(" #n ")" ::: "memory")
#define PG8_BAR __builtin_amdgcn_s_barrier()
#define PG8_SCHED __builtin_amdgcn_sched_barrier(0)
#define PG8_AOFF(u_) ((size_t)(u_).pm * tstepA)
    Unit cur, nxt; int ui = 0;
    if (!S.next(0, cur)) return;
    f32x4 acc[2][2][4][2];
#pragma unroll
    for (int a = 0; a < 2; ++a)
#pragma unroll
        for (int b = 0; b < 2; ++b)
#pragma unroll
            for (int m = 0; m < 4; ++m)
#pragma unroll
                for (int n = 0; n < 2; ++n) acc[a][b][m][n] = (f32x4){0.f, 0.f, 0.f, 0.f};
    bf16x8 At[4][2], B0[2][2], B1[2][2];
    const char* cA = (const char*)g.A + PG8_AOFF(cur); const char* cB = (const char*)g.Bt + (size_t)cur.pn * tstepB;
    PG8_STAGE(PG8_SB(0, 0), cB, voffB); PG8_STAGE(PG8_SB(0, 1), cB + hstepB, voffB); PG8_STAGE(PG8_SA(0, 0), cA, voffA); PG8_STAGE(PG8_SA(0, 1), cA + hstepA, voffA);
    if (wr == 1) PG8_BAR;
    PG8_WAIT_V(2); PG8_BAR;
    PG8_STAGE(PG8_SB(1, 0), cB + kstep, voffB); PG8_STAGE(PG8_SA(1, 0), cA + kstep, voffA); PG8_STAGE(PG8_SB(1, 1), cB + hstepB + kstep, voffB);
    PG8_WAIT_V(6); PG8_BAR;
    for (;;) {
        const bool has_next = S.next(ui + 1, nxt);
        const char* nA = has_next ? (const char*)g.A + PG8_AOFF(nxt) : cA; const char* nB = has_next ? (const char*)g.Bt + (size_t)nxt.pn * tstepB : cB;
        for (int t = 0; t < nt; t += 2) {
            const bool last = (t == nt - 2);
            const char* a1 = cA + (size_t)(t + 1) * kstep;
            const char* a2 = last ? nA : cA + (size_t)(t + 2) * kstep; const char* b2 = last ? nB : cB + (size_t)(t + 2) * kstep;
            const char* a3 = a2 + kstep; const char* b3 = b2 + kstep;
            PG8_LDB(B0, 0, 0); PG8_LDB(B1, 0, 1); PG8_SCHED; PG8_LDA(At, 0, 0); PG8_STAGE(PG8_SA(1, 1), a1 + hstepA, voffA);
            PG8_WAIT_V(8); PG8_WAIT_L(0); PG8_BAR; PG8_MMA(0, 0, At, B0); PG8_MMA(0, 1, At, B1); PG8_BAR; PG8_SCHED;
            PG8_LDA(At, 0, 1); PG8_STAGE(PG8_SB(0, 0), b2, voffB); PG8_STAGE(PG8_SB(0, 1), b2 + hstepB, voffB); PG8_STAGE(PG8_SA(0, 0), a2, voffA);
            PG8_WAIT_V(8); PG8_WAIT_L(0); PG8_BAR; PG8_MMA(1, 0, At, B0); PG8_MMA(1, 1, At, B1); PG8_BAR; PG8_SCHED;
            PG8_LDB(B0, 1, 0); PG8_LDB(B1, 1, 1); PG8_SCHED; PG8_LDA(At, 1, 0); PG8_STAGE(PG8_SA(0, 1), a2 + hstepA, voffA);
            PG8_WAIT_V(8); PG8_WAIT_L(0); PG8_BAR; PG8_MMA(0, 0, At, B0); PG8_MMA(0, 1, At, B1); PG8_BAR; PG8_SCHED;
            PG8_LDA(At, 1, 1); PG8_STAGE(PG8_SB(1, 0), b3, voffB); PG8_STAGE(PG8_SB(1, 1), b3 + hstepB, voffB); PG8_STAGE(PG8_SA(1, 0), a3, voffA);
            PG8_WAIT_V(8); PG8_WAIT_L(0); PG8_BAR; PG8_MMA(1, 0, At, B0); PG8_MMA(1, 1, At, B1); PG8_BAR; PG8_SCHED;
        }
        if constexpr (ALIGN_EPI) { if (wr == 0) PG8_BAR; }
        E(acc, cur, wr, wc, fr, fq);
        if (!has_next) break;
#pragma unroll
        for (int a = 0; a < 2; ++a)
#pragma unroll
            for (int b = 0; b < 2; ++b)
#pragma unroll
                for (int m = 0; m < 4; ++m)
#pragma unroll
                    for (int n = 0; n < 2; ++n) acc[a][b][m][n] = (f32x4){0.f, 0.f, 0.f, 0.f};
        cur = nxt; cA = nA; cB = nB; ++ui;
        if constexpr (ALIGN_EPI) { if (wr == 1) PG8_BAR; }
    }
    PG8_WAIT_V(0);
    if constexpr (!ALIGN_EPI) { if (wr == 0) PG8_BAR; }
    PG8_BAR;
#undef PG8_SA
#undef PG8_SB
#undef PG8_STAGE
#undef PG8_LDA
#undef PG8_LDB
#undef PG8_MMA
#undef PG8_WAIT_V
#undef PG8_WAIT_L
#undef PG8_BAR
#undef PG8_SCHED
#undef PG8_AOFF
}
}

struct Args { const float* in[19]; float* out; unsigned char* ws; int ph_lo, ph_hi; };
enum { I_X = 0, I_REL, I_NORMG, I_WIN, I_CONVW, I_CONVB, I_LRUW, I_LRUB, I_LAM, I_CPOS, I_CW1, I_CW2, I_WA2, I_BA, I_GNORM, I_WBR, I_WOUT, I_WFI, I_WFO };
enum { PH_PRE = 0, PH_G1, PH_LCONV, PH_LGATE, PH_LSCAN, PH_G23, PH_CMP1, PH_CMP2, PH_SEL, PH_ATT, PH_GLA, PH_G4, PH_BR, PH_OUT, PH_RES1, PH_FI, PH_FO, PH_RES2, NPH };

typedef const Args __attribute__((address_space(4)))* ArgsP;
struct Ctx {
    ArgsP ap; float* out; unsigned char* ws; LAS unsigned char* lds; unsigned char* ldsg;
    int tid, lane, wave, G, bid, L;
    const float* xin;
};

template <int MODE> __device__ __forceinline__ int srccol(int n) {
    if (MODE == 0) return n;
    if (MODE == 1) { if (n < 2560) return 2048 + n; if (n < 2608) return 4608 + (n - 2560); if (n < 2624) return 7728 + (n - 2608); if (n < 2816) return -1; return 4656 + (n - 2816); }
    if (MODE == 2) return 7744 + n;
      { const int t = n >> 8, j = n & 255; return j < 128 ? t * 128 + j : DFF + t * 128 + (j - 128); }
}
template <int MODE> __device__ __forceinline__ void tr_item(const float* W, int ldw, bf16_t* WT, int ldd, int nblk, int item, LAS float* scr, int lane) {
    const int kb = item / nblk, nb = item % nblk, k0 = 64 * kb, n0 = 32 * nb;
    const int sc = srccol<MODE>(n0 + (lane & 31));
#pragma unroll 8
    for (int i = 0; i < 32; ++i) { const int kk = 2 * i + (lane >> 5); scr[kk * 33 + (lane & 31)] = sc >= 0 ? W[(size_t)(k0 + kk) * ldw + sc] : 0.f; }
    asm volatile("s_waitcnt lgkmcnt(0)" ::: "memory");
    const int c = lane & 7;
#pragma unroll
    for (int j = 0; j < 4; ++j) { const int n = (lane >> 3) + 8 * j; const LAS float* s = scr + (8 * c) * 33 + n;
        u32x4 o; o.x = pk2(s[0 * 33], s[1 * 33]); o.y = pk2(s[2 * 33], s[3 * 33]); o.z = pk2(s[4 * 33], s[5 * 33]); o.w = pk2(s[6 * 33], s[7 * 33]);
        *(u32x4*)(WT + (size_t)(n0 + n) * ldd + k0 + 8 * c) = o; }
    asm volatile("s_waitcnt lgkmcnt(0)" ::: "memory");
}
__device__ __forceinline__ void rms_row_to_bf16(const float* xrow, const float* g, bf16_t* orow, int lane) {
    const f32x4* xr = (const f32x4*)xrow + lane; const f32x4* gr = (const f32x4*)g + lane;
    f32x4 v[4]; float s = 0.f;
#pragma unroll
    for (int j = 0; j < 4; ++j) { v[j] = xr[64 * j]; s += (v[j].x * v[j].x + v[j].y * v[j].y) + (v[j].z * v[j].z + v[j].w * v[j].w); }
    const float rstd = __builtin_amdgcn_rsqf(wave_sum(s) * (1.f / ND) + EPS);
    unsigned long long* o8 = (unsigned long long*)orow + lane;
#pragma unroll
    for (int j = 0; j < 4; ++j) { const f32x4 gg = gr[64 * j]; o8[64 * j] = (unsigned long long)pk2(v[j].x * rstd * gg.x, v[j].y * rstd * gg.y) | ((unsigned long long)pk2(v[j].z * rstd * gg.z, v[j].w * rstd * gg.w) << 32); }
}
__device__ __forceinline__ void ph_pre(Ctx& F) {
    const int L = F.L;
    LAS float* scr = (LAS float*)(F.lds + F.wave * 16384);
    const int gw = F.bid * NWAVES + F.wave, NGW = F.G * NWAVES;
    const float* win = F.ap->in[I_WIN] + (size_t)L * ND * IN_W;
    constexpr int I_G1 = 64 * 16, I_G23 = 184 * 16, I_G4 = 96 * 16, I_BR1 = 32 * 16, I_OUT = 32 * 16, I_FI = 176 * 16, I_FO = 32 * 44;
    constexpr int NITEMS = I_G1 + I_G23 + I_G4 + 3 * I_BR1 + I_OUT + I_FI + I_FO;
    for (int it = gw; it < NITEMS; it += NGW) {
        int r = it;
        if (r < I_G1) { tr_item<0>(win, IN_W, (bf16_t*)(F.ws + W_G1), 1024, 64, r, scr, F.lane); continue; } r -= I_G1;
        if (r < I_G23) { tr_item<1>(win, IN_W, (bf16_t*)(F.ws + W_G23), 1024, 184, r, scr, F.lane); continue; } r -= I_G23;
        if (r < I_G4) { tr_item<2>(win, IN_W, (bf16_t*)(F.ws + W_G4), 1024, 96, r, scr, F.lane); continue; } r -= I_G4;
        if (r < 3 * I_BR1) { const int b = r / I_BR1; tr_item<0>(F.ap->in[I_WBR] + ((size_t)L * 3 + b) * ND * ND, ND, (bf16_t*)(F.ws + W_BR) + (size_t)b * ND * ND, 1024, 32, r % I_BR1, scr, F.lane); continue; } r -= 3 * I_BR1;
        if (r < I_OUT) { tr_item<0>(F.ap->in[I_WOUT] + (size_t)L * ND * ND, ND, (bf16_t*)(F.ws + W_OUT), 1024, 32, r, scr, F.lane); continue; } r -= I_OUT;
        if (r < I_FI) { tr_item<3>(F.ap->in[I_WFI] + (size_t)L * ND * 2 * DFF, 2 * DFF, (bf16_t*)(F.ws + W_FI), 1024, 176, r, scr, F.lane); continue; } r -= I_FI;
        tr_item<0>(F.ap->in[I_WFO] + (size_t)L * DFF * ND, ND, (bf16_t*)(F.ws + W_FO), DFF, 32, r, scr, F.lane);
    }
    {
        const float* lw = F.ap->in[I_LRUW] + (size_t)L * 2 * 8 * 128 * 128; bf16_t* wt = (bf16_t*)(F.ws + W_LRU);
        for (int it = F.bid * NTHR + F.tid; it < 2048 * 128; it += F.G * NTHR) {
            const int row = it >> 7, kc = (it & 127) * 8, blk = row >> 8, g2 = (row >> 7) & 1, e = row & 127;
            u32x4 o = (u32x4){0u, 0u, 0u, 0u};
            if ((kc >> 7) == blk) { const int c0 = kc & 127; const float* s = lw + ((size_t)(g2 * 8 + blk) * 128 + c0) * 128 + e;
                o.x = pk2(s[0], s[128]); o.y = pk2(s[256], s[384]); o.z = pk2(s[512], s[640]); o.w = pk2(s[768], s[896]); }
            *(u32x4*)(wt + (size_t)row * 1024 + kc) = o;
        }
    }
    {
        float* ctl = (float*)(F.ws + WS_CTL);
        const int gt = F.bid * NTHR + F.tid;
        if (gt < 1024) { const float lam = F.ap->in[I_LAM][L * 1024 + gt]; const float e = __expf(-lam); const float sp = e < 0.03f ? e * (1.f - e * (0.5f - e * (0.33333333f - 0.25f * e))) : __logf(1.f + e); ctl[CT_C8 + gt] = -8.f * sp; }
        else if (gt < 1024 + 2048) { const int i = gt - 1024, h = i >> 7, d = i & 127; ctl[CT_RB + i] = F.ap->in[I_REL][rel_bucket(d) * 16 + h]; }
    }
    const float* g0 = F.ap->in[I_NORMG] + (size_t)(L * 4 + 0) * ND; bf16_t* H = (bf16_t*)(F.ws + WS_H);
    for (int m = gw; m < NT; m += NGW) rms_row_to_bf16(F.xin + (size_t)m * ND, g0, H + (size_t)m * ND, F.lane);
}

__device__ __forceinline__ void ph_lconv(Ctx& F) {
    const int L = F.L;
    const bf16_t* XA = (const bf16_t*)(F.ws + WS_XA); bf16_t* XC = (bf16_t*)(F.ws + WS_XC);
    const float* cw = F.ap->in[I_CONVW] + (size_t)L * 4 * 1024; const float* cb = F.ap->in[I_CONVB] + (size_t)L * 1024;
    for (int idx = F.bid * NTHR + F.tid; idx < NT * 128; idx += F.G * NTHR) {
        const int t = idx >> 7, c8 = (idx & 127) * 8, s = t & (NS - 1);
        float acc[8];
#pragma unroll
        for (int i = 0; i < 8; ++i) acc[i] = cb[c8 + i];
#pragma unroll
        for (int j = 0; j < 4; ++j) { if (s - 3 + j >= 0) { const u32x4 w = *(const u32x4*)(XA + (size_t)(t - 3 + j) * 1024 + c8); const float* ww = cw + j * 1024 + c8;
                acc[0] += ww[0] * bflo(w.x); acc[1] += ww[1] * bfhi(w.x); acc[2] += ww[2] * bflo(w.y); acc[3] += ww[3] * bfhi(w.y);
                acc[4] += ww[4] * bflo(w.z); acc[5] += ww[5] * bfhi(w.z); acc[6] += ww[6] * bflo(w.w); acc[7] += ww[7] * bfhi(w.w); } }
        u32x4 o; o.x = pk2(acc[0], acc[1]); o.y = pk2(acc[2], acc[3]); o.z = pk2(acc[4], acc[5]); o.w = pk2(acc[6], acc[7]);
        *(u32x4*)(XC + (size_t)t * 1024 + c8) = o;
    }
}

__device__ __forceinline__ void ph_lscan(Ctx& F) {
    const bf16_t* LA = (const bf16_t*)(F.ws + WS_LA); const bf16_t* U = (const bf16_t*)(F.ws + WS_U); bf16_t* GA = (bf16_t*)(F.ws + WS_GA);
    LAS float* sA = (LAS float*)F.lds; LAS float* sH = sA + 32 * 32;
    const int chunk = F.tid >> 4, cl = F.tid & 15;
    for (int unit = F.bid; unit < NB_ * 32; unit += F.G) {
        const int b = unit >> 5, c = (unit & 31) * 32 + cl * 2;
        const size_t base = ((size_t)b * NS + chunk * 64) * 1024 + c;
        float s0 = 0.f, s1 = 0.f, h0 = 0.f, h1 = 0.f;
        for (int i = 0; i < 64; ++i) { const unsigned lw = *(const unsigned*)(LA + base + (size_t)i * 1024), uw = *(const unsigned*)(U + base + (size_t)i * 1024);
            const float l0 = bflo(lw), l1 = bfhi(lw); s0 += l0; s1 += l1; h0 = __expf(l0) * h0 + bflo(uw); h1 = __expf(l1) * h1 + bfhi(uw); }
        sA[chunk * 32 + cl * 2] = s0; sA[chunk * 32 + cl * 2 + 1] = s1; sH[chunk * 32 + cl * 2] = h0; sH[chunk * 32 + cl * 2 + 1] = h1;
        __syncthreads();
        h0 = 0.f; h1 = 0.f;
        for (int k = 0; k < chunk; ++k) { h0 = __expf(sA[k * 32 + cl * 2]) * h0 + sH[k * 32 + cl * 2]; h1 = __expf(sA[k * 32 + cl * 2 + 1]) * h1 + sH[k * 32 + cl * 2 + 1]; }
        for (int i = 0; i < 64; ++i) { const unsigned lw = *(const unsigned*)(LA + base + (size_t)i * 1024), uw = *(const unsigned*)(U + base + (size_t)i * 1024);
            h0 = __expf(bflo(lw)) * h0 + bflo(uw); h1 = __expf(bfhi(lw)) * h1 + bfhi(uw);
            unsigned* gp = (unsigned*)(GA + base + (size_t)i * 1024); const unsigned gw = *gp;
            *gp = pk2(h0 * gelu_tanh(bflo(gw)), h1 * gelu_tanh(bfhi(gw))); }
        __syncthreads();
    }
}

__device__ __forceinline__ void ph_cmp1(Ctx& F) {
    const int L = F.L;
    const bf16_t* NBp = (const bf16_t*)(F.ws + WS_NB); float* HID = (float*)(F.ws + WS_HID);
    for (int it = F.bid * NTHR + F.tid; it < 2 * 32 * 32 * 256; it += F.G * NTHR) {
        const int n = it & 255, cq = (it >> 8) & 31, bg = (it >> 13) & 31, kv = it >> 18, b = bg >> 2, g = bg & 3;
        const float* w1 = F.ap->in[I_CW1] + ((size_t)(L * 2 + kv) * 2048) * 256 + n;
        const float* pos = F.ap->in[I_CPOS] + (size_t)(L * 2 + kv) * 2048;
        const bf16_t* src = NBp + (size_t)b * NS * LD_NB + 1024 + kv * 256 + g * 64;
        float acc[4] = {0.f, 0.f, 0.f, 0.f};
        for (int tk = 0; tk < 80; ++tk) { const int tok = 64 * cq + tk; if (tok >= NS) break;
            for (int d = 0; d < 64; ++d) { const float x = bf1(src[(size_t)tok * LD_NB + d]);
#pragma unroll
                for (int i = 0; i < 4; ++i) { const int kk = tk - 16 * i; if (kk >= 0 && kk < 32) { const int k = kk * 64 + d; acc[i] += (x + pos[k]) * w1[(size_t)k * 256]; } } } }
#pragma unroll
        for (int i = 0; i < 4; ++i) { const int c = 4 * cq + i; HID[((size_t)(kv * 32 + bg) * 128 + c) * 256 + n] = gelu_tanh(acc[i]); }
    }
}
__device__ __forceinline__ void ph_cmp2(Ctx& F) {
    const int L = F.L;
    const float* HID = (const float*)(F.ws + WS_HID); bf16_t* KC = (bf16_t*)(F.ws + WS_KC);
    for (int it = F.bid * NTHR + F.tid; it < 2 * 32 * 128 * 64; it += F.G * NTHR) {
        const int d = it & 63, c = (it >> 6) & 127, kvbg = it >> 13, kv = kvbg >> 5;
        const float* w2 = F.ap->in[I_CW2] + (size_t)(L * 2 + kv) * 256 * 64 + d; const float* h = HID + ((size_t)kvbg * 128 + c) * 256;
        float acc = 0.f;
        if (c < 127) for (int n = 0; n < 256; ++n) acc += h[n] * w2[n * 64];
        KC[it] = (bf16_t)f2bf(acc);
    }
}
__device__ __forceinline__ void ph_sel(Ctx& F) {
    const bf16_t* NBp = (const bf16_t*)(F.ws + WS_NB); const bf16_t* KC = (const bf16_t*)(F.ws + WS_KC); unsigned* SEL = (unsigned*)(F.ws + WS_SEL);
    const float* RB = (const float*)(F.ws + WS_CTL) + CT_RB;
    LAS float* imp = (LAS float*)F.lds;
    for (int unit = F.bid; unit < 32 * 4; unit += F.G) {
        const int bg = unit >> 2, b = bg >> 2, g = bg & 3, s = (unit & 3) * 512 + F.tid;
        const int nvalid = s >= 31 ? ((s - 31) >> 4) + 1 : 0;
        const bf16_t* kc = KC + (size_t)bg * 128 * 64;
#pragma unroll 1
        for (int j = 0; j < 32; ++j) imp[j * 512 + F.tid] = 0.f;
#pragma unroll 1
        for (int r = 0; r < 4; ++r) {
            const int h = g * 4 + r; const bf16_t* qp = NBp + ((size_t)b * NS + s) * LD_NB + h * 64;
            unsigned qw[32];
#pragma unroll
            for (int i = 0; i < 8; ++i) { const u32x4 w = *(const u32x4*)(qp + 8 * i); qw[4 * i] = w.x; qw[4 * i + 1] = w.y; qw[4 * i + 2] = w.z; qw[4 * i + 3] = w.w; }
            const float* rb = RB + h * 128;
            float mx = -1e30f, l = 0.f;
#pragma unroll 1
            for (int c = 0; c < 127; ++c) { const unsigned* kr = (const unsigned*)(kc + c * 64); float dot = 0.f;
#pragma unroll
                for (int i = 0; i < 32; ++i) { const unsigned kw = kr[i]; dot += bflo(qw[i]) * bflo(kw) + bfhi(qw[i]) * bfhi(kw); }
                if (c < nvalid) { const int dist = s - 16 * c - 31; const float lg = dot + rb[dist < 127 ? dist : 127];
                    const float mn = fmaxf(mx, lg); l = l * __expf(mx - mn) + __expf(lg - mn); mx = mn; } }
            const float inv = nvalid > 0 ? __builtin_amdgcn_rcpf(l) : 0.f;
#pragma unroll 1
            for (int c = 0; c < 127; ++c) { const unsigned* kr = (const unsigned*)(kc + c * 64); float dot = 0.f;
#pragma unroll
                for (int i = 0; i < 32; ++i) { const unsigned kw = kr[i]; dot += bflo(qw[i]) * bflo(kw) + bfhi(qw[i]) * bfhi(kw); }
                if (c < nvalid) { const int dist = s - 16 * c - 31; const float p = __expf(dot + rb[dist < 127 ? dist : 127] - mx) * inv;
                    const int j = c >> 2, cm = c & 3;
                    if (cm == 3) { imp[j * 512 + F.tid] += 0.5f * p; if (j + 1 < 32) imp[(j + 1) * 512 + F.tid] += 0.5f * p; }
                    else imp[j * 512 + F.tid] += p; } }
        }
        const int cur = s >> 6; unsigned mask;
        if (cur <= 7) mask = (2u << cur) - 1u;
        else { mask = 1u | (1u << cur) | (1u << (cur - 1));
#pragma unroll 1
            for (int k = 0; k < 5; ++k) { float best = -1.f; int bj = 1;
#pragma unroll 1
                for (int j = 1; j <= cur - 2; ++j) { const float v = imp[j * 512 + F.tid]; if (!((mask >> j) & 1u) && v > best) { best = v; bj = j; } }
                mask |= 1u << bj; } }
        SEL[(size_t)bg * NS + s] = mask;
    }
}
#define ATT_KEY(KROW, VROW, ACTIVE, DIST) do { const u32x4* kr_ = (const u32x4*)(KROW); float dot_ = 0.f; \
        _Pragma("unroll") for (int c_ = 0; c_ < 4; ++c_) { const u32x4 ka_ = kr_[2 * c_], kb_ = kr_[2 * c_ + 1]; \
            dot_ += bflo(qw[8 * c_]) * bflo(ka_.x) + bfhi(qw[8 * c_]) * bfhi(ka_.x) + bflo(qw[8 * c_ + 1]) * bflo(ka_.y) + bfhi(qw[8 * c_ + 1]) * bfhi(ka_.y) \
                  + bflo(qw[8 * c_ + 2]) * bflo(ka_.z) + bfhi(qw[8 * c_ + 2]) * bfhi(ka_.z) + bflo(qw[8 * c_ + 3]) * bflo(ka_.w) + bfhi(qw[8 * c_ + 3]) * bfhi(ka_.w) \
                  + bflo(qw[8 * c_ + 4]) * bflo(kb_.x) + bfhi(qw[8 * c_ + 4]) * bfhi(kb_.x) + bflo(qw[8 * c_ + 5]) * bflo(kb_.y) + bfhi(qw[8 * c_ + 5]) * bfhi(kb_.y) \
                  + bflo(qw[8 * c_ + 6]) * bflo(kb_.z) + bfhi(qw[8 * c_ + 6]) * bfhi(kb_.z) + bflo(qw[8 * c_ + 7]) * bflo(kb_.w) + bfhi(qw[8 * c_ + 7]) * bfhi(kb_.w); \
            __builtin_amdgcn_sched_barrier(0); } \
        if (ACTIVE) { const int dd_ = (DIST); const float lg_ = dot_ + rb[dd_ < 127 ? dd_ : 127]; const float mn_ = fmaxf(mx, lg_), sc_ = __expf(mx - mn_), p_ = __expf(lg_ - mn_); mx = mn_; l = l * sc_ + p_; \
            const u32x4* vr_ = (const u32x4*)(VROW); \
            _Pragma("unroll") for (int c_ = 0; c_ < 8; ++c_) { const u32x4 vv_ = vr_[c_]; \
                o[8 * c_] = o[8 * c_] * sc_ + p_ * bflo(vv_.x); o[8 * c_ + 1] = o[8 * c_ + 1] * sc_ + p_ * bfhi(vv_.x); o[8 * c_ + 2] = o[8 * c_ + 2] * sc_ + p_ * bflo(vv_.y); o[8 * c_ + 3] = o[8 * c_ + 3] * sc_ + p_ * bfhi(vv_.y); \
                o[8 * c_ + 4] = o[8 * c_ + 4] * sc_ + p_ * bflo(vv_.z); o[8 * c_ + 5] = o[8 * c_ + 5] * sc_ + p_ * bfhi(vv_.z); o[8 * c_ + 6] = o[8 * c_ + 6] * sc_ + p_ * bflo(vv_.w); o[8 * c_ + 7] = o[8 * c_ + 7] * sc_ + p_ * bfhi(vv_.w); \
                if (c_ & 1) __builtin_amdgcn_sched_barrier(0); } } } while (0)
__device__ __forceinline__ void ph_att(Ctx& F) {
    bf16_t* NBp = (bf16_t*)(F.ws + WS_NB); const bf16_t* KC = (const bf16_t*)(F.ws + WS_KC); const unsigned* SEL = (const unsigned*)(F.ws + WS_SEL);
    const float* RB = (const float*)(F.ws + WS_CTL) + CT_RB;
    for (int unit = F.bid; unit < NB_ * 16 * 4; unit += F.G) {
        const int sb = unit & 3, h = (unit >> 2) & 15, b = unit >> 6, g = h >> 2, bg = b * 4 + g;
        const int s = sb * 512 + F.tid, sw0 = sb * 512 + F.wave * 64;
        bf16_t* qp = NBp + ((size_t)b * NS + s) * LD_NB + h * 64;
        unsigned qw[32];
#pragma unroll
        for (int i = 0; i < 8; ++i) { const u32x4 w = *(const u32x4*)(qp + 8 * i); qw[4 * i] = w.x; qw[4 * i + 1] = w.y; qw[4 * i + 2] = w.z; qw[4 * i + 3] = w.w; }
        const bf16_t* gp = NBp + ((size_t)b * NS + s) * LD_NB + 2560 + h;
        const float g0 = sigmoidf_(bf1(gp[0])), g1 = sigmoidf_(bf1(gp[16])), g2 = sigmoidf_(bf1(gp[32]));
        const float* rb = RB + h * 128;
        float o[64]; LAS float* y = (LAS float*)F.lds + F.tid;
#pragma unroll
        for (int i = 0; i < 64; ++i) { y[i * 512] = 0.f; o[i] = 0.f; }
        float mx = -1e30f, l = 0.f;
        { const int nvalid = s >= 31 ? ((s - 31) >> 4) + 1 : 0; const bf16_t* kc = KC + (size_t)bg * 128 * 64; const bf16_t* vc = KC + (size_t)(32 + bg) * 128 * 64;
#pragma unroll 1
            for (int c = 0; c < 127; ++c) ATT_KEY(kc + c * 64, vc + c * 64, c < nvalid, s - 16 * c - 31);
            const float sc = l > 0.f ? g0 * __builtin_amdgcn_rcpf(l) : 0.f;
#pragma unroll
            for (int i = 0; i < 64; ++i) { y[i * 512] += sc * o[i]; o[i] = 0.f; }
            mx = -1e30f; l = 0.f; }
        const bf16_t* kvb = NBp + (size_t)b * NS * LD_NB + 1024 + g * 64;
        { const unsigned mask = SEL[(size_t)bg * NS + s];
#pragma unroll 1
            for (int j = 0; j < 32; ++j) { const bool bit = (mask >> j) & 1u; if (!__any(bit)) continue;
#pragma unroll 1
                for (int i = 0; i < 64; ++i) { const int tk = 64 * j + i; const bf16_t* row = kvb + (size_t)tk * LD_NB; ATT_KEY(row + 2 * 256, row + 3 * 256, bit && tk <= s, s - tk); } }
            const float sc = l > 0.f ? g1 * __builtin_amdgcn_rcpf(l) : 0.f;
#pragma unroll
            for (int i = 0; i < 64; ++i) { y[i * 512] += sc * o[i]; o[i] = 0.f; }
            mx = -1e30f; l = 0.f; }
        { const int t0 = sw0 - 255 > 0 ? sw0 - 255 : 0, t1 = sw0 + 63;
#pragma unroll 1
            for (int tk = t0; tk <= t1; ++tk) { const bf16_t* row = kvb + (size_t)tk * LD_NB; ATT_KEY(row + 4 * 256, row + 5 * 256, tk <= s && s - tk < 256, s - tk); }
            const float sc = l > 0.f ? g2 * __builtin_amdgcn_rcpf(l) : 0.f;
#pragma unroll
            for (int i = 0; i < 64; ++i) y[i * 512] += sc * o[i]; }
#pragma unroll
        for (int i = 0; i < 8; ++i) { u32x4 w; w.x = pk2(y[(8 * i) * 512], y[(8 * i + 1) * 512]); w.y = pk2(y[(8 * i + 2) * 512], y[(8 * i + 3) * 512]); w.z = pk2(y[(8 * i + 4) * 512], y[(8 * i + 5) * 512]); w.w = pk2(y[(8 * i + 6) * 512], y[(8 * i + 7) * 512]); *(u32x4*)(qp + 8 * i) = w; }
    }
}

__device__ __forceinline__ void ph_gla(Ctx& F) {
    const int L = F.L;
    const bf16_t* NBp = (const bf16_t*)(F.ws + WS_NB); bf16_t* GB = (bf16_t*)(F.ws + WS_GB);
    LAS float* sq = (LAS float*)F.lds; LAS float* sk = sq + 128; LAS float* sa = sk + 128; LAS float* so = sa + 128; LAS float* sss = so + 1024;
    const int e = F.tid & 255, half = F.tid >> 8;
    for (int unit = F.bid; unit < 32; unit += F.G) {
        const int b = unit >> 2, h = unit & 3;
        float S[64];
#pragma unroll
        for (int i = 0; i < 64; ++i) S[i] = 0.f;
        float wa[16]; float ba = 0.f;
        if (F.tid < 128) { const float* w = F.ap->in[I_WA2] + (size_t)L * 16 * 512 + h * 128 + F.tid;
#pragma unroll
            for (int r = 0; r < 16; ++r) wa[r] = w[r * 512];
            ba = F.ap->in[I_BA][L * 512 + h * 128 + F.tid]; }
        const float gn = F.ap->in[I_GNORM][L * 256 + e];
#pragma unroll 1
        for (int s = 0; s < NS; ++s) {
            const size_t t = (size_t)b * NS + s; bf16_t* row = GB + t * LD_GB;
            if (F.tid < 128) { const bf16_t* lr = NBp + t * LD_NB + 2608; float z = ba;
#pragma unroll
                for (int r = 0; r < 16; ++r) z += bf1(lr[r]) * wa[r];
                const float ls = (z < 0.f ? z : 0.f) - __logf(1.f + __expf(-fabsf(z)));
                sa[F.tid] = __expf(ls * (1.f / 16.f)); sq[F.tid] = bf1(row[h * 128 + F.tid]) * 0.08838834764831845f; sk[F.tid] = bf1(row[512 + h * 128 + F.tid]); }
            __syncthreads();
            const float v = bf1(row[1024 + h * 256 + e]); float acc = 0.f;
#pragma unroll
            for (int i = 0; i < 64; ++i) { const int dk = half * 64 + i; S[i] = sa[dk] * S[i] + sk[dk] * v; acc += sq[dk] * S[i]; }
            so[(s & 1) * 512 + half * 256 + e] = acc;
            __syncthreads();
            if (F.tid < 256) { const float ov = so[(s & 1) * 512 + e] + so[(s & 1) * 512 + 256 + e]; const float ss = wave_sum(ov * ov);
                if (F.lane == 0) sss[(s & 1) * 4 + F.wave] = ss;
                acc = ov; }
            __syncthreads();
            if (F.tid < 256) { const float tot = sss[(s & 1) * 4] + sss[(s & 1) * 4 + 1] + sss[(s & 1) * 4 + 2] + sss[(s & 1) * 4 + 3];
                bf16_t* op = row + 2048 + h * 256 + e; const float og = bf1(*op);
                *op = (bf16_t)f2bf(acc * __builtin_amdgcn_rsqf(tot * (1.f / 256.f) + EPS) * gn * (og * sigmoidf_(og))); }
        }
        __syncthreads();
    }
}

template <bool WITH_H> __device__ __forceinline__ void ph_res(Ctx& F, const float* xsrc, const float* gz, const float* gh) {
    const float* Z = (const float*)(F.ws + WS_XA); bf16_t* H = (bf16_t*)(F.ws + WS_H); float* out = F.out;
    const int gw = F.bid * NWAVES + F.wave, NGW = F.G * NWAVES;
    for (int m = gw; m < NT; m += NGW) {
        const f32x4* zr = (const f32x4*)(Z + (size_t)m * ND) + F.lane; const f32x4* xr = (const f32x4*)(xsrc + (size_t)m * ND) + F.lane;
        f32x4 z[4], x[4]; float s = 0.f;
#pragma unroll
        for (int j = 0; j < 4; ++j) { z[j] = zr[64 * j]; x[j] = xr[64 * j]; s += (z[j].x * z[j].x + z[j].y * z[j].y) + (z[j].z * z[j].z + z[j].w * z[j].w); }
        const float rstd = __builtin_amdgcn_rsqf(wave_sum(s) * (1.f / ND) + EPS); float s2 = 0.f;
#pragma unroll
        for (int j = 0; j < 4; ++j) { const f32x4 gg = ((const f32x4*)gz + F.lane)[64 * j]; x[j] = x[j] + z[j] * rstd * gg; ((f32x4*)(out + (size_t)m * ND) + F.lane)[64 * j] = x[j];
            s2 += (x[j].x * x[j].x + x[j].y * x[j].y) + (x[j].z * x[j].z + x[j].w * x[j].w); }
        if (WITH_H) { const float r2 = __builtin_amdgcn_rsqf(wave_sum(s2) * (1.f / ND) + EPS); unsigned long long* o8 = (unsigned long long*)(H + (size_t)m * ND) + F.lane;
#pragma unroll
            for (int j = 0; j < 4; ++j) { const f32x4 gg = ((const f32x4*)gh + F.lane)[64 * j];
                o8[64 * j] = (unsigned long long)pk2(x[j].x * r2 * gg.x, x[j].y * r2 * gg.y) | ((unsigned long long)pk2(x[j].z * r2 * gg.z, x[j].w * r2 * gg.w) << 32); } }
    }
}

template <int p> __device__ __forceinline__ void run_phase(Ctx& F, const int L) {
    using namespace pg8;
    unsigned char* ws = F.ws;
        F.L = L; F.xin = (L == 0) ? F.ap->in[I_X] : F.out;
        const float* ng = F.ap->in[I_NORMG] + (size_t)L * 4 * ND;
        StaticOrder S;
        switch (p) {
        case PH_PRE: if constexpr (PH_ON(PH_PRE)) { ph_pre(F); } break;
        case PH_G1: if constexpr (PH_ON(PH_G1)) { { Gemm g{(const bf16_t*)(ws + WS_H), (const bf16_t*)(ws + W_G1), 1024, 1024, 1024, 0}; S.init(64, 8, F.G, F.bid);
            EpiStore<0> E{{(bf16_t*)(ws + WS_XA), 1024, 0}, {(bf16_t*)(ws + WS_GA), 1024, 4}, {nullptr, 0, 0}, 4, 1 << 30, 0, 1.f};
            gemm_phase<EpiStore<0>, true>(F.lds, g, S, E, F.tid); } } break;
        case PH_LCONV: if constexpr (PH_ON(PH_LCONV)) { ph_lconv(F); } break;
        case PH_LGATE: if constexpr (PH_ON(PH_LGATE)) { { Gemm g{(const bf16_t*)(ws + WS_XC), (const bf16_t*)(ws + W_LRU), 1024, 1024, 1024, 0}; S.init(64, 8, F.G, F.bid);
            EpiLru E{(const bf16_t*)(ws + WS_XC), (bf16_t*)(ws + WS_LA), (bf16_t*)(ws + WS_U), F.ap->in[I_LRUB] + (size_t)L * 2048, (const float*)(ws + WS_CTL) + CT_C8};
            gemm_phase<EpiLru, true>(F.lds, g, S, E, F.tid); } } break;
        case PH_LSCAN: if constexpr (PH_ON(PH_LSCAN)) { ph_lscan(F); } break;
        case PH_G23: if constexpr (PH_ON(PH_G23)) { { Gemm g{(const bf16_t*)(ws + WS_H), (const bf16_t*)(ws + W_G23), 1024, 1024, 1024, 0}; S.init(64, 23, F.G, F.bid);
            EpiStore<0> E{{(bf16_t*)(ws + WS_NB), LD_NB, 0}, {(bf16_t*)(ws + WS_GB), LD_GB, 11}, {nullptr, 0, 0}, 11, 1 << 30, 4, 0.125f};
            gemm_phase<EpiStore<0>, true>(F.lds, g, S, E, F.tid); } } break;
        case PH_CMP1: if constexpr (PH_ON(PH_CMP1)) { ph_cmp1(F); } break;
        case PH_CMP2: if constexpr (PH_ON(PH_CMP2)) { ph_cmp2(F); } break;
        case PH_SEL: if constexpr (PH_ON(PH_SEL)) { ph_sel(F); } break;
        case PH_ATT: if constexpr (PH_ON(PH_ATT)) { ph_att(F); } break;
        case PH_GLA: if constexpr (PH_ON(PH_GLA)) { ph_gla(F); } break;
        case PH_G4: if constexpr (PH_ON(PH_G4)) { { Gemm g{(const bf16_t*)(ws + WS_H), (const bf16_t*)(ws + W_G4), 1024, 1024, 1024, 0}; S.init(64, 12, F.G, F.bid);
            EpiStore<2> E{{(bf16_t*)(ws + WS_XA), 1024, 0}, {(bf16_t*)(ws + WS_NB) + 1024, LD_NB, 4}, {(bf16_t*)(ws + WS_GB), LD_GB, 8}, 4, 8, 0, 1.f};
            gemm_phase<EpiStore<2>, true>(F.lds, g, S, E, F.tid); } } break;
        case PH_BR: if constexpr (PH_ON(PH_BR)) { { S.init(64, 4, F.G, F.bid); bf16_t* MO = (bf16_t*)(ws + WS_GB) + 1024;
            { Gemm g{(const bf16_t*)(ws + WS_GA), (const bf16_t*)(ws + W_BR), 1024, 1024, 1024, 0}; EpiBranch<true> E{(const bf16_t*)(ws + WS_XA), 1024, MO, LD_GB}; gemm_phase<EpiBranch<true>, false>(F.lds, g, S, E, F.tid); }
            { Gemm g{(const bf16_t*)(ws + WS_NB), (const bf16_t*)(ws + W_BR) + (size_t)ND * ND, LD_NB, 1024, 1024, 0}; EpiBranch<false> E{(const bf16_t*)(ws + WS_NB) + 1024, LD_NB, MO, LD_GB}; gemm_phase<EpiBranch<false>, false>(F.lds, g, S, E, F.tid); }
            { Gemm g{(const bf16_t*)(ws + WS_GB) + 2048, (const bf16_t*)(ws + W_BR) + (size_t)2 * ND * ND, LD_GB, 1024, 1024, 0}; EpiBranch<false> E{(const bf16_t*)(ws + WS_GB), LD_GB, MO, LD_GB}; gemm_phase<EpiBranch<false>, false>(F.lds, g, S, E, F.tid); } } } break;
        case PH_OUT: if constexpr (PH_ON(PH_OUT)) { { Gemm g{(const bf16_t*)(ws + WS_GB) + 1024, (const bf16_t*)(ws + W_OUT), LD_GB, 1024, 1024, 0}; S.init(64, 4, F.G, F.bid);
            EpiF32 E{(float*)(ws + WS_XA), 1024}; gemm_phase<EpiF32, false>(F.lds, g, S, E, F.tid); } } break;
        case PH_RES1: if constexpr (PH_ON(PH_RES1)) { ph_res<true>(F, F.xin, ng + 1 * ND, ng + 2 * ND); } break;
        case PH_FI: if constexpr (PH_ON(PH_FI)) { { Gemm g{(const bf16_t*)(ws + WS_H), (const bf16_t*)(ws + W_FI), 1024, 1024, 1024, 0}; S.init(64, 22, F.G, F.bid);
            EpiSwiGLU E{(bf16_t*)(ws + WS_NB), DFF}; gemm_phase<EpiSwiGLU, true>(F.lds, g, S, E, F.tid); } } break;
        case PH_FO: if constexpr (PH_ON(PH_FO)) { { Gemm g{(const bf16_t*)(ws + WS_NB), (const bf16_t*)(ws + W_FO), DFF, DFF, DFF, 0}; S.init(64, 4, F.G, F.bid);
            EpiF32 E{(float*)(ws + WS_XA), 1024}; gemm_phase<EpiF32, false>(F.lds, g, S, E, F.tid); } } break;
        case PH_RES2: if constexpr (PH_ON(PH_RES2)) { ph_res<false>(F, F.out, ng + 3 * ND, nullptr); } break;
        }
}
constexpr int LDS_BYTES = 147456;
template <bool COOP> __global__ void __launch_bounds__(NTHR, 2) mk_fwd(Args args) {
    extern __shared__ __attribute__((aligned(16))) unsigned char lds_raw[];
    Ctx F; F.lds = (LAS unsigned char*)lds_raw; F.ldsg = lds_raw;
    F.tid = threadIdx.x; F.lane = F.tid & 63; F.wave = __builtin_amdgcn_readfirstlane(F.tid >> 6); F.G = gridDim.x; F.bid = blockIdx.x;
    const int lo = args.ph_lo, hi = args.ph_hi;
#define MK_PHASE(L_, P_) if (lo <= (L_) * NPH + (P_) && (L_) * NPH + (P_) < hi) { \
        { int bid_ = blockIdx.x; asm volatile("" : "+s"(bid_)); F.bid = bid_; \
          int tid_ = threadIdx.x; asm volatile("" : "+v"(tid_)); F.tid = tid_; F.lane = tid_ & 63; F.wave = __builtin_amdgcn_readfirstlane(tid_ >> 6); \
          unsigned long long apl_ = (unsigned long long)__builtin_amdgcn_kernarg_segment_ptr(); asm volatile("" : "+s"(apl_)); F.ap = (ArgsP)apl_; \
          F.ws = F.ap->ws; F.out = F.ap->out; F.G = gridDim.x; } \
        run_phase<P_>(F, L_); \
        if (COOP) { if ((L_) * NPH + (P_) + 1 < hi) cg::this_grid().sync(); } }
#define MK_LAYER(L_) MK_PHASE(L_, 0) MK_PHASE(L_, 1) MK_PHASE(L_, 2) MK_PHASE(L_, 3) MK_PHASE(L_, 4) MK_PHASE(L_, 5) MK_PHASE(L_, 6) MK_PHASE(L_, 7) MK_PHASE(L_, 8) \
        MK_PHASE(L_, 9) MK_PHASE(L_, 10) MK_PHASE(L_, 11) MK_PHASE(L_, 12) MK_PHASE(L_, 13) MK_PHASE(L_, 14) MK_PHASE(L_, 15) MK_PHASE(L_, 16) MK_PHASE(L_, 17)
    MK_LAYER(0)
    MK_LAYER(1)
}

extern "C" void kernel_launch(void* const* d_in, const int* in_sizes, int n_in, void* d_out, int out_size, void* d_ws, size_t ws_size, hipStream_t stream) {
    static int grid = 0;
    if (grid == 0) {
        if (n_in != 19 || out_size != NT * ND || ws_size < WS_END) { fprintf(stderr, "kernel_launch: unexpected shapes/workspace (n_in %d out %d ws %zu need %zu)\n", n_in, out_size, ws_size, (size_t)WS_END); grid = -1; return; }
        int dev = 0, cus = 0, per_cu = 0;
        hipGetDevice(&dev); hipDeviceGetAttribute(&cus, hipDeviceAttributeMultiprocessorCount, dev);
        hipFuncSetAttribute((const void*)mk_fwd<true>, hipFuncAttributeMaxDynamicSharedMemorySize, LDS_BYTES);
        hipFuncSetAttribute((const void*)mk_fwd<false>, hipFuncAttributeMaxDynamicSharedMemorySize, LDS_BYTES);
        hipOccupancyMaxActiveBlocksPerMultiprocessor(&per_cu, (const void*)mk_fwd<true>, NTHR, LDS_BYTES);
        if (per_cu < 1) { fprintf(stderr, "kernel_launch: occupancy query says %d blocks/CU\n", per_cu); per_cu = 1; }
        (void)hipGetLastError();
        grid = cus;
    }
    if (grid < 0) return;
    Args a{};
    for (int i = 0; i < 19; ++i) a.in[i] = (const float*)d_in[i];
    a.out = (float*)d_out; a.ws = (unsigned char*)d_ws;
#if MK_COOP
    a.ph_lo = 0; a.ph_hi = 2 * NPH;
    void* kargs[] = {&a};
    hipError_t e = hipLaunchCooperativeKernel((const void*)mk_fwd<true>, dim3(grid), dim3(NTHR), kargs, LDS_BYTES, stream);
    if (e != hipSuccess) fprintf(stderr, "cooperative launch failed: %s (grid %d)\n", hipGetErrorString(e), grid);
#else
    for (int ph = 0; ph < 2 * NPH; ++ph) {
        a.ph_lo = ph; a.ph_hi = ph + 1;
        hipLaunchKernelGGL(mk_fwd<false>, dim3(grid), dim3(NTHR), LDS_BYTES, stream, a);
    }
#endif
}
```

```cpp
#include <hip/hip_runtime.h>
#include <hip/hip_cooperative_groups.h>
#include <cstdio>
#include <cstdint>
namespace cg = cooperative_groups;

#ifndef MK_COOP
#define MK_COOP 1
#endif
#ifndef MK_PM
#define MK_PM 0xFFFFFFFFu
#endif
#define PH_ON(p) (((MK_PM) >> (p)) & 1u)

#define LAS __attribute__((address_space(3)))
typedef unsigned short bf16_t;
typedef short bf16x8 __attribute__((ext_vector_type(8)));
typedef float f32x4 __attribute__((ext_vector_type(4)));
typedef float f32x2 __attribute__((ext_vector_type(2)));
typedef unsigned u32x4 __attribute__((ext_vector_type(4)));
typedef unsigned u32x2 __attribute__((ext_vector_type(2)));

constexpr int NB_ = 8, NS = 2048, ND = 1024, NT = NB_ * NS;
constexpr int IN_W = 10816, DFF = 2816;
constexpr int LD_NB = 2816, LD_GB = 3072;
constexpr float EPS = 1e-6f;
constexpr int NTHR = 512, NWAVES = 8;

constexpr size_t MiB = 1u << 20;
constexpr size_t WS_CTL = 0;
constexpr size_t WS_W = 1 * MiB;
constexpr size_t W_G1 = WS_W;
constexpr size_t W_G23 = W_G1 + 4 * MiB;
constexpr size_t W_G4 = W_G23 + 5888ull * 1024 * 2;
constexpr size_t W_LRU = W_G4 + 6 * MiB;
constexpr size_t W_BR = W_LRU + 4 * MiB;
constexpr size_t W_OUT = W_BR + 6 * MiB;
constexpr size_t W_FI = W_OUT + 2 * MiB;
constexpr size_t W_FO = W_FI + 11 * MiB;
constexpr size_t W_END = W_FO + 1024ull * 2816 * 2;
constexpr size_t WS_H = 52 * MiB;
constexpr size_t WS_XA = 84 * MiB;
constexpr size_t WS_GA = 116 * MiB;
constexpr size_t WS_NB = 148 * MiB;
constexpr size_t WS_GB = 236 * MiB;
constexpr size_t WS_END = 332 * MiB;
static_assert(W_END <= WS_H, "weights region");
constexpr size_t WS_XC = WS_NB, WS_LA = WS_NB + 32 * MiB, WS_U = WS_NB + 64 * MiB;
constexpr size_t WS_HID = WS_XA;
constexpr size_t WS_KC = WS_XA + 8 * MiB;
constexpr size_t WS_SEL = WS_XA + 10 * MiB;
constexpr int CT_C8 = 0;
constexpr int CT_RB = 1024;

__device__ __forceinline__ unsigned f2bf(float f) { unsigned u = __float_as_uint(f); return (u + 0x7fffu + ((u >> 16) & 1u)) >> 16; }
__device__ __forceinline__ unsigned pk2(float lo, float hi) { return f2bf(lo) | (f2bf(hi) << 16); }
__device__ __forceinline__ float bflo(unsigned w) { return __uint_as_float(w << 16); }
__device__ __forceinline__ float bfhi(unsigned w) { return __uint_as_float(w & 0xffff0000u); }
__device__ __forceinline__ float bf1(bf16_t h) { return __uint_as_float((unsigned)h << 16); }
__device__ __forceinline__ float sigmoidf_(float x) { return __builtin_amdgcn_rcpf(1.f + __expf(-x)); }
__device__ __forceinline__ float gelu_tanh(float x) { const float u = 1.5957691216057308f * (x + 0.044715f * x * x * x); return x * sigmoidf_(u); }
__device__ __forceinline__ float wave_sum(float v) {
    v += __int_as_float(__builtin_amdgcn_ds_swizzle(__float_as_int(v), 0x041f));
    v += __int_as_float(__builtin_amdgcn_ds_swizzle(__float_as_int(v), 0x081f));
    v += __int_as_float(__builtin_amdgcn_ds_swizzle(__float_as_int(v), 0x101f));
    v += __int_as_float(__builtin_amdgcn_ds_swizzle(__float_as_int(v), 0x201f));
    v += __int_as_float(__builtin_amdgcn_ds_swizzle(__float_as_int(v), 0x401f));
    auto rr = __builtin_amdgcn_permlane32_swap(__float_as_uint(v), __float_as_uint(v), false, false);
    return __uint_as_float(rr[0]) + __uint_as_float(rr[1]);
}
__device__ __forceinline__ int rel_bucket(int n) {
    if (n < 16) return n;
    int b = 16;
    b += (n >= 19) + (n >= 21) + (n >= 24) + (n >= 27) + (n >= 31) + (n >= 35) + (n >= 40) + (n >= 46) + (n >= 52) + (n >= 59) + (n >= 67) + (n >= 77) + (n >= 87) + (n >= 99) + (n >= 113);
    return b;
}

namespace pg8 {
constexpr int BM = 256, BK = 64, HALF = 128, HTB = HALF * BK * 2, STAGE_BYTES = 8 * HTB, NXCD = 8, WGM = 8;
__device__ __forceinline__ int lds_byte(int r, int c) { const int st = (r >> 4) * 2 + (c >> 5), rr = r & 15, cc = c & 31, ob = rr * 64 + cc * 2; return st * 1024 + (ob ^ (((ob >> 9) & 1) << 5)); }
__device__ __forceinline__ void stage_rc(int b, int& R, int& C) { const int st = b / 1024, sb = b % 1024, swz = sb ^ (((sb >> 9) & 1) << 5); R = (st >> 1) * 16 + swz / 64; C = (st & 1) * 32 + (swz % 64) / 2; }
__device__ __forceinline__ int perm32(int rho) { const int n = rho >> 4, i = rho & 15; return 8 * (i >> 2) + 4 * n + (i & 3); }

struct Unit { int pm, pn; };
struct Gemm { const bf16_t* A; const bf16_t* Bt; int lda, ldb, K, akw; };

struct StaticOrder {
    int nM, nN, nwg, G, c;
    __device__ void init(int nM_, int nN_, int G_, int c_) { nM = nM_; nN = nN_; nwg = nM * nN; G = G_; c = c_; }
    __device__ bool next(int i, Unit& u) const {
        const long L = (long)i * G + c; if (L >= nwg) return false;
        int wgid = (int)L; { const int q = nwg / NXCD, r = nwg % NXCD, xcd = wgid % NXCD, off = wgid / NXCD; wgid = (xcd < r ? xcd * (q + 1) : r * (q + 1) + (xcd - r) * q) + off; }
        const int nig = WGM * nN, gid = wgid / nig, fm = gid * WGM, gsz = (nM - fm) < WGM ? (nM - fm) : WGM;
        u.pm = fm + ((wgid % nig) % gsz); u.pn = (wgid % nig) / gsz; return true;
    }
};

typedef __bf16 bf16x2_t __attribute__((ext_vector_type(2)));
__device__ __forceinline__ unsigned cvt_pk_bf16(float lo, float hi) { const f32x2 v = {lo, hi}; const bf16x2_t b = __builtin_convertvector(v, bf16x2_t); return __builtin_bit_cast(unsigned, b); }

struct Seg { bf16_t* base; int ld; int tile0; };
template <int ACT  > struct EpiStore {
    static constexpr bool PERM = true;
    Seg s0, s1, s2; int t1, t2; int nscale; float scale;
    __device__ __forceinline__ void operator()(const f32x4 (&acc)[2][2][4][2], const Unit& u, int wr, int wc, int fr, int fq) const {
        const bool c1_ = u.pn < t1, c2_ = u.pn < t2;
        bf16_t* const pb0 = s0.base; bf16_t* const pb1 = s1.base; bf16_t* const pb2 = s2.base; const int l0 = s0.ld, l1 = s1.ld, l2 = s2.ld, q0 = s0.tile0, q1 = s1.tile0, q2 = s2.tile0;
        bf16_t* base = c1_ ? pb0 : (c2_ ? pb1 : pb2); const int ld = c1_ ? l0 : (c2_ ? l1 : l2), t0 = c1_ ? q0 : (c2_ ? q1 : q2);
        const float sc = u.pn < nscale ? scale : 1.f;
        const int row0 = u.pm * BM + wr * 64 + fr, col0 = (u.pn - t0) * BM + wc * 32 + 8 * fq;
#pragma unroll
        for (int ai = 0; ai < 2; ++ai)
#pragma unroll
            for (int m = 0; m < 4; ++m) { bf16_t* rowp = base + (size_t)(row0 + ai * HALF + m * 16) * ld + col0;
#pragma unroll
                for (int bj = 0; bj < 2; ++bj) { f32x4 v0 = acc[ai][bj][m][0] * sc, v1 = acc[ai][bj][m][1] * sc;
                    if (ACT == 2) {
#pragma unroll
                        for (int j = 0; j < 4; ++j) { v0[j] = sigmoidf_(v0[j]); v1[j] = sigmoidf_(v1[j]); } }
                    u32x4 w; w.x = cvt_pk_bf16(v0[0], v0[1]); w.y = cvt_pk_bf16(v0[2], v0[3]); w.z = cvt_pk_bf16(v1[0], v1[1]); w.w = cvt_pk_bf16(v1[2], v1[3]);
                    *(u32x4*)(rowp + bj * HALF) = w; }
                if (ACT != 0) __builtin_amdgcn_sched_barrier(0); }
    }
};
struct EpiLru {
    static constexpr bool PERM = false;
    const bf16_t* XC; bf16_t* LA; bf16_t* U; const float* bg; const float* c8;
    __device__ __forceinline__ void operator()(const f32x4 (&acc)[2][2][4][2], const Unit& u, int wr, int wc, int fr, int fq) const {
        const int row0 = u.pm * BM + wr * 64 + fr, ch0 = u.pn * HALF + wc * 32 + 4 * fq;
#pragma unroll
        for (int n = 0; n < 2; ++n) { const int ch = ch0 + n * 16;
            const f32x4 br = *(const f32x4*)(bg + ch), bi = *(const f32x4*)(bg + 1024 + ch), cc = *(const f32x4*)(c8 + ch);
            u32x2 xw = *(const u32x2*)(XC + (size_t)row0 * 1024 + ch);
#pragma unroll
            for (int it = 0; it < 8; ++it) { const int ai = it >> 2, m = it & 3; const size_t off = (size_t)(row0 + ai * HALF + m * 16) * 1024 + ch;
                u32x2 xn = xw; if (it < 7) xn = *(const u32x2*)(XC + (size_t)(row0 + ((it + 1) >> 2) * HALF + ((it + 1) & 3) * 16) * 1024 + ch);
                const float xv[4] = {bflo(xw.x), bfhi(xw.x), bflo(xw.y), bfhi(xw.y)};
                float la[4], uu[4];
#pragma unroll
                for (int j = 0; j < 4; ++j) { const float r = sigmoidf_(acc[ai][0][m][n][j] + br[j]), ig = sigmoidf_(acc[ai][1][m][n][j] + bi[j]);
                    la[j] = cc[j] * r; uu[j] = __builtin_amdgcn_sqrtf(fmaxf(1.f - __expf(2.f * la[j]), 0.f)) * (ig * xv[j]); }
                u32x2 wl, wu; wl.x = cvt_pk_bf16(la[0], la[1]); wl.y = cvt_pk_bf16(la[2], la[3]); wu.x = cvt_pk_bf16(uu[0], uu[1]); wu.y = cvt_pk_bf16(uu[2], uu[3]);
                *(u32x2*)(LA + off) = wl; *(u32x2*)(U + off) = wu; xw = xn;
                __builtin_amdgcn_sched_barrier(0); } }
    }
};
__device__ __forceinline__ u32x4 ld16_agent(const void* p) {
    const unsigned long long* q = (const unsigned long long*)p;
    const unsigned long long a = __hip_atomic_load(q, __ATOMIC_RELAXED, __HIP_MEMORY_SCOPE_AGENT), b = __hip_atomic_load(q + 1, __ATOMIC_RELAXED, __HIP_MEMORY_SCOPE_AGENT);
    return (u32x4){(unsigned)a, (unsigned)(a >> 32), (unsigned)b, (unsigned)(b >> 32)};
}
template <bool FIRST> struct EpiBranch {
    static constexpr bool PERM = true;
    const bf16_t* G; int ldg; bf16_t* O; int ldo;
    __device__ __forceinline__ void operator()(const f32x4 (&acc)[2][2][4][2], const Unit& u, int wr, int wc, int fr, int fq) const {
        const int row0 = u.pm * BM + wr * 64 + fr, col0 = u.pn * BM + wc * 32 + 8 * fq;
        u32x4 gw[2], ow[2];
#pragma unroll
        for (int bj = 0; bj < 2; ++bj) { gw[bj] = *(const u32x4*)(G + (size_t)row0 * ldg + col0 + bj * HALF); if (!FIRST) ow[bj] = *(const u32x4*)(O + (size_t)row0 * ldo + col0 + bj * HALF); }
#pragma unroll
        for (int it = 0; it < 8; ++it) { const int ai = it >> 2, m = it & 3; const size_t r = (size_t)(row0 + ai * HALF + m * 16);
            u32x4 gn[2], on[2];
#pragma unroll
            for (int bj = 0; bj < 2; ++bj) { gn[bj] = gw[bj]; on[bj] = ow[bj]; }
            if (it < 7) { const size_t rn = (size_t)(row0 + ((it + 1) >> 2) * HALF + ((it + 1) & 3) * 16);
#pragma unroll
                for (int bj = 0; bj < 2; ++bj) { gn[bj] = *(const u32x4*)(G + rn * ldg + col0 + bj * HALF); if (!FIRST) on[bj] = *(const u32x4*)(O + rn * ldo + col0 + bj * HALF); } }
#pragma unroll
            for (int bj = 0; bj < 2; ++bj) { const u32x4 g4 = gw[bj];
                float v[8] = {acc[ai][bj][m][0][0] * bflo(g4.x), acc[ai][bj][m][0][1] * bfhi(g4.x), acc[ai][bj][m][0][2] * bflo(g4.y), acc[ai][bj][m][0][3] * bfhi(g4.y),
                              acc[ai][bj][m][1][0] * bflo(g4.z), acc[ai][bj][m][1][1] * bfhi(g4.z), acc[ai][bj][m][1][2] * bflo(g4.w), acc[ai][bj][m][1][3] * bfhi(g4.w)};
                if (!FIRST) { const u32x4 o4 = ow[bj]; v[0] += bflo(o4.x); v[1] += bfhi(o4.x); v[2] += bflo(o4.y); v[3] += bfhi(o4.y); v[4] += bflo(o4.z); v[5] += bfhi(o4.z); v[6] += bflo(o4.w); v[7] += bfhi(o4.w); }
                u32x4 w; w.x = cvt_pk_bf16(v[0], v[1]); w.y = cvt_pk_bf16(v[2], v[3]); w.z = cvt_pk_bf16(v[4], v[5]); w.w = cvt_pk_bf16(v[6], v[7]);
                *(u32x4*)(O + r * ldo + col0 + bj * HALF) = w; }
#pragma unroll
            for (int bj = 0; bj < 2; ++bj) { gw[bj] = gn[bj]; ow[bj] = on[bj]; }
            __builtin_amdgcn_sched_barrier(0); }
    }
};
struct EpiF32 {
    static constexpr bool PERM = false;
    float* O; int ldc;
    __device__ __forceinline__ void operator()(const f32x4 (&acc)[2][2][4][2], const Unit& u, int wr, int wc, int fr, int fq) const {
        const int row0 = u.pm * BM + wr * 64 + fr, col0 = u.pn * BM + wc * 32 + 4 * fq;
#pragma unroll
        for (int ai = 0; ai < 2; ++ai)
#pragma unroll
            for (int m = 0; m < 4; ++m) { float* rowp = O + (size_t)(row0 + ai * HALF + m * 16) * ldc + col0;
#pragma unroll
                for (int bj = 0; bj < 2; ++bj)
#pragma unroll
                    for (int n = 0; n < 2; ++n) *(f32x4*)(rowp + bj * HALF + n * 16) = acc[ai][bj][m][n]; }
    }
};
struct EpiSwiGLU {
    static constexpr bool PERM = true;
    bf16_t* O; int ldc;
    __device__ __forceinline__ void operator()(const f32x4 (&acc)[2][2][4][2], const Unit& u, int wr, int wc, int fr, int fq) const {
        const int row0 = u.pm * BM + wr * 64 + fr, col0 = u.pn * HALF + wc * 32 + 8 * fq;
#pragma unroll
        for (int ai = 0; ai < 2; ++ai)
#pragma unroll
            for (int m = 0; m < 4; ++m) { bf16_t* rowp = O + (size_t)(row0 + ai * HALF + m * 16) * ldc + col0;
                float v[8];
#pragma unroll
                for (int n = 0; n < 2; ++n)
#pragma unroll
                    for (int j = 0; j < 4; ++j) { const float g = acc[ai][0][m][n][j], up = acc[ai][1][m][n][j]; v[n * 4 + j] = g * sigmoidf_(g) * up; }
                u32x4 w; w.x = cvt_pk_bf16(v[0], v[1]); w.y = cvt_pk_bf16(v[2], v[3]); w.z = cvt_pk_bf16(v[4], v[5]); w.w = cvt_pk_bf16(v[6], v[7]);
                *(u32x4*)rowp = w; }
    }
};

template <class Epi, bool ALIGN_EPI>
__device__ __forceinline__ void gemm_phase(LAS unsigned char* lds, const Gemm g, const StaticOrder& S, const Epi& E, const int tid) {
    const int wid = __builtin_amdgcn_readfirstlane(tid >> 6), lane = tid & 63, wr = wid >> 2, wc = wid & 3, fr = lane & 15, fq = lane >> 4;
    const int K = g.K, nt = K / BK;
    unsigned voffA[2], voffB[2];
#pragma unroll
    for (int i = 0; i < 2; ++i) { int R, C; stage_rc(tid * 16 + i * 8192, R, C); const int Rb = Epi::PERM ? ((R & ~31) + perm32(R & 31)) : R;
        voffA[i] = (unsigned)(R * g.lda + C) * 2u; voffB[i] = (unsigned)(Rb * g.ldb + C) * 2u; }
    const size_t kstep = (size_t)(BK * 2);
    const size_t hstepA = (size_t)HALF * g.lda * 2, hstepB = (size_t)HALF * g.ldb * 2;
    const size_t tstepA = 2 * hstepA, tstepB = 2 * hstepB;
    const unsigned ldsw = (unsigned)wid * 1024u;
    const int aoff = lds_byte(wr * 64 + fr, fq * 8), boff = lds_byte(wc * 32 + fr, fq * 8);
#define PG8_SA(b, h) (((b) * 2 + (h)) * HTB)
#define PG8_SB(b, h) ((4 + (b) * 2 + (h)) * HTB)
#define PG8_STAGE(bufoff, gbase, voff) do { _Pragma("unroll") for (int _i = 0; _i < 2; ++_i) \
        __builtin_amdgcn_global_load_lds((const unsigned*)((const char*)(gbase) + (voff)[_i]), (LAS unsigned*)(lds + (bufoff) + ldsw + _i * 8192), 16, 0, 0); } while (0)
#define PG8_LDA(dst, b, h) do { _Pragma("unroll") for (int m = 0; m < 4; ++m) _Pragma("unroll") for (int k = 0; k < 2; ++k) dst[m][k] = *(const LAS bf16x8*)(lds + PG8_SA(b, h) + aoff + m * 2048 + k * 1024); } while (0)
#define PG8_LDB(dst, b, h) do { _Pragma("unroll") for (int n = 0; n < 2; ++n) _Pragma("unroll") for (int k = 0; k < 2; ++k) dst[n][k] = *(const LAS bf16x8*)(lds + PG8_SB(b, h) + boff + n * 2048 + k * 1024); } while (0)
#define PG8_MMA(ai, bj, At, Bt) do { __builtin_amdgcn_s_setprio(1); _Pragma("unroll") for (int m = 0; m < 4; ++m) _Pragma("unroll") for (int n = 0; n < 2; ++n) _Pragma("unroll") for (int k = 0; k < 2; ++k) \
        acc[ai][bj][m][n] = __builtin_amdgcn_mfma_f32_16x16x32_bf16(Bt[n][k], At[m][k], acc[ai][bj][m][n], 0, 0, 0); __builtin_amdgcn_s_setprio(0); } while (0)
#define PG8_WAIT_V(n) asm volatile("s_waitcnt vmcnt(" #n ")" ::: "memory")
#define PG8_WAIT_L(n) asm volatile("s_waitcnt lgkmcnt(" #n ")" ::: "memory")
#define PG8_BAR __builtin_amdgcn_s_barrier()
#define PG8_SCHED __builtin_amdgcn_sched_barrier(0)
#define PG8_AOFF(u_) ((size_t)(u_).pm * tstepA)
    Unit cur, nxt; int ui = 0;
    if (!S.next(0, cur)) return;
    f32x4 acc[2][2][4][2];
#pragma unroll
    for (int a = 0; a < 2; ++a)
#pragma unroll
        for (int b = 0; b < 2; ++b)
#pragma unroll
            for (int m = 0; m < 4; ++m)
#pragma unroll
                for (int n = 0; n < 2; ++n) acc[a][b][m][n] = (f32x4){0.f, 0.f, 0.f, 0.f};
    bf16x8 At[4][2], B0[2][2], B1[2][2];
    const char* cA = (const char*)g.A + PG8_AOFF(cur); const char* cB = (const char*)g.Bt + (size_t)cur.pn * tstepB;
    PG8_STAGE(PG8_SB(0, 0), cB, voffB); PG8_STAGE(PG8_SB(0, 1), cB + hstepB, voffB); PG8_STAGE(PG8_SA(0, 0), cA, voffA); PG8_STAGE(PG8_SA(0, 1), cA + hstepA, voffA);
    if (wr == 1) PG8_BAR;
    PG8_WAIT_V(2); PG8_BAR;
    PG8_STAGE(PG8_SB(1, 0), cB + kstep, voffB); PG8_STAGE(PG8_SA(1, 0), cA + kstep, voffA); PG8_STAGE(PG8_SB(1, 1), cB + hstepB + kstep, voffB);
    PG8_WAIT_V(6); PG8_BAR;
    for (;;) {
        const bool has_next = S.next(ui + 1, nxt);
        const char* nA = has_next ? (const char*)g.A + PG8_AOFF(nxt) : cA; const char* nB = has_next ? (const char*)g.Bt + (size_t)nxt.pn * tstepB : cB;
        for (int t = 0; t < nt; t += 2) {
            const bool last = (t == nt - 2);
            const char* a1 = cA + (size_t)(t + 1) * kstep;
            const char* a2 = last ? nA : cA + (size_t)(t + 2) * kstep; const char* b2 = last ? nB : cB + (size_t)(t + 2) * kstep;
            const char* a3 = a2 + kstep; const char* b3 = b2 + kstep;
            PG8_LDB(B0, 0, 0); PG8_LDB(B1, 0, 1); PG8_SCHED; PG8_LDA(At, 0, 0); PG8_STAGE(PG8_SA(1, 1), a1 + hstepA, voffA);
            PG8_WAIT_V(8); PG8_WAIT_L(0); PG8_BAR; PG8_MMA(0, 0, At, B0); PG8_MMA(0, 1, At, B1); PG8_BAR; PG8_SCHED;
            PG8_LDA(At, 0, 1); PG8_STAGE(PG8_SB(0, 0), b2, voffB); PG8_STAGE(PG8_SB(0, 1), b2 + hstepB, voffB); PG8_STAGE(PG8_SA(0, 0), a2, voffA);
            PG8_WAIT_V(8); PG8_WAIT_L(0); PG8_BAR; PG8_MMA(1, 0, At, B0); PG8_MMA(1, 1, At, B1); PG8_BAR; PG8_SCHED;
            PG8_LDB(B0, 1, 0); PG8_LDB(B1, 1, 1); PG8_SCHED; PG8_LDA(At, 1, 0); PG8_STAGE(PG8_SA(0, 1), a2 + hstepA, voffA);
            PG8_WAIT_V(8); PG8_WAIT_L(0); PG8_BAR; PG8_MMA(0, 0, At, B0); PG8_MMA(0, 1, At, B1); PG8_BAR; PG8_SCHED;
            PG8_LDA(At, 1, 1); PG8_STAGE(PG8_SB(1, 0), b3, voffB); PG8_STAGE(PG8_SB(1, 1), b3 + hstepB, voffB); PG8_STAGE(PG8_SA(1, 0), a3, voffA);
            PG8_WAIT_V(8); PG8_WAIT_L(0); PG8_BAR; PG8_MMA(1, 0, At, B0); PG8_MMA(1, 1, At, B1); PG8_BAR; PG8_SCHED;
        }
        if constexpr (ALIGN_EPI) { if (wr == 0) PG8_BAR; }
        E(acc, cur, wr, wc, fr, fq);
        if (!has_next) break;
#pragma unroll
        for (int a = 0; a < 2; ++a)
#pragma unroll
            for (int b = 0; b < 2; ++b)
#pragma unroll
                for (int m = 0; m < 4; ++m)
#pragma unroll
                    for (int n = 0; n < 2; ++n) acc[a][b][m][n] = (f32x4){0.f, 0.f, 0.f, 0.f};
        cur = nxt; cA = nA; cB = nB; ++ui;
        if constexpr (ALIGN_EPI) { if (wr == 1) PG8_BAR; }
    }
    PG8_WAIT_V(0);
    if constexpr (!ALIGN_EPI) { if (wr == 0) PG8_BAR; }
    PG8_BAR;
#undef PG8_SA
#undef PG8_SB
#undef PG8_STAGE
#undef PG8_LDA
#undef PG8_LDB
#undef PG8_MMA
#undef PG8_WAIT_V
#undef PG8_WAIT_L
#undef PG8_BAR
#undef PG8_SCHED
#undef PG8_AOFF
}
}

struct Args { const float* in[19]; float* out; unsigned char* ws; int ph_lo, ph_hi; };
enum { I_X = 0, I_REL, I_NORMG, I_WIN, I_CONVW, I_CONVB, I_LRUW, I_LRUB, I_LAM, I_CPOS, I_CW1, I_CW2, I_WA2, I_BA, I_GNORM, I_WBR, I_WOUT, I_WFI, I_WFO };
enum { PH_PRE = 0, PH_G1, PH_LCONV, PH_LGATE, PH_LSCAN, PH_G23, PH_CMP1, PH_CMP2, PH_SEL, PH_ATT, PH_GLA, PH_G4, PH_BR, PH_OUT, PH_RES1, PH_FI, PH_FO, PH_RES2, NPH };

typedef const Args __attribute__((address_space(4)))* ArgsP;
struct Ctx {
    ArgsP ap; float* out; unsigned char* ws; LAS unsigned char* lds; unsigned char* ldsg;
    int tid, lane, wave, G, bid, L;
    const float* xin;
};

template <int MODE> __device__ __forceinline__ int srccol(int n) {
    if (MODE == 0) return n;
    if (MODE == 1) { if (n < 2560) return 2048 + n; if (n < 2608) return 4608 + (n - 2560); if (n < 2624) return 7728 + (n - 2608); if (n < 2816) return -1; return 4656 + (n - 2816); }
    if (MODE == 2) return 7744 + n;
      { const int t = n >> 8, j = n & 255; return j < 128 ? t * 128 + j : DFF + t * 128 + (j - 128); }
}
template <int MODE> __device__ __forceinline__ void tr_item(const float* W, int ldw, bf16_t* WT, int ldd, int nblk, int item, LAS float* scr, int lane) {
    const int kb = item / nblk, nb = item % nblk, k0 = 64 * kb, n0 = 32 * nb;
    const int sc = srccol<MODE>(n0 + (lane & 31));
#pragma unroll 8
    for (int i = 0; i < 32; ++i) { const int kk = 2 * i + (lane >> 5); scr[kk * 33 + (lane & 31)] = sc >= 0 ? W[(size_t)(k0 + kk) * ldw + sc] : 0.f; }
    asm volatile("s_waitcnt lgkmcnt(0)" ::: "memory");
    const int c = lane & 7;
#pragma unroll
    for (int j = 0; j < 4; ++j) { const int n = (lane >> 3) + 8 * j; const LAS float* s = scr + (8 * c) * 33 + n;
        u32x4 o; o.x = pk2(s[0 * 33], s[1 * 33]); o.y = pk2(s[2 * 33], s[3 * 33]); o.z = pk2(s[4 * 33], s[5 * 33]); o.w = pk2(s[6 * 33], s[7 * 33]);
        *(u32x4*)(WT + (size_t)(n0 + n) * ldd + k0 + 8 * c) = o; }
    asm volatile("s_waitcnt lgkmcnt(0)" ::: "memory");
}
__device__ __forceinline__ void rms_row_to_bf16(const float* xrow, const float* g, bf16_t* orow, int lane) {
    const f32x4* xr = (const f32x4*)xrow + lane; const f32x4* gr = (const f32x4*)g + lane;
    f32x4 v[4]; float s = 0.f;
#pragma unroll
    for (int j = 0; j < 4; ++j) { v[j] = xr[64 * j]; s += (v[j].x * v[j].x + v[j].y * v[j].y) + (v[j].z * v[j].z + v[j].w * v[j].w); }
    const float rstd = __builtin_amdgcn_rsqf(wave_sum(s) * (1.f / ND) + EPS);
    unsigned long long* o8 = (unsigned long long*)orow + lane;
#pragma unroll
    for (int j = 0; j < 4; ++j) { const f32x4 gg = gr[64 * j]; o8[64 * j] = (unsigned long long)pk2(v[j].x * rstd * gg.x, v[j].y * rstd * gg.y) | ((unsigned long long)pk2(v[j].z * rstd * gg.z, v[j].w * rstd * gg.w) << 32); }
}
__device__ __forceinline__ void ph_pre(Ctx& F) {
    const int L = F.L;
    LAS float* scr = (LAS float*)(F.lds + F.wave * 16384);
    const int gw = F.bid * NWAVES + F.wave, NGW = F.G * NWAVES;
    const float* win = F.ap->in[I_WIN] + (size_t)L * ND * IN_W;
    constexpr int I_G1 = 64 * 16, I_G23 = 184 * 16, I_G4 = 96 * 16, I_BR1 = 32 * 16, I_OUT = 32 * 16, I_FI = 176 * 16, I_FO = 32 * 44;
    constexpr int NITEMS = I_G1 + I_G23 + I_G4 + 3 * I_BR1 + I_OUT + I_FI + I_FO;
    for (int it = gw; it < NITEMS; it += NGW) {
        int r = it;
        if (r < I_G1) { tr_item<0>(win, IN_W, (bf16_t*)(F.ws + W_G1), 1024, 64, r, scr, F.lane); continue; } r -= I_G1;
        if (r < I_G23) { tr_item<1>(win, IN_W, (bf16_t*)(F.ws + W_G23), 1024, 184, r, scr, F.lane); continue; } r -= I_G23;
        if (r < I_G4) { tr_item<2>(win, IN_W, (bf16_t*)(F.ws + W_G4), 1024, 96, r, scr, F.lane); continue; } r -= I_G4;
        if (r < 3 * I_BR1) { const int b = r / I_BR1; tr_item<0>(F.ap->in[I_WBR] + ((size_t)L * 3 + b) * ND * ND, ND, (bf16_t*)(F.ws + W_BR) + (size_t)b * ND * ND, 1024, 32, r % I_BR1, scr, F.lane); continue; } r -= 3 * I_BR1;
        if (r < I_OUT) { tr_item<0>(F.ap->in[I_WOUT] + (size_t)L * ND * ND, ND, (bf16_t*)(F.ws + W_OUT), 1024, 32, r, scr, F.lane); continue; } r -= I_OUT;
        if (r < I_FI) { tr_item<3>(F.ap->in[I_WFI] + (size_t)L * ND * 2 * DFF, 2 * DFF, (bf16_t*)(F.ws + W_FI), 1024, 176, r, scr, F.lane); continue; } r -= I_FI;
        tr_item<0>(F.ap->in[I_WFO] + (size_t)L * DFF * ND, ND, (bf16_t*)(F.ws + W_FO), DFF, 32, r, scr, F.lane);
    }
    {
        const float* lw = F.ap->in[I_LRUW] + (size_t)L * 2 * 8 * 128 * 128; bf16_t* wt = (bf16_t*)(F.ws + W_LRU);
        for (int it = F.bid * NTHR + F.tid; it < 2048 * 128; it += F.G * NTHR) {
            const int row = it >> 7, kc = (it & 127) * 8, blk = row >> 8, g2 = (row >> 7) & 1, e = row & 127;
            u32x4 o = (u32x4){0u, 0u, 0u, 0u};
            if ((kc >> 7) == blk) { const int c0 = kc & 127; const float* s = lw + ((size_t)(g2 * 8 + blk) * 128 + c0) * 128 + e;
                o.x = pk2(s[0], s[128]); o.y = pk2(s[256], s[384]); o.z = pk2(s[512], s[640]); o.w = pk2(s[768], s[896]); }
            *(u32x4*)(wt + (size_t)row * 1024 + kc) = o;
        }
    }
    {
        float* ctl = (float*)(F.ws + WS_CTL);
        const int gt = F.bid * NTHR + F.tid;
        if (gt < 1024) { const float lam = F.ap->in[I_LAM][L * 1024 + gt]; const float e = __expf(-lam); const float sp = e < 0.03f ? e * (1.f - e * (0.5f - e * (0.33333333f - 0.25f * e))) : __logf(1.f + e); ctl[CT_C8 + gt] = -8.f * sp; }
        else if (gt < 1024 + 2048) { const int i = gt - 1024, h = i >> 7, d = i & 127; ctl[CT_RB + i] = F.ap->in[I_REL][rel_bucket(d) * 16 + h]; }
    }
    const float* g0 = F.ap->in[I_NORMG] + (size_t)(L * 4 + 0) * ND; bf16_t* H = (bf16_t*)(F.ws + WS_H);
    for (int m = gw; m < NT; m += NGW) rms_row_to_bf16(F.xin + (size_t)m * ND, g0, H + (size_t)m * ND, F.lane);
}

__device__ __forceinline__ void ph_lconv(Ctx& F) {
    const int L = F.L;
    const bf16_t* XA = (const bf16_t*)(F.ws + WS_XA); bf16_t* XC = (bf16_t*)(F.ws + WS_XC);
    const float* cw = F.ap->in[I_CONVW] + (size_t)L * 4 * 1024; const float* cb = F.ap->in[I_CONVB] + (size_t)L * 1024;
    for (int idx = F.bid * NTHR + F.tid; idx < NT * 128; idx += F.G * NTHR) {
        const int t = idx >> 7, c8 = (idx & 127) * 8, s = t & (NS - 1);
        float acc[8];
#pragma unroll
        for (int i = 0; i < 8; ++i) acc[i] = cb[c8 + i];
#pragma unroll
        for (int j = 0; j < 4; ++j) { if (s - 3 + j >= 0) { const u32x4 w = *(const u32x4*)(XA + (size_t)(t - 3 + j) * 1024 + c8); const float* ww = cw + j * 1024 + c8;
                acc[0] += ww[0] * bflo(w.x); acc[1] += ww[1] * bfhi(w.x); acc[2] += ww[2] * bflo(w.y); acc[3] += ww[3] * bfhi(w.y);
                acc[4] += ww[4] * bflo(w.z); acc[5] += ww[5] * bfhi(w.z); acc[6] += ww[6] * bflo(w.w); acc[7] += ww[7] * bfhi(w.w); } }
        u32x4 o; o.x = pk2(acc[0], acc[1]); o.y = pk2(acc[2], acc[3]); o.z = pk2(acc[4], acc[5]); o.w = pk2(acc[6], acc[7]);
        *(u32x4*)(XC + (size_t)t * 1024 + c8) = o;
    }
}

__device__ __forceinline__ void ph_lscan(Ctx& F) {
    const bf16_t* LA = (const bf16_t*)(F.ws + WS_LA); const bf16_t* U = (const bf16_t*)(F.ws + WS_U); bf16_t* GA = (bf16_t*)(F.ws + WS_GA);
    LAS float* sA = (LAS float*)F.lds; LAS float* sH = sA + 32 * 32;
    const int chunk = F.tid >> 4, cl = F.tid & 15;
    for (int unit = F.bid; unit < NB_ * 32; unit += F.G) {
        const int b = unit >> 5, c = (unit & 31) * 32 + cl * 2;
        const size_t base = ((size_t)b * NS + chunk * 64) * 1024 + c;
        float s0 = 0.f, s1 = 0.f, h0 = 0.f, h1 = 0.f;
        for (int i = 0; i < 64; ++i) { const unsigned lw = *(const unsigned*)(LA + base + (size_t)i * 1024), uw = *(const unsigned*)(U + base + (size_t)i * 1024);
            const float l0 = bflo(lw), l1 = bfhi(lw); s0 += l0; s1 += l1; h0 = __expf(l0) * h0 + bflo(uw); h1 = __expf(l1) * h1 + bfhi(uw); }
        sA[chunk * 32 + cl * 2] = s0; sA[chunk * 32 + cl * 2 + 1] = s1; sH[chunk * 32 + cl * 2] = h0; sH[chunk * 32 + cl * 2 + 1] = h1;
        __syncthreads();
        h0 = 0.f; h1 = 0.f;
        for (int k = 0; k < chunk; ++k) { h0 = __expf(sA[k * 32 + cl * 2]) * h0 + sH[k * 32 + cl * 2]; h1 = __expf(sA[k * 32 + cl * 2 + 1]) * h1 + sH[k * 32 + cl * 2 + 1]; }
        for (int i = 0; i < 64; ++i) { const unsigned lw = *(const unsigned*)(LA + base + (size_t)i * 1024), uw = *(const unsigned*)(U + base + (size_t)i * 1024);
            h0 = __expf(bflo(lw)) * h0 + bflo(uw); h1 = __expf(bfhi(lw)) * h1 + bfhi(uw);
            unsigned* gp = (unsigned*)(GA + base + (size_t)i * 1024); const unsigned gw = *gp;
            *gp = pk2(h0 * gelu_tanh(bflo(gw)), h1 * gelu_tanh(bfhi(gw))); }
        __syncthreads();
    }
}

__device__ __forceinline__ void ph_cmp1(Ctx& F) {
    const int L = F.L;
    const bf16_t* NBp = (const bf16_t*)(F.ws + WS_NB); float* HID = (float*)(F.ws + WS_HID);
    for (int it = F.bid * NTHR + F.tid; it < 2 * 32 * 32 * 256; it += F.G * NTHR) {
        const int n = it & 255, cq = (it >> 8) & 31, bg = (it >> 13) & 31, kv = it >> 18, b = bg >> 2, g = bg & 3;
        const float* w1 = F.ap->in[I_CW1] + ((size_t)(L * 2 + kv) * 2048) * 256 + n;
        const float* pos = F.ap->in[I_CPOS] + (size_t)(L * 2 + kv) * 2048;
        const bf16_t* src = NBp + (size_t)b * NS * LD_NB + 1024 + kv * 256 + g * 64;
        float acc[4] = {0.f, 0.f, 0.f, 0.f};
        for (int tk = 0; tk < 80; ++tk) { const int tok = 64 * cq + tk; if (tok >= NS) break;
            for (int d = 0; d < 64; ++d) { const float x = bf1(src[(size_t)tok * LD_NB + d]);
#pragma unroll
                for (int i = 0; i < 4; ++i) { const int kk = tk - 16 * i; if (kk >= 0 && kk < 32) { const int k = kk * 64 + d; acc[i] += (x + pos[k]) * w1[(size_t)k * 256]; } } } }
#pragma unroll
        for (int i = 0; i < 4; ++i) { const int c = 4 * cq + i; HID[((size_t)(kv * 32 + bg) * 128 + c) * 256 + n] = gelu_tanh(acc[i]); }
    }
}
__device__ __forceinline__ void ph_cmp2(Ctx& F) {
    const int L = F.L;
    const float* HID = (const float*)(F.ws + WS_HID); bf16_t* KC = (bf16_t*)(F.ws + WS_KC);
    for (int it = F.bid * NTHR + F.tid; it < 2 * 32 * 128 * 64; it += F.G * NTHR) {
        const int d = it & 63, c = (it >> 6) & 127, kvbg = it >> 13, kv = kvbg >> 5;
        const float* w2 = F.ap->in[I_CW2] + (size_t)(L * 2 + kv) * 256 * 64 + d; const float* h = HID + ((size_t)kvbg * 128 + c) * 256;
        float acc = 0.f;
        if (c < 127) for (int n = 0; n < 256; ++n) acc += h[n] * w2[n * 64];
        KC[it] = (bf16_t)f2bf(acc);
    }
}
__device__ __forceinline__ void ph_sel(Ctx& F) {
    const bf16_t* NBp = (const bf16_t*)(F.ws + WS_NB); const bf16_t* KC = (const bf16_t*)(F.ws + WS_KC); unsigned* SEL = (unsigned*)(F.ws + WS_SEL);
    const float* RB = (const float*)(F.ws + WS_CTL) + CT_RB;
    LAS float* imp = (LAS float*)F.lds;
    for (int unit = F.bid; unit < 32 * 4; unit += F.G) {
        const int bg = unit >> 2, b = bg >> 2, g = bg & 3, s = (unit & 3) * 512 + F.tid;
        const int nvalid = s >= 31 ? ((s - 31) >> 4) + 1 : 0;
        const bf16_t* kc = KC + (size_t)bg * 128 * 64;
#pragma unroll 1
        for (int j = 0; j < 32; ++j) imp[j * 512 + F.tid] = 0.f;
#pragma unroll 1
        for (int r = 0; r < 4; ++r) {
            const int h = g * 4 + r; const bf16_t* qp = NBp + ((size_t)b * NS + s) * LD_NB + h * 64;
            unsigned qw[32];
#pragma unroll
            for (int i = 0; i < 8; ++i) { const u32x4 w = *(const u32x4*)(qp + 8 * i); qw[4 * i] = w.x; qw[4 * i + 1] = w.y; qw[4 * i + 2] = w.z; qw[4 * i + 3] = w.w; }
            const float* rb = RB + h * 128;
            float mx = -1e30f, l = 0.f;
#pragma unroll 1
            for (int c = 0; c < 127; ++c) { const unsigned* kr = (const unsigned*)(kc + c * 64); float dot = 0.f;
#pragma unroll
                for (int i = 0; i < 32; ++i) { const unsigned kw = kr[i]; dot += bflo(qw[i]) * bflo(kw) + bfhi(qw[i]) * bfhi(kw); }
                if (c < nvalid) { const int dist = s - 16 * c - 31; const float lg = dot + rb[dist < 127 ? dist : 127];
                    const float mn = fmaxf(mx, lg); l = l * __expf(mx - mn) + __expf(lg - mn); mx = mn; } }
            const float inv = nvalid > 0 ? __builtin_amdgcn_rcpf(l) : 0.f;
#pragma unroll 1
            for (int c = 0; c < 127; ++c) { const unsigned* kr = (const unsigned*)(kc + c * 64); float dot = 0.f;
#pragma unroll
                for (int i = 0; i < 32; ++i) { const unsigned kw = kr[i]; dot += bflo(qw[i]) * bflo(kw) + bfhi(qw[i]) * bfhi(kw); }
                if (c < nvalid) { const int dist = s - 16 * c - 31; const float p = __expf(dot + rb[dist < 127 ? dist : 127] - mx) * inv;
                    const int j = c >> 2, cm = c & 3;
                    if (cm == 3) { imp[j * 512 + F.tid] += 0.5f * p; if (j + 1 < 32) imp[(j + 1) * 512 + F.tid] += 0.5f * p; }
                    else imp[j * 512 + F.tid] += p; } }
        }
        const int cur = s >> 6; unsigned mask;
        if (cur <= 7) mask = (2u << cur) - 1u;
        else { mask = 1u | (1u << cur) | (1u << (cur - 1));
#pragma unroll 1
            for (int k = 0; k < 5; ++k) { float best = -1.f; int bj = 1;
#pragma unroll 1
                for (int j = 1; j <= cur - 2; ++j) { const float v = imp[j * 512 + F.tid]; if (!((mask >> j) & 1u) && v > best) { best = v; bj = j; } }
                mask |= 1u << bj; } }
        SEL[(size_t)bg * NS + s] = mask;
    }
}
#define ATT_KEY(KROW, VROW, ACTIVE, DIST) do { const u32x4* kr_ = (const u32x4*)(KROW); float dot_ = 0.f; \
        _Pragma("unroll") for (int c_ = 0; c_ < 4; ++c_) { const u32x4 ka_ = kr_[2 * c_], kb_ = kr_[2 * c_ + 1]; \
            dot_ += bflo(qw[8 * c_]) * bflo(ka_.x) + bfhi(qw[8 * c_]) * bfhi(ka_.x) + bflo(qw[8 * c_ + 1]) * bflo(ka_.y) + bfhi(qw[8 * c_ + 1]) * bfhi(ka_.y) \
                  + bflo(qw[8 * c_ + 2]) * bflo(ka_.z) + bfhi(qw[8 * c_ + 2]) * bfhi(ka_.z) + bflo(qw[8 * c_ + 3]) * bflo(ka_.w) + bfhi(qw[8 * c_ + 3]) * bfhi(ka_.w) \
                  + bflo(qw[8 * c_ + 4]) * bflo(kb_.x) + bfhi(qw[8 * c_ + 4]) * bfhi(kb_.x) + bflo(qw[8 * c_ + 5]) * bflo(kb_.y) + bfhi(qw[8 * c_ + 5]) * bfhi(kb_.y) \
                  + bflo(qw[8 * c_ + 6]) * bflo(kb_.z) + bfhi(qw[8 * c_ + 6]) * bfhi(kb_.z) + bflo(qw[8 * c_ + 7]) * bflo(kb_.w) + bfhi(qw[8 * c_ + 7]) * bfhi(kb_.w); \
            __builtin_amdgcn_sched_barrier(0); } \
        if (ACTIVE) { const int dd_ = (DIST); const float lg_ = dot_ + rb[dd_ < 127 ? dd_ : 127]; const float mn_ = fmaxf(mx, lg_), sc_ = __expf(mx - mn_), p_ = __expf(lg_ - mn_); mx = mn_; l = l * sc_ + p_; \
            const u32x4* vr_ = (const u32x4*)(VROW); \
            _Pragma("unroll") for (int c_ = 0; c_ < 8; ++c_) { const u32x4 vv_ = vr_[c_]; \
                o[8 * c_] = o[8 * c_] * sc_ + p_ * bflo(vv_.x); o[8 * c_ + 1] = o[8 * c_ + 1] * sc_ + p_ * bfhi(vv_.x); o[8 * c_ + 2] = o[8 * c_ + 2] * sc_ + p_ * bflo(vv_.y); o[8 * c_ + 3] = o[8 * c_ + 3] * sc_ + p_ * bfhi(vv_.y); \
                o[8 * c_ + 4] = o[8 * c_ + 4] * sc_ + p_ * bflo(vv_.z); o[8 * c_ + 5] = o[8 * c_ + 5] * sc_ + p_ * bfhi(vv_.z); o[8 * c_ + 6] = o[8 * c_ + 6] * sc_ + p_ * bflo(vv_.w); o[8 * c_ + 7] = o[8 * c_ + 7] * sc_ + p_ * bfhi(vv_.w); \
                if (c_ & 1) __builtin_amdgcn_sched_barrier(0); } } } while (0)
__device__ __forceinline__ void ph_att(Ctx& F) {
    bf16_t* NBp = (bf16_t*)(F.ws + WS_NB); const bf16_t* KC = (const bf16_t*)(F.ws + WS_KC); const unsigned* SEL = (const unsigned*)(F.ws + WS_SEL);
    const float* RB = (const float*)(F.ws + WS_CTL) + CT_RB;
    for (int unit = F.bid; unit < NB_ * 16 * 4; unit += F.G) {
        const int sb = unit & 3, h = (unit >> 2) & 15, b = unit >> 6, g = h >> 2, bg = b * 4 + g;
        const int s = sb * 512 + F.tid, sw0 = sb * 512 + F.wave * 64;
        bf16_t* qp = NBp + ((size_t)b * NS + s) * LD_NB + h * 64;
        unsigned qw[32];
#pragma unroll
        for (int i = 0; i < 8; ++i) { const u32x4 w = *(const u32x4*)(qp + 8 * i); qw[4 * i] = w.x; qw[4 * i + 1] = w.y; qw[4 * i + 2] = w.z; qw[4 * i + 3] = w.w; }
        const bf16_t* gp = NBp + ((size_t)b * NS + s) * LD_NB + 2560 + h;
        const float g0 = sigmoidf_(bf1(gp[0])), g1 = sigmoidf_(bf1(gp[16])), g2 = sigmoidf_(bf1(gp[32]));
        const float* rb = RB + h * 128;
        float o[64]; LAS float* y = (LAS float*)F.lds + F.tid;
#pragma unroll
        for (int i = 0; i < 64; ++i) { y[i * 512] = 0.f; o[i] = 0.f; }
        float mx = -1e30f, l = 0.f;
        { const int nvalid = s >= 31 ? ((s - 31) >> 4) + 1 : 0; const bf16_t* kc = KC + (size_t)bg * 128 * 64; const bf16_t* vc = KC + (size_t)(32 + bg) * 128 * 64;
#pragma unroll 1
            for (int c = 0; c < 127; ++c) ATT_KEY(kc + c * 64, vc + c * 64, c < nvalid, s - 16 * c - 31);
            const float sc = l > 0.f ? g0 * __builtin_amdgcn_rcpf(l) : 0.f;
#pragma unroll
            for (int i = 0; i < 64; ++i) { y[i * 512] += sc * o[i]; o[i] = 0.f; }
            mx = -1e30f; l = 0.f; }
        const bf16_t* kvb = NBp + (size_t)b * NS * LD_NB + 1024 + g * 64;
        { const unsigned mask = SEL[(size_t)bg * NS + s];
#pragma unroll 1
            for (int j = 0; j < 32; ++j) { const bool bit = (mask >> j) & 1u; if (!__any(bit)) continue;
#pragma unroll 1
                for (int i = 0; i < 64; ++i) { const int tk = 64 * j + i; const bf16_t* row = kvb + (size_t)tk * LD_NB; ATT_KEY(row + 2 * 256, row + 3 * 256, bit && tk <= s, s - tk); } }
            const float sc = l > 0.f ? g1 * __builtin_amdgcn_rcpf(l) : 0.f;
#pragma unroll
            for (int i = 0; i < 64; ++i) { y[i * 512] += sc * o[i]; o[i] = 0.f; }
            mx = -1e30f; l = 0.f; }
        { const int t0 = sw0 - 255 > 0 ? sw0 - 255 : 0, t1 = sw0 + 63;
#pragma unroll 1
            for (int tk = t0; tk <= t1; ++tk) { const bf16_t* row = kvb + (size_t)tk * LD_NB; ATT_KEY(row + 4 * 256, row + 5 * 256, tk <= s && s - tk < 256, s - tk); }
            const float sc = l > 0.f ? g2 * __builtin_amdgcn_rcpf(l) : 0.f;
#pragma unroll
            for (int i = 0; i < 64; ++i) y[i * 512] += sc * o[i]; }
#pragma unroll
        for (int i = 0; i < 8; ++i) { u32x4 w; w.x = pk2(y[(8 * i) * 512], y[(8 * i + 1) * 512]); w.y = pk2(y[(8 * i + 2) * 512], y[(8 * i + 3) * 512]); w.z = pk2(y[(8 * i + 4) * 512], y[(8 * i + 5) * 512]); w.w = pk2(y[(8 * i + 6) * 512], y[(8 * i + 7) * 512]); *(u32x4*)(qp + 8 * i) = w; }
    }
}

__device__ __forceinline__ void ph_gla(Ctx& F) {
    const int L = F.L;
    const bf16_t* NBp = (const bf16_t*)(F.ws + WS_NB); bf16_t* GB = (bf16_t*)(F.ws + WS_GB);
    LAS float* sq = (LAS float*)F.lds; LAS float* sk = sq + 128; LAS float* sa = sk + 128; LAS float* so = sa + 128; LAS float* sss = so + 1024;
    const int e = F.tid & 255, half = F.tid >> 8;
    for (int unit = F.bid; unit < 32; unit += F.G) {
        const int b = unit >> 2, h = unit & 3;
        float S[64];
#pragma unroll
        for (int i = 0; i < 64; ++i) S[i] = 0.f;
        float wa[16]; float ba = 0.f;
        if (F.tid < 128) { const float* w = F.ap->in[I_WA2] + (size_t)L * 16 * 512 + h * 128 + F.tid;
#pragma unroll
            for (int r = 0; r < 16; ++r) wa[r] = w[r * 512];
            ba = F.ap->in[I_BA][L * 512 + h * 128 + F.tid]; }
        const float gn = F.ap->in[I_GNORM][L * 256 + e];
#pragma unroll 1
        for (int s = 0; s < NS; ++s) {
            const size_t t = (size_t)b * NS + s; bf16_t* row = GB + t * LD_GB;
            if (F.tid < 128) { const bf16_t* lr = NBp + t * LD_NB + 2608; float z = ba;
#pragma unroll
                for (int r = 0; r < 16; ++r) z += bf1(lr[r]) * wa[r];
                const float ls = (z < 0.f ? z : 0.f) - __logf(1.f + __expf(-fabsf(z)));
                sa[F.tid] = __expf(ls * (1.f / 16.f)); sq[F.tid] = bf1(row[h * 128 + F.tid]) * 0.08838834764831845f; sk[F.tid] = bf1(row[512 + h * 128 + F.tid]); }
            __syncthreads();
            const float v = bf1(row[1024 + h * 256 + e]); float acc = 0.f;
#pragma unroll
            for (int i = 0; i < 64; ++i) { const int dk = half * 64 + i; S[i] = sa[dk] * S[i] + sk[dk] * v; acc += sq[dk] * S[i]; }
            so[(s & 1) * 512 + half * 256 + e] = acc;
            __syncthreads();
            if (F.tid < 256) { const float ov = so[(s & 1) * 512 + e] + so[(s & 1) * 512 + 256 + e]; const float ss = wave_sum(ov * ov);
                if (F.lane == 0) sss[(s & 1) * 4 + F.wave] = ss;
                acc = ov; }
            __syncthreads();
            if (F.tid < 256) { const float tot = sss[(s & 1) * 4] + sss[(s & 1) * 4 + 1] + sss[(s & 1) * 4 + 2] + sss[(s & 1) * 4 + 3];
                bf16_t* op = row + 2048 + h * 256 + e; const float og = bf1(*op);
                *op = (bf16_t)f2bf(acc * __builtin_amdgcn_rsqf(tot * (1.f / 256.f) + EPS) * gn * (og * sigmoidf_(og))); }
        }
        __syncthreads();
    }
}

template <bool WITH_H> __device__ __forceinline__ void ph_res(Ctx& F, const float* xsrc, const float* gz, const float* gh) {
    const float* Z = (const float*)(F.ws + WS_XA); bf16_t* H = (bf16_t*)(F.ws + WS_H); float* out = F.out;
    const int gw = F.bid * NWAVES + F.wave, NGW = F.G * NWAVES;
    for (int m = gw; m < NT; m += NGW) {
        const f32x4* zr = (const f32x4*)(Z + (size_t)m * ND) + F.lane; const f32x4* xr = (const f32x4*)(xsrc + (size_t)m * ND) + F.lane;
        f32x4 z[4], x[4]; float s = 0.f;
#pragma unroll
        for (int j = 0; j < 4; ++j) { z[j] = zr[64 * j]; x[j] = xr[64 * j]; s += (z[j].x * z[j].x + z[j].y * z[j].y) + (z[j].z * z[j].z + z[j].w * z[j].w); }
        const float rstd = __builtin_amdgcn_rsqf(wave_sum(s) * (1.f / ND) + EPS); float s2 = 0.f;
#pragma unroll
        for (int j = 0; j < 4; ++j) { const f32x4 gg = ((const f32x4*)gz + F.lane)[64 * j]; x[j] = x[j] + z[j] * rstd * gg; ((f32x4*)(out + (size_t)m * ND) + F.lane)[64 * j] = x[j];
            s2 += (x[j].x * x[j].x + x[j].y * x[j].y) + (x[j].z * x[j].z + x[j].w * x[j].w); }
        if (WITH_H) { const float r2 = __builtin_amdgcn_rsqf(wave_sum(s2) * (1.f / ND) + EPS); unsigned long long* o8 = (unsigned long long*)(H + (size_t)m * ND) + F.lane;
#pragma unroll
            for (int j = 0; j < 4; ++j) { const f32x4 gg = ((const f32x4*)gh + F.lane)[64 * j];
                o8[64 * j] = (unsigned long long)pk2(x[j].x * r2 * gg.x, x[j].y * r2 * gg.y) | ((unsigned long long)pk2(x[j].z * r2 * gg.z, x[j].w * r2 * gg.w) << 32); } }
    }
}

template <int p> __device__ __forceinline__ void run_phase(Ctx& F, const int L) {
    using namespace pg8;
    unsigned char* ws = F.ws;
        F.L = L; F.xin = (L == 0) ? F.ap->in[I_X] : F.out;
        const float* ng = F.ap->in[I_NORMG] + (size_t)L * 4 * ND;
        StaticOrder S;
        switch (p) {
        case PH_PRE: if constexpr (PH_ON(PH_PRE)) { ph_pre(F); } break;
        case PH_G1: if constexpr (PH_ON(PH_G1)) { { Gemm g{(const bf16_t*)(ws + WS_H), (const bf16_t*)(ws + W_G1), 1024, 1024, 1024, 0}; S.init(64, 8, F.G, F.bid);
            EpiStore<0> E{{(bf16_t*)(ws + WS_XA), 1024, 0}, {(bf16_t*)(ws + WS_GA), 1024, 4}, {nullptr, 0, 0}, 4, 1 << 30, 0, 1.f};
            gemm_phase<EpiStore<0>, true>(F.lds, g, S, E, F.tid); } } break;
        case PH_LCONV: if constexpr (PH_ON(PH_LCONV)) { ph_lconv(F); } break;
        case PH_LGATE: if constexpr (PH_ON(PH_LGATE)) { { Gemm g{(const bf16_t*)(ws + WS_XC), (const bf16_t*)(ws + W_LRU), 1024, 1024, 1024, 0}; S.init(64, 8, F.G, F.bid);
            EpiLru E{(const bf16_t*)(ws + WS_XC), (bf16_t*)(ws + WS_LA), (bf16_t*)(ws + WS_U), F.ap->in[I_LRUB] + (size_t)L * 2048, (const float*)(ws + WS_CTL) + CT_C8};
            gemm_phase<EpiLru, true>(F.lds, g, S, E, F.tid); } } break;
        case PH_LSCAN: if constexpr (PH_ON(PH_LSCAN)) { ph_lscan(F); } break;
        case PH_G23: if constexpr (PH_ON(PH_G23)) { { Gemm g{(const bf16_t*)(ws + WS_H), (const bf16_t*)(ws + W_G23), 1024, 1024, 1024, 0}; S.init(64, 23, F.G, F.bid);
            EpiStore<0> E{{(bf16_t*)(ws + WS_NB), LD_NB, 0}, {(bf16_t*)(ws + WS_GB), LD_GB, 11}, {nullptr, 0, 0}, 11, 1 << 30, 4, 0.125f};
            gemm_phase<EpiStore<0>, true>(F.lds, g, S, E, F.tid); } } break;
        case PH_CMP1: if constexpr (PH_ON(PH_CMP1)) { ph_cmp1(F); } break;
        case PH_CMP2: if constexpr (PH_ON(PH_CMP2)) { ph_cmp2(F); } break;
        case PH_SEL: if constexpr (PH_ON(PH_SEL)) { ph_sel(F); } break;
        case PH_ATT: if constexpr (PH_ON(PH_ATT)) { ph_att(F); } break;
        case PH_GLA: if constexpr (PH_ON(PH_GLA)) { ph_gla(F); } break;
        case PH_G4: if constexpr (PH_ON(PH_G4)) { { Gemm g{(const bf16_t*)(ws + WS_H), (const bf16_t*)(ws + W_G4), 1024, 1024, 1024, 0}; S.init(64, 12, F.G, F.bid);
            EpiStore<2> E{{(bf16_t*)(ws + WS_XA), 1024, 0}, {(bf16_t*)(ws + WS_NB) + 1024, LD_NB, 4}, {(bf16_t*)(ws + WS_GB), LD_GB, 8}, 4, 8, 0, 1.f};
            gemm_phase<EpiStore<2>, true>(F.lds, g, S, E, F.tid); } } break;
        case PH_BR: if constexpr (PH_ON(PH_BR)) { { S.init(64, 4, F.G, F.bid); bf16_t* MO = (bf16_t*)(ws + WS_GB) + 1024;
            { Gemm g{(const bf16_t*)(ws + WS_GA), (const bf16_t*)(ws + W_BR), 1024, 1024, 1024, 0}; EpiBranch<true> E{(const bf16_t*)(ws + WS_XA), 1024, MO, LD_GB}; gemm_phase<EpiBranch<true>, false>(F.lds, g, S, E, F.tid); }
            { Gemm g{(const bf16_t*)(ws + WS_NB), (const bf16_t*)(ws + W_BR) + (size_t)ND * ND, LD_NB, 1024, 1024, 0}; EpiBranch<false> E{(const bf16_t*)(ws + WS_NB) + 1024, LD_NB, MO, LD_GB}; gemm_phase<EpiBranch<false>, false>(F.lds, g, S, E, F.tid); }
            { Gemm g{(const bf16_t*)(ws + WS_GB) + 2048, (const bf16_t*)(ws + W_BR) + (size_t)2 * ND * ND, LD_GB, 1024, 1024, 0}; EpiBranch<false> E{(const bf16_t*)(ws + WS_GB), LD_GB, MO, LD_GB}; gemm_phase<EpiBranch<false>, false>(F.lds, g, S, E, F.tid); } } } break;
        case PH_OUT: if constexpr (PH_ON(PH_OUT)) { { Gemm g{(const bf16_t*)(ws + WS_GB) + 1024, (const bf16_t*)(ws + W_OUT), LD_GB, 1024, 1024, 0}; S.init(64, 4, F.G, F.bid);
            EpiF32 E{(float*)(ws + WS_XA), 1024}; gemm_phase<EpiF32, false>(F.lds, g, S, E, F.tid); } } break;
        case PH_RES1: if constexpr (PH_ON(PH_RES1)) { ph_res<true>(F, F.xin, ng + 1 * ND, ng + 2 * ND); } break;
        case PH_FI: if constexpr (PH_ON(PH_FI)) { { Gemm g{(const bf16_t*)(ws + WS_H), (const bf16_t*)(ws + W_FI), 1024, 1024, 1024, 0}; S.init(64, 22, F.G, F.bid);
            EpiSwiGLU E{(bf16_t*)(ws + WS_NB), DFF}; gemm_phase<EpiSwiGLU, true>(F.lds, g, S, E, F.tid); } } break;
        case PH_FO: if constexpr (PH_ON(PH_FO)) { { Gemm g{(const bf16_t*)(ws + WS_NB), (const bf16_t*)(ws + W_FO), DFF, DFF, DFF, 0}; S.init(64, 4, F.G, F.bid);
            EpiF32 E{(float*)(ws + WS_XA), 1024}; gemm_phase<EpiF32, false>(F.lds, g, S, E, F.tid); } } break;
        case PH_RES2: if constexpr (PH_ON(PH_RES2)) { ph_res<false>(F, F.out, ng + 3 * ND, nullptr); } break;
        }
}
constexpr int LDS_BYTES = 147456;
template <bool COOP> __global__ void __launch_bounds__(NTHR, 2) mk_fwd(Args args) {
    extern __shared__ __attribute__((aligned(16))) unsigned char lds_raw[];
    Ctx F; F.lds = (LAS unsigned char*)lds_raw; F.ldsg = lds_raw;
    F.tid = threadIdx.x; F.lane = F.tid & 63; F.wave = __builtin_amdgcn_readfirstlane(F.tid >> 6); F.G = gridDim.x; F.bid = blockIdx.x;
    const int lo = args.ph_lo, hi = args.ph_hi;
#define MK_PHASE(L_, P_) if (lo <= (L_) * NPH + (P_) && (L_) * NPH + (P_) < hi) { \
        { int bid_ = blockIdx.x; asm volatile("" : "+s"(bid_)); F.bid = bid_; \
          int tid_ = threadIdx.x; asm volatile("" : "+v"(tid_)); F.tid = tid_; F.lane = tid_ & 63; F.wave = __builtin_amdgcn_readfirstlane(tid_ >> 6); \
          unsigned long long apl_ = (unsigned long long)__builtin_amdgcn_kernarg_segment_ptr(); asm volatile("" : "+s"(apl_)); F.ap = (ArgsP)apl_; \
          F.ws = F.ap->ws; F.out = F.ap->out; F.G = gridDim.x; } \
        run_phase<P_>(F, L_); \
        if (COOP) { if ((L_) * NPH + (P_) + 1 < hi) cg::this_grid().sync(); } }
#define MK_LAYER(L_) MK_PHASE(L_, 0) MK_PHASE(L_, 1) MK_PHASE(L_, 2) MK_PHASE(L_, 3) MK_PHASE(L_, 4) MK_PHASE(L_, 5) MK_PHASE(L_, 6) MK_PHASE(L_, 7) MK_PHASE(L_, 8) \
        MK_PHASE(L_, 9) MK_PHASE(L_, 10) MK_PHASE(L_, 11) MK_PHASE(L_, 12) MK_PHASE(L_, 13) MK_PHASE(L_, 14) MK_PHASE(L_, 15) MK_PHASE(L_, 16) MK_PHASE(L_, 17)
    MK_LAYER(0)
    MK_LAYER(1)
}

extern "C" void kernel_launch(void* const* d_in, const int* in_sizes, int n_in, void* d_out, int out_size, void* d_ws, size_t ws_size, hipStream_t stream) {
    static int grid = 0;
    if (grid == 0) {
        if (n_in != 19 || out_size != NT * ND || ws_size < WS_END) { fprintf(stderr, "kernel_launch: unexpected shapes/workspace (n_in %d out %d ws %zu need %zu)\n", n_in, out_size, ws_size, (size_t)WS_END); grid = -1; return; }
        int dev = 0, cus = 0, per_cu = 0;
        hipGetDevice(&dev); hipDeviceGetAttribute(&cus, hipDeviceAttributeMultiprocessorCount, dev);
        hipFuncSetAttribute((const void*)mk_fwd<true>, hipFuncAttributeMaxDynamicSharedMemorySize, LDS_BYTES);
        hipFuncSetAttribute((const void*)mk_fwd<false>, hipFuncAttributeMaxDynamicSharedMemorySize, LDS_BYTES);
        hipOccupancyMaxActiveBlocksPerMultiprocessor(&per_cu, (const void*)mk_fwd<true>, NTHR, LDS_BYTES);
        if (per_cu < 1) { fprintf(stderr, "kernel_launch: occupancy query says %d blocks/CU\n", per_cu); per_cu = 1; }
        (void)hipGetLastError();
        grid = cus;
    }
    if (grid < 0) return;
    Args a{};
    for (int i = 0; i < 19; ++i) a.in[i] = (const float*)d_in[i];
    a.out = (float*)d_out; a.ws = (unsigned char*)d_ws;
#if MK_COOP
    a.ph_lo = 0; a.ph_hi = 2 * NPH;
    void* kargs[] = {&a};
    hipError_t e = hipLaunchCooperativeKernel((const void*)mk_fwd<true>, dim3(grid), dim3(NTHR), kargs, LDS_BYTES, stream);
    if (e != hipSuccess) fprintf(stderr, "cooperative launch failed: %s (grid %d)\n", hipGetErrorString(e), grid);
#else
    for (int ph = 0; ph < 2 * NPH; ++ph) {
        a.ph_lo = ph; a.ph_hi = ph + 1;
        hipLaunchKernelGGL(mk_fwd<false>, dim3(grid), dim3(NTHR), LDS_BYTES, stream, a);
    }
#endif
}
```

```cpp
#include <hip/hip_runtime.h>
#include <hip/hip_cooperative_groups.h>
#include <cstdio>
#include <cstdint>
namespace cg = cooperative_groups;

#ifndef MK_COOP
#define MK_COOP 1
#endif
#ifndef MK_NAIVE_ATT
#define MK_NAIVE_ATT 0
#endif
#ifndef MK_NAIVE_GLA
#define MK_NAIVE_GLA 0
#endif
#ifndef MK_PM
#define MK_PM 0xFFFFFFFFu
#endif
#define PH_ON(p) (((MK_PM) >> (p)) & 1u)

#define LAS __attribute__((address_space(3)))
typedef unsigned short bf16_t;
typedef short bf16x8 __attribute__((ext_vector_type(8)));
typedef float f32x4 __attribute__((ext_vector_type(4)));
typedef float f32x2 __attribute__((ext_vector_type(2)));
typedef unsigned u32x4 __attribute__((ext_vector_type(4)));
typedef unsigned u32x2 __attribute__((ext_vector_type(2)));

constexpr int NB_ = 8, NS = 2048, ND = 1024, NT = NB_ * NS;
constexpr int IN_W = 10816, DFF = 2816;
constexpr int LD_NB = 2816, LD_GB = 3072;
constexpr float EPS = 1e-6f;
constexpr int NTHR = 512, NWAVES = 8;

constexpr size_t MiB = 1u << 20;
constexpr size_t WS_CTL = 0;
constexpr size_t WS_W = 1 * MiB;
constexpr size_t W_G1 = WS_W;
constexpr size_t W_G23 = W_G1 + 4 * MiB;
constexpr size_t W_G4 = W_G23 + 5888ull * 1024 * 2;
constexpr size_t W_LRU = W_G4 + 6 * MiB;
constexpr size_t W_BR = W_LRU + 4 * MiB;
constexpr size_t W_OUT = W_BR + 6 * MiB;
constexpr size_t W_FI = W_OUT + 2 * MiB;
constexpr size_t W_FO = W_FI + 11 * MiB;
constexpr size_t W_C1 = W_FO + 1024ull * 2816 * 2;
constexpr size_t W_END = W_C1 + 2 * MiB;
constexpr size_t WS_H = 54 * MiB;
constexpr size_t WS_XA = 86 * MiB;
constexpr size_t WS_GA = 118 * MiB;
constexpr size_t WS_NB = 150 * MiB;
constexpr size_t WS_GB = 238 * MiB;
constexpr size_t WS_END = 334 * MiB;
static_assert(W_END <= WS_H, "weights region");
constexpr size_t WS_XC = WS_NB, WS_LA = WS_NB + 32 * MiB, WS_U = WS_NB + 64 * MiB;
constexpr size_t WS_HID = WS_XA;
constexpr size_t WS_KC = WS_XA + 8 * MiB;
constexpr size_t WS_SEL = WS_XA + 10 * MiB;
constexpr int CT_C8 = 0;
constexpr int CT_RB = 1024;
constexpr int CT_C1 = 4096;

__device__ __forceinline__ unsigned f2bf(float f) { unsigned u = __float_as_uint(f); return (u + 0x7fffu + ((u >> 16) & 1u)) >> 16; }
__device__ __forceinline__ unsigned pk2(float lo, float hi) { return f2bf(lo) | (f2bf(hi) << 16); }
__device__ __forceinline__ float bflo(unsigned w) { return __uint_as_float(w << 16); }
__device__ __forceinline__ float bfhi(unsigned w) { return __uint_as_float(w & 0xffff0000u); }
__device__ __forceinline__ float bf1(bf16_t h) { return __uint_as_float((unsigned)h << 16); }
__device__ __forceinline__ float sigmoidf_(float x) { return __builtin_amdgcn_rcpf(1.f + __expf(-x)); }
__device__ __forceinline__ float gelu_tanh(float x) { const float u = 1.5957691216057308f * (x + 0.044715f * x * x * x); return x * sigmoidf_(u); }
__device__ __forceinline__ float wave_sum(float v) {
    v += __int_as_float(__builtin_amdgcn_ds_swizzle(__float_as_int(v), 0x041f));
    v += __int_as_float(__builtin_amdgcn_ds_swizzle(__float_as_int(v), 0x081f));
    v += __int_as_float(__builtin_amdgcn_ds_swizzle(__float_as_int(v), 0x101f));
    v += __int_as_float(__builtin_amdgcn_ds_swizzle(__float_as_int(v), 0x201f));
    v += __int_as_float(__builtin_amdgcn_ds_swizzle(__float_as_int(v), 0x401f));
    auto rr = __builtin_amdgcn_permlane32_swap(__float_as_uint(v), __float_as_uint(v), false, false);
    return __uint_as_float(rr[0]) + __uint_as_float(rr[1]);
}
__device__ __forceinline__ int rel_bucket(int n) {
    if (n < 16) return n;
    int b = 16;
    b += (n >= 19) + (n >= 21) + (n >= 24) + (n >= 27) + (n >= 31) + (n >= 35) + (n >= 40) + (n >= 46) + (n >= 52) + (n >= 59) + (n >= 67) + (n >= 77) + (n >= 87) + (n >= 99) + (n >= 113);
    return b;
}

namespace pg8 {
constexpr int BM = 256, BK = 64, HALF = 128, HTB = HALF * BK * 2, STAGE_BYTES = 8 * HTB, NXCD = 8, WGM = 8;
__device__ __forceinline__ int lds_byte(int r, int c) { const int st = (r >> 4) * 2 + (c >> 5), rr = r & 15, cc = c & 31, ob = rr * 64 + cc * 2; return st * 1024 + (ob ^ (((ob >> 9) & 1) << 5)); }
__device__ __forceinline__ void stage_rc(int b, int& R, int& C) { const int st = b / 1024, sb = b % 1024, swz = sb ^ (((sb >> 9) & 1) << 5); R = (st >> 1) * 16 + swz / 64; C = (st & 1) * 32 + (swz % 64) / 2; }
__device__ __forceinline__ int perm32(int rho) { const int n = rho >> 4, i = rho & 15; return 8 * (i >> 2) + 4 * n + (i & 3); }

struct Unit { int pm, pn, z; };
struct Gemm { const bf16_t* A; const bf16_t* Bt; int lda, ldb, K, kstepA; };

struct StaticOrder {
    int nM, nN, nwg, G, c;
    __device__ void init(int nM_, int nN_, int G_, int c_) { nM = nM_; nN = nN_; nwg = nM * nN; G = G_; c = c_; }
    __device__ bool next(int i, Unit& u) const {
        const long L = (long)i * G + c; if (L >= nwg) return false;
        int wgid = (int)L; { const int q = nwg / NXCD, r = nwg % NXCD, xcd = wgid % NXCD, off = wgid / NXCD; wgid = (xcd < r ? xcd * (q + 1) : r * (q + 1) + (xcd - r) * q) + off; }
        const int nig = WGM * nN, gid = wgid / nig, fm = gid * WGM, gsz = (nM - fm) < WGM ? (nM - fm) : WGM;
        u.pm = fm + ((wgid % nig) % gsz); u.pn = (wgid % nig) / gsz; u.z = 0; return true;
    }
    __device__ __forceinline__ size_t aoff(const Unit& u, size_t ta) const { return (size_t)u.pm * ta; }
    __device__ __forceinline__ size_t boff(const Unit& u, size_t tb) const { return (size_t)u.pn * tb; }
};
struct CmpOrder {
    int G, c, base;
    __device__ bool next(int i, Unit& u) const { if (i > 0) return false; const int k = c - base; if (k < 0 || k >= 64) return false; u.z = k >> 3; u.pm = (k & 7) >> 1; u.pn = k & 1; return true; }
    __device__ __forceinline__ size_t aoff(const Unit& u, size_t ta) const { return (size_t)u.pm * ta + (size_t)((u.z >> 2) * 256 + (u.z & 3) * 64) * 2; }
    __device__ __forceinline__ size_t boff(const Unit& u, size_t tb) const { return (size_t)u.pn * tb + (size_t)(u.z >> 2) * 512 * 1024 * 2; }
};

typedef __bf16 bf16x2_t __attribute__((ext_vector_type(2)));
__device__ __forceinline__ unsigned cvt_pk_bf16(float lo, float hi) { const f32x2 v = {lo, hi}; const bf16x2_t b = __builtin_convertvector(v, bf16x2_t); return __builtin_bit_cast(unsigned, b); }

struct Seg { bf16_t* base; int ld; int tile0; };
template <int ACT  > struct EpiStore {
    static constexpr bool PERM = true;
    Seg s0, s1, s2; int t1, t2; int nscale; float scale; size_t zs;
    __device__ __forceinline__ void operator()(const f32x4 (&acc)[2][2][4][2], const Unit& u, int wr, int wc, int fr, int fq) const {
        const bool c1_ = u.pn < t1, c2_ = u.pn < t2;
        bf16_t* const pb0 = s0.base; bf16_t* const pb1 = s1.base; bf16_t* const pb2 = s2.base; const int l0 = s0.ld, l1 = s1.ld, l2 = s2.ld, q0 = s0.tile0, q1 = s1.tile0, q2 = s2.tile0;
        bf16_t* base = (c1_ ? pb0 : (c2_ ? pb1 : pb2)) + (size_t)u.z * zs; const int ld = c1_ ? l0 : (c2_ ? l1 : l2), t0 = c1_ ? q0 : (c2_ ? q1 : q2);
        const float sc = u.pn < nscale ? scale : 1.f;
        const int row0 = u.pm * BM + wr * 64 + fr, col0 = (u.pn - t0) * BM + wc * 32 + 8 * fq;
#pragma unroll
        for (int ai = 0; ai < 2; ++ai)
#pragma unroll
            for (int m = 0; m < 4; ++m) { bf16_t* rowp = base + (size_t)(row0 + ai * HALF + m * 16) * ld + col0;
#pragma unroll
                for (int bj = 0; bj < 2; ++bj) { f32x4 v0 = acc[ai][bj][m][0] * sc, v1 = acc[ai][bj][m][1] * sc;
                    if (ACT == 2) {
#pragma unroll
                        for (int j = 0; j < 4; ++j) { v0[j] = sigmoidf_(v0[j]); v1[j] = sigmoidf_(v1[j]); } }
                    u32x4 w; w.x = cvt_pk_bf16(v0[0], v0[1]); w.y = cvt_pk_bf16(v0[2], v0[3]); w.z = cvt_pk_bf16(v1[0], v1[1]); w.w = cvt_pk_bf16(v1[2], v1[3]);
                    *(u32x4*)(rowp + bj * HALF) = w; }
                if (ACT != 0) __builtin_amdgcn_sched_barrier(0); }
    }
};
struct EpiLru {
    static constexpr bool PERM = false;
    const bf16_t* XC; bf16_t* LA; bf16_t* U; const float* bg; const float* c8;
    __device__ __forceinline__ void operator()(const f32x4 (&acc)[2][2][4][2], const Unit& u, int wr, int wc, int fr, int fq) const {
        const int row0 = u.pm * BM + wr * 64 + fr, ch0 = u.pn * HALF + wc * 32 + 4 * fq;
#pragma unroll
        for (int n = 0; n < 2; ++n) { const int ch = ch0 + n * 16;
            const f32x4 br = *(const f32x4*)(bg + ch), bi = *(const f32x4*)(bg + 1024 + ch), cc = *(const f32x4*)(c8 + ch);
            u32x2 xw = *(const u32x2*)(XC + (size_t)row0 * 1024 + ch);
#pragma unroll
            for (int it = 0; it < 8; ++it) { const int ai = it >> 2, m = it & 3; const size_t off = (size_t)(row0 + ai * HALF + m * 16) * 1024 + ch;
                u32x2 xn = xw; if (it < 7) xn = *(const u32x2*)(XC + (size_t)(row0 + ((it + 1) >> 2) * HALF + ((it + 1) & 3) * 16) * 1024 + ch);
                const float xv[4] = {bflo(xw.x), bfhi(xw.x), bflo(xw.y), bfhi(xw.y)};
                float la[4], uu[4];
#pragma unroll
                for (int j = 0; j < 4; ++j) { const float r = sigmoidf_(acc[ai][0][m][n][j] + br[j]), ig = sigmoidf_(acc[ai][1][m][n][j] + bi[j]);
                    la[j] = cc[j] * r; uu[j] = __builtin_amdgcn_sqrtf(fmaxf(1.f - __expf(2.f * la[j]), 0.f)) * (ig * xv[j]); }
                u32x2 wl, wu; wl.x = cvt_pk_bf16(la[0], la[1]); wl.y = cvt_pk_bf16(la[2], la[3]); wu.x = cvt_pk_bf16(uu[0], uu[1]); wu.y = cvt_pk_bf16(uu[2], uu[3]);
                *(u32x2*)(LA + off) = wl; *(u32x2*)(U + off) = wu; xw = xn;
                __builtin_amdgcn_sched_barrier(0); } }
    }
};
__device__ __forceinline__ u32x4 ld16_agent(const void* p) {
    const unsigned long long* q = (const unsigned long long*)p;
    const unsigned long long a = __hip_atomic_load(q, __ATOMIC_RELAXED, __HIP_MEMORY_SCOPE_AGENT), b = __hip_atomic_load(q + 1, __ATOMIC_RELAXED, __HIP_MEMORY_SCOPE_AGENT);
    return (u32x4){(unsigned)a, (unsigned)(a >> 32), (unsigned)b, (unsigned)(b >> 32)};
}
template <bool FIRST> struct EpiBranch {
    static constexpr bool PERM = true;
    const bf16_t* G; int ldg; bf16_t* O; int ldo;
    __device__ __forceinline__ void operator()(const f32x4 (&acc)[2][2][4][2], const Unit& u, int wr, int wc, int fr, int fq) const {
        const int row0 = u.pm * BM + wr * 64 + fr, col0 = u.pn * BM + wc * 32 + 8 * fq;
        u32x4 gw[2], ow[2];
#pragma unroll
        for (int bj = 0; bj < 2; ++bj) { gw[bj] = *(const u32x4*)(G + (size_t)row0 * ldg + col0 + bj * HALF); if (!FIRST) ow[bj] = *(const u32x4*)(O + (size_t)row0 * ldo + col0 + bj * HALF); }
#pragma unroll
        for (int it = 0; it < 8; ++it) { const int ai = it >> 2, m = it & 3; const size_t r = (size_t)(row0 + ai * HALF + m * 16);
            u32x4 gn[2], on[2];
#pragma unroll
            for (int bj = 0; bj < 2; ++bj) { gn[bj] = gw[bj]; on[bj] = ow[bj]; }
            if (it < 7) { const size_t rn = (size_t)(row0 + ((it + 1) >> 2) * HALF + ((it + 1) & 3) * 16);
#pragma unroll
                for (int bj = 0; bj < 2; ++bj) { gn[bj] = *(const u32x4*)(G + rn * ldg + col0 + bj * HALF); if (!FIRST) on[bj] = *(const u32x4*)(O + rn * ldo + col0 + bj * HALF); } }
#pragma unroll
            for (int bj = 0; bj < 2; ++bj) { const u32x4 g4 = gw[bj];
                float v[8] = {acc[ai][bj][m][0][0] * bflo(g4.x), acc[ai][bj][m][0][1] * bfhi(g4.x), acc[ai][bj][m][0][2] * bflo(g4.y), acc[ai][bj][m][0][3] * bfhi(g4.y),
                              acc[ai][bj][m][1][0] * bflo(g4.z), acc[ai][bj][m][1][1] * bfhi(g4.z), acc[ai][bj][m][1][2] * bflo(g4.w), acc[ai][bj][m][1][3] * bfhi(g4.w)};
                if (!FIRST) { const u32x4 o4 = ow[bj]; v[0] += bflo(o4.x); v[1] += bfhi(o4.x); v[2] += bflo(o4.y); v[3] += bfhi(o4.y); v[4] += bflo(o4.z); v[5] += bfhi(o4.z); v[6] += bflo(o4.w); v[7] += bfhi(o4.w); }
                u32x4 w; w.x = cvt_pk_bf16(v[0], v[1]); w.y = cvt_pk_bf16(v[2], v[3]); w.z = cvt_pk_bf16(v[4], v[5]); w.w = cvt_pk_bf16(v[6], v[7]);
                *(u32x4*)(O + r * ldo + col0 + bj * HALF) = w; }
#pragma unroll
            for (int bj = 0; bj < 2; ++bj) { gw[bj] = gn[bj]; ow[bj] = on[bj]; }
            __builtin_amdgcn_sched_barrier(0); }
    }
};
struct EpiF32 {
    static constexpr bool PERM = false;
    float* O; int ldc;
    __device__ __forceinline__ void operator()(const f32x4 (&acc)[2][2][4][2], const Unit& u, int wr, int wc, int fr, int fq) const {
        const int row0 = u.pm * BM + wr * 64 + fr, col0 = u.pn * BM + wc * 32 + 4 * fq;
#pragma unroll
        for (int ai = 0; ai < 2; ++ai)
#pragma unroll
            for (int m = 0; m < 4; ++m) { float* rowp = O + (size_t)(row0 + ai * HALF + m * 16) * ldc + col0;
#pragma unroll
                for (int bj = 0; bj < 2; ++bj)
#pragma unroll
                    for (int n = 0; n < 2; ++n) *(f32x4*)(rowp + bj * HALF + n * 16) = acc[ai][bj][m][n]; }
    }
};
struct EpiSwiGLU {
    static constexpr bool PERM = true;
    bf16_t* O; int ldc;
    __device__ __forceinline__ void operator()(const f32x4 (&acc)[2][2][4][2], const Unit& u, int wr, int wc, int fr, int fq) const {
        const int row0 = u.pm * BM + wr * 64 + fr, col0 = u.pn * HALF + wc * 32 + 8 * fq;
#pragma unroll
        for (int ai = 0; ai < 2; ++ai)
#pragma unroll
            for (int m = 0; m < 4; ++m) { bf16_t* rowp = O + (size_t)(row0 + ai * HALF + m * 16) * ldc + col0;
                float v[8];
#pragma unroll
                for (int n = 0; n < 2; ++n)
#pragma unroll
                    for (int j = 0; j < 4; ++j) { const float g = acc[ai][0][m][n][j], up = acc[ai][1][m][n][j]; v[n * 4 + j] = g * sigmoidf_(g) * up; }
                u32x4 w; w.x = cvt_pk_bf16(v[0], v[1]); w.y = cvt_pk_bf16(v[2], v[3]); w.z = cvt_pk_bf16(v[4], v[5]); w.w = cvt_pk_bf16(v[6], v[7]);
                *(u32x4*)rowp = w; }
    }
};

template <class Epi, bool ALIGN_EPI, class Sched>
__device__ __forceinline__ void gemm_phase(LAS unsigned char* lds, const Gemm g, const Sched& S, const Epi& E, const int tid) {
    const int wid = __builtin_amdgcn_readfirstlane(tid >> 6), lane = tid & 63, wr = wid >> 2, wc = wid & 3, fr = lane & 15, fq = lane >> 4;
    const int K = g.K, nt = K / BK;
    unsigned voffA[2], voffB[2];
#pragma unroll
    for (int i = 0; i < 2; ++i) { int R, C; stage_rc(tid * 16 + i * 8192, R, C); const int Rb = Epi::PERM ? ((R & ~31) + perm32(R & 31)) : R;
        voffA[i] = (unsigned)(R * g.lda + C) * 2u; voffB[i] = (unsigned)(Rb * g.ldb + C) * 2u; }
    const size_t kstep = (size_t)(BK * 2), kstA = (size_t)g.kstepA;
    const size_t hstepA = (size_t)HALF * g.lda * 2, hstepB = (size_t)HALF * g.ldb * 2;
    const size_t tstepA = 2 * hstepA, tstepB = 2 * hstepB;
    const unsigned ldsw = (unsigned)wid * 1024u;
    const int aoff = lds_byte(wr * 64 + fr, fq * 8), boff = lds_byte(wc * 32 + fr, fq * 8);
#define PG8_SA(b, h) (((b) * 2 + (h)) * HTB)
#define PG8_SB(b, h) ((4 + (b) * 2 + (h)) * HTB)
#define PG8_STAGE(bufoff, gbase, voff) do { _Pragma("unroll") for (int _i = 0; _i < 2; ++_i) \
        __builtin_amdgcn_global_load_lds((const unsigned*)((const char*)(gbase) + (voff)[_i]), (LAS unsigned*)(lds + (bufoff) + ldsw + _i * 8192), 16, 0, 0); } while (0)
#define PG8_LDA(dst, b, h) do { _Pragma("unroll") for (int m = 0; m < 4; ++m) _Pragma("unroll") for (int k = 0; k < 2; ++k) dst[m][k] = *(const LAS bf16x8*)(lds + PG8_SA(b, h) + aoff + m * 2048 + k * 1024); } while (0)
#define PG8_LDB(dst, b, h) do { _Pragma("unroll") for (int n = 0; n < 2; ++n) _Pragma("unroll") for (int k = 0; k < 2; ++k) dst[n][k] = *(const LAS bf16x8*)(lds + PG8_SB(b, h) + boff + n * 2048 + k * 1024); } while (0)
#define PG8_MMA(ai, bj, At, Bt) do { __builtin_amdgcn_s_setprio(1); _Pragma("unroll") for (int m = 0; m < 4; ++m) _Pragma("unroll") for (int n = 0; n < 2; ++n) _Pragma("unroll") for (int k = 0; k < 2; ++k) \
        acc[ai][bj][m][n] = __builtin_amdgcn_mfma_f32_16x16x32_bf16(Bt[n][k], At[m][k], acc[ai][bj][m][n], 0, 0, 0); __builtin_amdgcn_s_setprio(0); } while (0)
#define PG8_WAIT_V(n) asm volatile("s_waitcnt vmcnt(" #n ")" ::: "memory")
#define PG8_WAIT_L(n) asm volatile("s_waitcnt lgkmcnt(" #n ")" ::: "memory")
#define PG8_BAR __builtin_amdgcn_s_barrier()
#define PG8_SCHED __builtin_amdgcn_sched_barrier(0)
#define PG8_AOFF(u_) (S.aoff((u_), tstepA))
#define PG8_BOFF(u_) (S.boff((u_), tstepB))
    Unit cur, nxt; int ui = 0;
    if (!S.next(0, cur)) return;
    f32x4 acc[2][2][4][2];
#pragma unroll
    for (int a = 0; a < 2; ++a)
#pragma unroll
        for (int b = 0; b < 2; ++b)
#pragma unroll
            for (int m = 0; m < 4; ++m)
#pragma unroll
                for (int n = 0; n < 2; ++n) acc[a][b][m][n] = (f32x4){0.f, 0.f, 0.f, 0.f};
    bf16x8 At[4][2], B0[2][2], B1[2][2];
    const char* cA = (const char*)g.A + PG8_AOFF(cur); const char* cB = (const char*)g.Bt + PG8_BOFF(cur);
    PG8_STAGE(PG8_SB(0, 0), cB, voffB); PG8_STAGE(PG8_SB(0, 1), cB + hstepB, voffB); PG8_STAGE(PG8_SA(0, 0), cA, voffA); PG8_STAGE(PG8_SA(0, 1), cA + hstepA, voffA);
    if (wr == 1) PG8_BAR;
    PG8_WAIT_V(2); PG8_BAR;
    PG8_STAGE(PG8_SB(1, 0), cB + kstep, voffB); PG8_STAGE(PG8_SA(1, 0), cA + kstA, voffA); PG8_STAGE(PG8_SB(1, 1), cB + hstepB + kstep, voffB);
    PG8_WAIT_V(6); PG8_BAR;
    for (;;) {
        const bool has_next = S.next(ui + 1, nxt);
        const char* nA = has_next ? (const char*)g.A + PG8_AOFF(nxt) : cA; const char* nB = has_next ? (const char*)g.Bt + PG8_BOFF(nxt) : cB;
        for (int t = 0; t < nt; t += 2) {
            const bool last = (t == nt - 2);
            const char* a1 = cA + (size_t)(t + 1) * kstA;
            const char* a2 = last ? nA : cA + (size_t)(t + 2) * kstA; const char* b2 = last ? nB : cB + (size_t)(t + 2) * kstep;
            const char* a3 = a2 + kstA; const char* b3 = b2 + kstep;
            PG8_LDB(B0, 0, 0); PG8_LDB(B1, 0, 1); PG8_SCHED; PG8_LDA(At, 0, 0); PG8_STAGE(PG8_SA(1, 1), a1 + hstepA, voffA);
            PG8_WAIT_V(8); PG8_WAIT_L(0); PG8_BAR; PG8_MMA(0, 0, At, B0); PG8_MMA(0, 1, At, B1); PG8_BAR; PG8_SCHED;
            PG8_LDA(At, 0, 1); PG8_STAGE(PG8_SB(0, 0), b2, voffB); PG8_STAGE(PG8_SB(0, 1), b2 + hstepB, voffB); PG8_STAGE(PG8_SA(0, 0), a2, voffA);
            PG8_WAIT_V(8); PG8_WAIT_L(0); PG8_BAR; PG8_MMA(1, 0, At, B0); PG8_MMA(1, 1, At, B1); PG8_BAR; PG8_SCHED;
            PG8_LDB(B0, 1, 0); PG8_LDB(B1, 1, 1); PG8_SCHED; PG8_LDA(At, 1, 0); PG8_STAGE(PG8_SA(0, 1), a2 + hstepA, voffA);
            PG8_WAIT_V(8); PG8_WAIT_L(0); PG8_BAR; PG8_MMA(0, 0, At, B0); PG8_MMA(0, 1, At, B1); PG8_BAR; PG8_SCHED;
            PG8_LDA(At, 1, 1); PG8_STAGE(PG8_SB(1, 0), b3, voffB); PG8_STAGE(PG8_SB(1, 1), b3 + hstepB, voffB); PG8_STAGE(PG8_SA(1, 0), a3, voffA);
            PG8_WAIT_V(8); PG8_WAIT_L(0); PG8_BAR; PG8_MMA(1, 0, At, B0); PG8_MMA(1, 1, At, B1); PG8_BAR; PG8_SCHED;
        }
        if constexpr (ALIGN_EPI) { if (wr == 0) PG8_BAR; }
        E(acc, cur, wr, wc, fr, fq);
        if (!has_next) break;
#pragma unroll
        for (int a = 0; a < 2; ++a)
#pragma unroll
            for (int b = 0; b < 2; ++b)
#pragma unroll
                for (int m = 0; m < 4; ++m)
#pragma unroll
                    for (int n = 0; n < 2; ++n) acc[a][b][m][n] = (f32x4){0.f, 0.f, 0.f, 0.f};
        cur = nxt; cA = nA; cB = nB; ++ui;
        if constexpr (ALIGN_EPI) { if (wr == 1) PG8_BAR; }
    }
    PG8_WAIT_V(0);
    if constexpr (!ALIGN_EPI) { if (wr == 0) PG8_BAR; }
    PG8_BAR;
#undef PG8_SA
#undef PG8_SB
#undef PG8_STAGE
#undef PG8_LDA
#undef PG8_LDB
#undef PG8_MMA
#undef PG8_WAIT_V
#undef PG8_WAIT_L
#undef PG8_BAR
#undef PG8_SCHED
#undef PG8_AOFF
#undef PG8_BOFF
}
}

struct Args { const float* in[19]; float* out; unsigned char* ws; int ph_lo, ph_hi; };
enum { I_X = 0, I_REL, I_NORMG, I_WIN, I_CONVW, I_CONVB, I_LRUW, I_LRUB, I_LAM, I_CPOS, I_CW1, I_CW2, I_WA2, I_BA, I_GNORM, I_WBR, I_WOUT, I_WFI, I_WFO };
enum { PH_PRE = 0, PH_G1, PH_LCONV, PH_LGATE, PH_LSCAN, PH_G23, PH_CMP1, PH_CMP2, PH_SEL, PH_ATT, PH_GLA, PH_G4, PH_BR, PH_OUT, PH_RES1, PH_FI, PH_FO, PH_RES2, NPH };

typedef const Args __attribute__((address_space(4)))* ArgsP;
struct Ctx {
    ArgsP ap; float* out; unsigned char* ws; LAS unsigned char* lds; unsigned char* ldsg;
    int tid, lane, wave, G, bid, L;
    const float* xin;
};

template <int MODE> __device__ __forceinline__ int srccol(int n) {
    if (MODE == 0) return n;
    if (MODE == 1) { if (n < 2560) return 2048 + n; if (n < 2608) return 4608 + (n - 2560); if (n < 2624) return 7728 + (n - 2608); if (n < 2816) return -1; return 4656 + (n - 2816); }
    if (MODE == 2) return 7744 + n;
      { const int t = n >> 8, j = n & 255; return j < 128 ? t * 128 + j : DFF + t * 128 + (j - 128); }
}
template <int MODE> __device__ __forceinline__ void tr_item(const float* W, int ldw, bf16_t* WT, int ldd, int nblk, int item, LAS float* scr, int lane) {
    const int kb = item / nblk, nb = item % nblk, k0 = 64 * kb, n0 = 32 * nb;
    const int sc = srccol<MODE>(n0 + (lane & 31));
#pragma unroll 8
    for (int i = 0; i < 32; ++i) { const int kk = 2 * i + (lane >> 5); scr[kk * 33 + (lane & 31)] = sc >= 0 ? W[(size_t)(k0 + kk) * ldw + sc] : 0.f; }
    asm volatile("s_waitcnt lgkmcnt(0)" ::: "memory");
    const int c = lane & 7;
#pragma unroll
    for (int j = 0; j < 4; ++j) { const int n = (lane >> 3) + 8 * j; const LAS float* s = scr + (8 * c) * 33 + n;
        u32x4 o; o.x = pk2(s[0 * 33], s[1 * 33]); o.y = pk2(s[2 * 33], s[3 * 33]); o.z = pk2(s[4 * 33], s[5 * 33]); o.w = pk2(s[6 * 33], s[7 * 33]);
        *(u32x4*)(WT + (size_t)(n0 + n) * ldd + k0 + 8 * c) = o; }
    asm volatile("s_waitcnt lgkmcnt(0)" ::: "memory");
}
__device__ __forceinline__ void rms_row_to_bf16(const float* xrow, const float* g, bf16_t* orow, int lane) {
    const f32x4* xr = (const f32x4*)xrow + lane; const f32x4* gr = (const f32x4*)g + lane;
    f32x4 v[4]; float s = 0.f;
#pragma unroll
    for (int j = 0; j < 4; ++j) { v[j] = xr[64 * j]; s += (v[j].x * v[j].x + v[j].y * v[j].y) + (v[j].z * v[j].z + v[j].w * v[j].w); }
    const float rstd = __builtin_amdgcn_rsqf(wave_sum(s) * (1.f / ND) + EPS);
    unsigned long long* o8 = (unsigned long long*)orow + lane;
#pragma unroll
    for (int j = 0; j < 4; ++j) { const f32x4 gg = gr[64 * j]; o8[64 * j] = (unsigned long long)pk2(v[j].x * rstd * gg.x, v[j].y * rstd * gg.y) | ((unsigned long long)pk2(v[j].z * rstd * gg.z, v[j].w * rstd * gg.w) << 32); }
}
__device__ __forceinline__ void ph_pre(Ctx& F) {
    const int L = F.L;
    LAS float* scr = (LAS float*)(F.lds + F.wave * 16384);
    const int gw = F.bid * NWAVES + F.wave, NGW = F.G * NWAVES;
    const float* win = F.ap->in[I_WIN] + (size_t)L * ND * IN_W;
    constexpr int I_G1 = 64 * 16, I_G23 = 184 * 16, I_G4 = 96 * 16, I_BR1 = 32 * 16, I_OUT = 32 * 16, I_FI = 176 * 16, I_FO = 32 * 44;
    constexpr int I_C1 = 8 * 16;
    constexpr int NITEMS = I_G1 + I_G23 + I_G4 + 3 * I_BR1 + I_OUT + I_FI + I_FO + 4 * I_C1;
    for (int it = gw; it < NITEMS; it += NGW) {
        int r = it;
        if (r < I_G1) { tr_item<0>(win, IN_W, (bf16_t*)(F.ws + W_G1), 1024, 64, r, scr, F.lane); continue; } r -= I_G1;
        if (r < I_G23) { tr_item<1>(win, IN_W, (bf16_t*)(F.ws + W_G23), 1024, 184, r, scr, F.lane); continue; } r -= I_G23;
        if (r < I_G4) { tr_item<2>(win, IN_W, (bf16_t*)(F.ws + W_G4), 1024, 96, r, scr, F.lane); continue; } r -= I_G4;
        if (r < 3 * I_BR1) { const int b = r / I_BR1; tr_item<0>(F.ap->in[I_WBR] + ((size_t)L * 3 + b) * ND * ND, ND, (bf16_t*)(F.ws + W_BR) + (size_t)b * ND * ND, 1024, 32, r % I_BR1, scr, F.lane); continue; } r -= 3 * I_BR1;
        if (r < I_OUT) { tr_item<0>(F.ap->in[I_WOUT] + (size_t)L * ND * ND, ND, (bf16_t*)(F.ws + W_OUT), 1024, 32, r, scr, F.lane); continue; } r -= I_OUT;
        if (r < I_FI) { tr_item<3>(F.ap->in[I_WFI] + (size_t)L * ND * 2 * DFF, 2 * DFF, (bf16_t*)(F.ws + W_FI), 1024, 176, r, scr, F.lane); continue; } r -= I_FI;
        if (r < I_FO) { tr_item<0>(F.ap->in[I_WFO] + (size_t)L * DFF * ND, ND, (bf16_t*)(F.ws + W_FO), DFF, 32, r, scr, F.lane); continue; } r -= I_FO;
        { const int q = r / I_C1, kv = q >> 1, half = q & 1;
          tr_item<0>(F.ap->in[I_CW1] + ((size_t)(L * 2 + kv) * 2048 + 1024 * half) * 256, 256, (bf16_t*)(F.ws + W_C1) + ((size_t)kv * 512 + 256 * half) * 1024, 1024, 8, r % I_C1, scr, F.lane); }
    }
    if (F.bid == F.G - 1) { const int kv = F.tid >> 8, n = F.tid & 255; const float* w1 = F.ap->in[I_CW1] + (size_t)(L * 2 + kv) * 2048 * 256 + n; const float* pos = F.ap->in[I_CPOS] + (size_t)(L * 2 + kv) * 2048;
        float a0 = 0.f, a1 = 0.f, a2 = 0.f, a3 = 0.f;
#pragma unroll 4
        for (int k = 0; k < 2048; k += 4) { a0 += pos[k] * w1[(size_t)k * 256]; a1 += pos[k + 1] * w1[(size_t)(k + 1) * 256]; a2 += pos[k + 2] * w1[(size_t)(k + 2) * 256]; a3 += pos[k + 3] * w1[(size_t)(k + 3) * 256]; }
        ((float*)(F.ws + WS_CTL))[CT_C1 + F.tid] = (a0 + a1) + (a2 + a3); }
    {
        const float* lw = F.ap->in[I_LRUW] + (size_t)L * 2 * 8 * 128 * 128; bf16_t* wt = (bf16_t*)(F.ws + W_LRU);
        for (int it = F.bid * NTHR + F.tid; it < 2048 * 128; it += F.G * NTHR) {
            const int row = it >> 7, kc = (it & 127) * 8, blk = row >> 8, g2 = (row >> 7) & 1, e = row & 127;
            u32x4 o = (u32x4){0u, 0u, 0u, 0u};
            if ((kc >> 7) == blk) { const int c0 = kc & 127; const float* s = lw + ((size_t)(g2 * 8 + blk) * 128 + c0) * 128 + e;
                o.x = pk2(s[0], s[128]); o.y = pk2(s[256], s[384]); o.z = pk2(s[512], s[640]); o.w = pk2(s[768], s[896]); }
            *(u32x4*)(wt + (size_t)row * 1024 + kc) = o;
        }
    }
    {
        float* ctl = (float*)(F.ws + WS_CTL);
        const int gt = F.bid * NTHR + F.tid;
        if (gt < 1024) { const float lam = F.ap->in[I_LAM][L * 1024 + gt]; const float e = __expf(-lam); const float sp = e < 0.03f ? e * (1.f - e * (0.5f - e * (0.33333333f - 0.25f * e))) : __logf(1.f + e); ctl[CT_C8 + gt] = -8.f * sp; }
        else if (gt < 1024 + 2048) { const int i = gt - 1024, h = i >> 7, d = i & 127; ctl[CT_RB + i] = F.ap->in[I_REL][rel_bucket(d) * 16 + h]; }
    }
    const float* g0 = F.ap->in[I_NORMG] + (size_t)(L * 4 + 0) * ND; bf16_t* H = (bf16_t*)(F.ws + WS_H);
    for (int m = gw; m < NT; m += NGW) rms_row_to_bf16(F.xin + (size_t)m * ND, g0, H + (size_t)m * ND, F.lane);
}

__device__ __forceinline__ void ph_lconv(Ctx& F) {
    const int L = F.L;
    const bf16_t* XA = (const bf16_t*)(F.ws + WS_XA); bf16_t* XC = (bf16_t*)(F.ws + WS_XC);
    const float* cw = F.ap->in[I_CONVW] + (size_t)L * 4 * 1024; const float* cb = F.ap->in[I_CONVB] + (size_t)L * 1024;
    for (int idx = F.bid * NTHR + F.tid; idx < NT * 128; idx += F.G * NTHR) {
        const int t = idx >> 7, c8 = (idx & 127) * 8, s = t & (NS - 1);
        float acc[8];
#pragma unroll
        for (int i = 0; i < 8; ++i) acc[i] = cb[c8 + i];
#pragma unroll
        for (int j = 0; j < 4; ++j) { if (s - 3 + j >= 0) { const u32x4 w = *(const u32x4*)(XA + (size_t)(t - 3 + j) * 1024 + c8); const float* ww = cw + j * 1024 + c8;
                acc[0] += ww[0] * bflo(w.x); acc[1] += ww[1] * bfhi(w.x); acc[2] += ww[2] * bflo(w.y); acc[3] += ww[3] * bfhi(w.y);
                acc[4] += ww[4] * bflo(w.z); acc[5] += ww[5] * bfhi(w.z); acc[6] += ww[6] * bflo(w.w); acc[7] += ww[7] * bfhi(w.w); } }
        u32x4 o; o.x = pk2(acc[0], acc[1]); o.y = pk2(acc[2], acc[3]); o.z = pk2(acc[4], acc[5]); o.w = pk2(acc[6], acc[7]);
        *(u32x4*)(XC + (size_t)t * 1024 + c8) = o;
    }
}

__device__ __forceinline__ void ph_lscan(Ctx& F) {
    const bf16_t* LA = (const bf16_t*)(F.ws + WS_LA); const bf16_t* U = (const bf16_t*)(F.ws + WS_U); bf16_t* GA = (bf16_t*)(F.ws + WS_GA);
    LAS float* sA = (LAS float*)F.lds; LAS float* sH = sA + 32 * 32;
    const int chunk = F.tid >> 4, cl = F.tid & 15;
    for (int unit = F.bid; unit < NB_ * 32; unit += F.G) {
        const int b = unit >> 5, c = (unit & 31) * 32 + cl * 2;
        const size_t base = ((size_t)b * NS + chunk * 64) * 1024 + c;
        float s0 = 0.f, s1 = 0.f, h0 = 0.f, h1 = 0.f;
        for (int i = 0; i < 64; ++i) { const unsigned lw = *(const unsigned*)(LA + base + (size_t)i * 1024), uw = *(const unsigned*)(U + base + (size_t)i * 1024);
            const float l0 = bflo(lw), l1 = bfhi(lw); s0 += l0; s1 += l1; h0 = __expf(l0) * h0 + bflo(uw); h1 = __expf(l1) * h1 + bfhi(uw); }
        sA[chunk * 32 + cl * 2] = s0; sA[chunk * 32 + cl * 2 + 1] = s1; sH[chunk * 32 + cl * 2] = h0; sH[chunk * 32 + cl * 2 + 1] = h1;
        __syncthreads();
        h0 = 0.f; h1 = 0.f;
        for (int k = 0; k < chunk; ++k) { h0 = __expf(sA[k * 32 + cl * 2]) * h0 + sH[k * 32 + cl * 2]; h1 = __expf(sA[k * 32 + cl * 2 + 1]) * h1 + sH[k * 32 + cl * 2 + 1]; }
        for (int i = 0; i < 64; ++i) { const unsigned lw = *(const unsigned*)(LA + base + (size_t)i * 1024), uw = *(const unsigned*)(U + base + (size_t)i * 1024);
            h0 = __expf(bflo(lw)) * h0 + bflo(uw); h1 = __expf(bfhi(lw)) * h1 + bfhi(uw);
            unsigned* gp = (unsigned*)(GA + base + (size_t)i * 1024); const unsigned gw = *gp;
            *gp = pk2(h0 * gelu_tanh(bflo(gw)), h1 * gelu_tanh(bfhi(gw))); }
        __syncthreads();
    }
}

__device__ __forceinline__ void ph_cmp2g(Ctx& F) {
    const int L = F.L;
    const bf16_t* P = (const bf16_t*)(F.ws + WS_HID); bf16_t* KC = (bf16_t*)(F.ws + WS_KC); const float* c1 = (const float*)(F.ws + WS_CTL) + CT_C1;
    LAS float* hid = (LAS float*)F.lds;
    for (int unit = F.bid; unit < 2 * 32 * 16; unit += F.G) {
        const int cg = unit & 15, bg = (unit >> 4) & 31, kv = unit >> 9, b = bg >> 2, g = bg & 3;
        const bf16_t* Pb = P + ((size_t)(kv * 4 + g) * 1024 + b * 128) * 512;
#pragma unroll
        for (int it = 0; it < 4; ++it) { const int e = F.tid + it * 512, cl = e >> 8, n = e & 255, c = cg * 8 + cl;
            float v = 0.f; if (c < 127) v = gelu_tanh(bf1(Pb[(size_t)c * 512 + n]) + bf1(Pb[(size_t)(c + 1) * 512 + 256 + n]) + c1[kv * 256 + n]);
            hid[cl * 256 + n] = v; }
        __syncthreads();
        { const int cl = F.tid >> 6, d = F.tid & 63, c = cg * 8 + cl; const float* w2 = F.ap->in[I_CW2] + (size_t)(L * 2 + kv) * 256 * 64 + d; float acc = 0.f;
#pragma unroll 8
            for (int n = 0; n < 256; ++n) acc += hid[cl * 256 + n] * w2[n * 64];
            KC[((size_t)(kv * 32 + bg) * 128 + c) * 64 + d] = (bf16_t)f2bf(c < 127 ? acc : 0.f); }
        __syncthreads();
    }
}
__device__ __forceinline__ void ph_sel(Ctx& F) {
    const bf16_t* NBp = (const bf16_t*)(F.ws + WS_NB); const bf16_t* KC = (const bf16_t*)(F.ws + WS_KC); unsigned* SEL = (unsigned*)(F.ws + WS_SEL);
    const float* RB = (const float*)(F.ws + WS_CTL) + CT_RB;
    LAS float* imp = (LAS float*)F.lds;
    for (int unit = F.bid; unit < 32 * 4; unit += F.G) {
        const int bg = unit >> 2, b = bg >> 2, g = bg & 3, s = (unit & 3) * 512 + F.tid;
        const int nvalid = s >= 31 ? ((s - 31) >> 4) + 1 : 0;
        const bf16_t* kc = KC + (size_t)bg * 128 * 64;
#pragma unroll 1
        for (int j = 0; j < 32; ++j) imp[j * 512 + F.tid] = 0.f;
#pragma unroll 1
        for (int r = 0; r < 4; ++r) {
            const int h = g * 4 + r; const bf16_t* qp = NBp + ((size_t)b * NS + s) * LD_NB + h * 64;
            unsigned qw[32];
#pragma unroll
            for (int i = 0; i < 8; ++i) { const u32x4 w = *(const u32x4*)(qp + 8 * i); qw[4 * i] = w.x; qw[4 * i + 1] = w.y; qw[4 * i + 2] = w.z; qw[4 * i + 3] = w.w; }
            const float* rb = RB + h * 128;
            float mx = -1e30f, l = 0.f;
#pragma unroll 1
            for (int c = 0; c < 127; ++c) { const unsigned* kr = (const unsigned*)(kc + c * 64); float dot = 0.f;
#pragma unroll
                for (int i = 0; i < 32; ++i) { const unsigned kw = kr[i]; dot += bflo(qw[i]) * bflo(kw) + bfhi(qw[i]) * bfhi(kw); }
                if (c < nvalid) { const int dist = s - 16 * c - 31; const float lg = dot + rb[dist < 127 ? dist : 127];
                    const float mn = fmaxf(mx, lg); l = l * __expf(mx - mn) + __expf(lg - mn); mx = mn; } }
            const float inv = nvalid > 0 ? __builtin_amdgcn_rcpf(l) : 0.f;
#pragma unroll 1
            for (int c = 0; c < 127; ++c) { const unsigned* kr = (const unsigned*)(kc + c * 64); float dot = 0.f;
#pragma unroll
                for (int i = 0; i < 32; ++i) { const unsigned kw = kr[i]; dot += bflo(qw[i]) * bflo(kw) + bfhi(qw[i]) * bfhi(kw); }
                if (c < nvalid) { const int dist = s - 16 * c - 31; const float p = __expf(dot + rb[dist < 127 ? dist : 127] - mx) * inv;
                    const int j = c >> 2, cm = c & 3;
                    if (cm == 3) { imp[j * 512 + F.tid] += 0.5f * p; if (j + 1 < 32) imp[(j + 1) * 512 + F.tid] += 0.5f * p; }
                    else imp[j * 512 + F.tid] += p; } }
        }
        const int cur = s >> 6; unsigned mask;
        if (cur <= 7) mask = (2u << cur) - 1u;
        else { mask = 1u | (1u << cur) | (1u << (cur - 1));
#pragma unroll 1
            for (int k = 0; k < 5; ++k) { float best = -1.f; int bj = 1;
#pragma unroll 1
                for (int j = 1; j <= cur - 2; ++j) { const float v = imp[j * 512 + F.tid]; if (!((mask >> j) & 1u) && v > best) { best = v; bj = j; } }
                mask |= 1u << bj; } }
        SEL[(size_t)bg * NS + s] = mask;
    }
}
#define ATT_KEY(KROW, VROW, ACTIVE, DIST) do { const u32x4* kr_ = (const u32x4*)(KROW); float dot_ = 0.f; \
        _Pragma("unroll") for (int c_ = 0; c_ < 4; ++c_) { const u32x4 ka_ = kr_[2 * c_], kb_ = kr_[2 * c_ + 1]; \
            dot_ += bflo(qw[8 * c_]) * bflo(ka_.x) + bfhi(qw[8 * c_]) * bfhi(ka_.x) + bflo(qw[8 * c_ + 1]) * bflo(ka_.y) + bfhi(qw[8 * c_ + 1]) * bfhi(ka_.y) \
                  + bflo(qw[8 * c_ + 2]) * bflo(ka_.z) + bfhi(qw[8 * c_ + 2]) * bfhi(ka_.z) + bflo(qw[8 * c_ + 3]) * bflo(ka_.w) + bfhi(qw[8 * c_ + 3]) * bfhi(ka_.w) \
                  + bflo(qw[8 * c_ + 4]) * bflo(kb_.x) + bfhi(qw[8 * c_ + 4]) * bfhi(kb_.x) + bflo(qw[8 * c_ + 5]) * bflo(kb_.y) + bfhi(qw[8 * c_ + 5]) * bfhi(kb_.y) \
                  + bflo(qw[8 * c_ + 6]) * bflo(kb_.z) + bfhi(qw[8 * c_ + 6]) * bfhi(kb_.z) + bflo(qw[8 * c_ + 7]) * bflo(kb_.w) + bfhi(qw[8 * c_ + 7]) * bfhi(kb_.w); \
            __builtin_amdgcn_sched_barrier(0); } \
        if (ACTIVE) { const int dd_ = (DIST); const float lg_ = dot_ + rb[dd_ < 127 ? dd_ : 127]; const float mn_ = fmaxf(mx, lg_), sc_ = __expf(mx - mn_), p_ = __expf(lg_ - mn_); mx = mn_; l = l * sc_ + p_; \
            const u32x4* vr_ = (const u32x4*)(VROW); \
            _Pragma("unroll") for (int c_ = 0; c_ < 8; ++c_) { const u32x4 vv_ = vr_[c_]; \
                o[8 * c_] = o[8 * c_] * sc_ + p_ * bflo(vv_.x); o[8 * c_ + 1] = o[8 * c_ + 1] * sc_ + p_ * bfhi(vv_.x); o[8 * c_ + 2] = o[8 * c_ + 2] * sc_ + p_ * bflo(vv_.y); o[8 * c_ + 3] = o[8 * c_ + 3] * sc_ + p_ * bfhi(vv_.y); \
                o[8 * c_ + 4] = o[8 * c_ + 4] * sc_ + p_ * bflo(vv_.z); o[8 * c_ + 5] = o[8 * c_ + 5] * sc_ + p_ * bfhi(vv_.z); o[8 * c_ + 6] = o[8 * c_ + 6] * sc_ + p_ * bflo(vv_.w); o[8 * c_ + 7] = o[8 * c_ + 7] * sc_ + p_ * bfhi(vv_.w); \
                if (c_ & 1) __builtin_amdgcn_sched_barrier(0); } } } while (0)
__device__ __forceinline__ void ph_att(Ctx& F) {
    bf16_t* NBp = (bf16_t*)(F.ws + WS_NB); const bf16_t* KC = (const bf16_t*)(F.ws + WS_KC); const unsigned* SEL = (const unsigned*)(F.ws + WS_SEL);
    const float* RB = (const float*)(F.ws + WS_CTL) + CT_RB;
    for (int unit = F.bid; unit < NB_ * 16 * 4; unit += F.G) {
        const int sb = unit & 3, h = (unit >> 2) & 15, b = unit >> 6, g = h >> 2, bg = b * 4 + g;
        const int s = sb * 512 + F.tid, sw0 = sb * 512 + F.wave * 64;
        bf16_t* qp = NBp + ((size_t)b * NS + s) * LD_NB + h * 64;
        unsigned qw[32];
#pragma unroll
        for (int i = 0; i < 8; ++i) { const u32x4 w = *(const u32x4*)(qp + 8 * i); qw[4 * i] = w.x; qw[4 * i + 1] = w.y; qw[4 * i + 2] = w.z; qw[4 * i + 3] = w.w; }
        const bf16_t* gp = NBp + ((size_t)b * NS + s) * LD_NB + 2560 + h;
        const float g0 = sigmoidf_(bf1(gp[0])), g1 = sigmoidf_(bf1(gp[16])), g2 = sigmoidf_(bf1(gp[32]));
        const float* rb = RB + h * 128;
        float o[64]; LAS float* y = (LAS float*)F.lds + F.tid;
#pragma unroll
        for (int i = 0; i < 64; ++i) { y[i * 512] = 0.f; o[i] = 0.f; }
        float mx = -1e30f, l = 0.f;
        { const int nvalid = s >= 31 ? ((s - 31) >> 4) + 1 : 0; const bf16_t* kc = KC + (size_t)bg * 128 * 64; const bf16_t* vc = KC + (size_t)(32 + bg) * 128 * 64;
#pragma unroll 1
            for (int c = 0; c < 127; ++c) ATT_KEY(kc + c * 64, vc + c * 64, c < nvalid, s - 16 * c - 31);
            const float sc = l > 0.f ? g0 * __builtin_amdgcn_rcpf(l) : 0.f;
#pragma unroll
            for (int i = 0; i < 64; ++i) { y[i * 512] += sc * o[i]; o[i] = 0.f; }
            mx = -1e30f; l = 0.f; }
        const bf16_t* kvb = NBp + (size_t)b * NS * LD_NB + 1024 + g * 64;
        { const unsigned mask = SEL[(size_t)bg * NS + s];
#pragma unroll 1
            for (int j = 0; j < 32; ++j) { const bool bit = (mask >> j) & 1u; if (!__any(bit)) continue;
#pragma unroll 1
                for (int i = 0; i < 64; ++i) { const int tk = 64 * j + i; const bf16_t* row = kvb + (size_t)tk * LD_NB; ATT_KEY(row + 2 * 256, row + 3 * 256, bit && tk <= s, s - tk); } }
            const float sc = l > 0.f ? g1 * __builtin_amdgcn_rcpf(l) : 0.f;
#pragma unroll
            for (int i = 0; i < 64; ++i) { y[i * 512] += sc * o[i]; o[i] = 0.f; }
            mx = -1e30f; l = 0.f; }
        { const int t0 = sw0 - 255 > 0 ? sw0 - 255 : 0, t1 = sw0 + 63;
#pragma unroll 1
            for (int tk = t0; tk <= t1; ++tk) { const bf16_t* row = kvb + (size_t)tk * LD_NB; ATT_KEY(row + 4 * 256, row + 5 * 256, tk <= s && s - tk < 256, s - tk); }
            const float sc = l > 0.f ? g2 * __builtin_amdgcn_rcpf(l) : 0.f;
#pragma unroll
            for (int i = 0; i < 64; ++i) y[i * 512] += sc * o[i]; }
#pragma unroll
        for (int i = 0; i < 8; ++i) { u32x4 w; w.x = pk2(y[(8 * i) * 512], y[(8 * i + 1) * 512]); w.y = pk2(y[(8 * i + 2) * 512], y[(8 * i + 3) * 512]); w.z = pk2(y[(8 * i + 4) * 512], y[(8 * i + 5) * 512]); w.w = pk2(y[(8 * i + 6) * 512], y[(8 * i + 7) * 512]); *(u32x4*)(qp + 8 * i) = w; }
    }
}

typedef float f32x16 __attribute__((ext_vector_type(16)));
#define MFMA32(a, b, c) __builtin_amdgcn_mfma_f32_32x32x16_bf16((a), (b), (c), 0, 0, 0)
namespace att {
constexpr int KROW = 144, VROW = 136, KCROW = 144, VCROW = 264;
constexpr int L_KB = 0, L_VB = 2 * 64 * KROW, L_KC = L_VB + 2 * 64 * VROW, L_VC = L_KC + 128 * KCROW, L_RB = L_VC + 64 * VCROW, L_IMP = L_RB + 4 * 256 * 4, L_SEL = L_IMP + 4 * 64 * 33 * 4, L_END = L_SEL + 66 * 4;
static_assert(L_END <= 140000, "attention LDS map");
constexpr float LOG2E = 1.4426950408889634f;
}
__device__ __forceinline__ float other_half(float v, int hi) { auto rr = __builtin_amdgcn_permlane32_swap(__float_as_uint(v), __float_as_uint(v), false, false); return __uint_as_float(hi ? rr[0] : rr[1]); }
__device__ __forceinline__ bf16x8 pack8(const f32x16& p, const int s8) {
    u32x4 w; w.x = pg8::cvt_pk_bf16(p[s8], p[s8 + 1]); w.y = pg8::cvt_pk_bf16(p[s8 + 2], p[s8 + 3]); w.z = pg8::cvt_pk_bf16(p[s8 + 4], p[s8 + 5]); w.w = pg8::cvt_pk_bf16(p[s8 + 6], p[s8 + 7]);
    return __builtin_bit_cast(bf16x8, w);
}
__device__ __forceinline__ void ph_att_mfma(Ctx& F) {
    using namespace att;
    bf16_t* NBp = (bf16_t*)(F.ws + WS_NB); const bf16_t* KCg = (const bf16_t*)(F.ws + WS_KC);
    const float* RB = (const float*)(F.ws + WS_CTL) + CT_RB;
    LAS unsigned char* lds = F.lds;
    const int tid = F.tid, lane = F.lane, w = F.wave, r32 = lane & 31, hi = lane >> 5, hr = w >> 1, qh = w & 1;
    const float NEG = -__builtin_inff();
    for (int unit = F.bid; unit < 1024; unit += F.G) {
        const int bg = unit & 31, c = 31 - (unit >> 5), b = bg >> 2, g = bg & 3, h = g * 4 + hr;
        const int s0 = 64 * c, qidx = 32 * qh + r32, s = s0 + qidx;
        const size_t trow = (size_t)b * NS + s;
        { const bf16_t* kc = KCg + (size_t)bg * 128 * 64; const bf16_t* vc = KCg + (size_t)(32 + bg) * 128 * 64;
#pragma unroll
            for (int it = 0; it < 2; ++it) { const int e = tid + it * 512, key = e >> 3, ch = e & 7;
                const u32x4 kv = *(const u32x4*)(kc + key * 64 + ch * 8); *(LAS u32x4*)(lds + L_KC + key * KCROW + ch * 16) = kv;
                const u32x4 vv = *(const u32x4*)(vc + key * 64 + ch * 8); const unsigned vw[4] = {vv.x, vv.y, vv.z, vv.w};
#pragma unroll
                for (int i = 0; i < 4; ++i) { *(LAS bf16_t*)(lds + L_VC + (8 * ch + 2 * i) * VCROW + key * 2) = (bf16_t)(vw[i] & 0xffffu); *(LAS bf16_t*)(lds + L_VC + (8 * ch + 2 * i + 1) * VCROW + key * 2) = (bf16_t)(vw[i] >> 16); } }
#pragma unroll
            for (int it = 0; it < 2; ++it) { const int e = tid + it * 512, hh = e >> 8, d = e & 255; ((LAS float*)(lds + L_RB))[e] = RB[(g * 4 + hh) * 128 + (d < 127 ? d : 127)] * LOG2E; } }
        bf16x8 qf[4];
#pragma unroll
        for (int ds = 0; ds < 4; ++ds) qf[ds] = *(const bf16x8*)(NBp + trow * LD_NB + h * 64 + 16 * ds + 8 * hi);
        float g0, g1, g2; { const bf16_t* gp = NBp + trow * LD_NB + 2560 + h; g0 = sigmoidf_(bf1(gp[0])); g1 = sigmoidf_(bf1(gp[16])); g2 = sigmoidf_(bf1(gp[32])); }
        const LAS float* rbl = (const LAS float*)(lds + L_RB) + hr * 256;
        __syncthreads();
        f32x16 y[2], o[2];
#pragma unroll
        for (int i = 0; i < 16; ++i) { y[0][i] = 0.f; y[1][i] = 0.f; o[0][i] = 0.f; o[1][i] = 0.f; }
        {
            f32x16 sc[4];
#pragma unroll
            for (int sub = 0; sub < 4; ++sub) {
#pragma unroll
                for (int i = 0; i < 16; ++i) sc[sub][i] = 0.f;
#pragma unroll
                for (int ds = 0; ds < 4; ++ds) { const bf16x8 a = *(const LAS bf16x8*)(lds + L_KC + (32 * sub + r32) * KCROW + ds * 32 + hi * 16); sc[sub] = MFMA32(a, qf[ds], sc[sub]); } }
            float mx = NEG;
#pragma unroll
            for (int sub = 0; sub < 4; ++sub)
#pragma unroll
                for (int i = 0; i < 16; ++i) { const int cc = 32 * sub + (i & 3) + 8 * (i >> 2) + 4 * hi; const int dist = s - 16 * cc - 31;
                    const float tb = rbl[dist < 0 ? 0 : (dist > 255 ? 255 : dist)]; const float x = dist >= 0 ? sc[sub][i] * LOG2E + tb : NEG; sc[sub][i] = x; mx = fmaxf(mx, x); }
            mx = fmaxf(mx, other_half(mx, hi)); const float mu = mx == NEG ? 0.f : mx;
            float l = 0.f;
#pragma unroll
            for (int sub = 0; sub < 4; ++sub)
#pragma unroll
                for (int i = 0; i < 16; ++i) { const float p = __builtin_amdgcn_exp2f(sc[sub][i] - mu); sc[sub][i] = p; l += p; }
            l += other_half(l, hi); const float inv = l > 0.f ? __builtin_amdgcn_rcpf(l) : 0.f;
#pragma unroll
            for (int sub = 0; sub < 4; ++sub)
#pragma unroll
                for (int i = 0; i < 16; ++i) sc[sub][i] *= inv;
            { LAS float* imp = (LAS float*)(lds + L_IMP) + (hr * 64 + qidx) * 33; float tprev = 0.f;
#pragma unroll
                for (int sub = 0; sub < 4; ++sub)
#pragma unroll
                    for (int gq = 0; gq < 4; ++gq) { const float t = 0.5f * sc[sub][4 * gq + 3]; const float G = sc[sub][4 * gq] + sc[sub][4 * gq + 1] + sc[sub][4 * gq + 2] + t;
                        const float to = other_half(t, hi);
                        imp[8 * sub + 2 * gq + hi] = G + (hi ? to : tprev); tprev = to; } }
#pragma unroll
            for (int ks = 0; ks < 8; ++ks) { const bf16x8 pf = pack8(sc[ks >> 1], (ks & 1) * 8);
#pragma unroll
                for (int dt = 0; dt < 2; ++dt) { const LAS unsigned char* vp = lds + L_VC + (32 * dt + r32) * VCROW + (16 * ks + 4 * hi) * 2;
                    const u32x2 va = *(const LAS u32x2*)vp, vb = *(const LAS u32x2*)(vp + 16); const u32x4 vw = {va.x, va.y, vb.x, vb.y};
                    o[dt] = MFMA32(__builtin_bit_cast(bf16x8, vw), pf, o[dt]); } }
#pragma unroll
            for (int i = 0; i < 16; ++i) { y[0][i] = g0 * o[0][i]; y[1][i] = g0 * o[1][i]; o[0][i] = 0.f; o[1][i] = 0.f; }
        }
        __syncthreads();
        if (w == 0) {
            unsigned mask;
            if (c <= 7) mask = (2u << c) - 1u;
            else {
                const LAS float* imp = (const LAS float*)(lds + L_IMP) + lane * 33; float tot[32];
#pragma unroll
                for (int j = 0; j < 32; ++j) tot[j] = imp[j] + imp[64 * 33 + j] + imp[2 * 64 * 33 + j] + imp[3 * 64 * 33 + j];
                mask = 1u | (1u << c) | (1u << (c - 1));
#pragma unroll 1
                for (int k = 0; k < 5; ++k) { float best = -1.f; int bj = 1;
#pragma unroll
                    for (int j = 1; j < 30; ++j) { const bool ok = (j <= c - 2) && !((mask >> j) & 1u) && tot[j] > best; best = ok ? tot[j] : best; bj = ok ? j : bj; }
                    mask |= 1u << bj; } }
            ((LAS unsigned*)(lds + L_SEL))[lane] = mask;
            unsigned un = mask;
            un |= (unsigned)__builtin_amdgcn_ds_swizzle((int)un, 0x041f); un |= (unsigned)__builtin_amdgcn_ds_swizzle((int)un, 0x081f); un |= (unsigned)__builtin_amdgcn_ds_swizzle((int)un, 0x101f);
            un |= (unsigned)__builtin_amdgcn_ds_swizzle((int)un, 0x201f); un |= (unsigned)__builtin_amdgcn_ds_swizzle((int)un, 0x401f);
            { auto rr = __builtin_amdgcn_permlane32_swap(un, un, false, false); un = rr[0] | rr[1]; }
            if (lane == 0) ((LAS unsigned*)(lds + L_SEL))[64] = un;
        }
        __syncthreads();
        const unsigned mymask = ((const LAS unsigned*)(lds + L_SEL))[qidx];
        unsigned uni = (unsigned)__builtin_amdgcn_readfirstlane((int)((const LAS unsigned*)(lds + L_SEL))[64]);
        const bf16_t* kvb = NBp + (size_t)b * NS * LD_NB + 1024 + g * 64;
        const int skey = tid >> 3, sch = tid & 7;
        const int nslc = __builtin_popcount(uni), jw0 = c - 4 > 0 ? c - 4 : 0, nitem = nslc + (c - jw0 + 1);
        float m = -1e30f, l = 0.f;
        u32x4 kreg, vreg;
        int jcur; bool wincur;
        { const bool isw = nslc == 0; jcur = isw ? jw0 : __builtin_ctz(uni); wincur = isw; if (!isw) uni &= uni - 1; }
        { const bf16_t* src = kvb + (size_t)(64 * jcur + skey) * LD_NB + (wincur ? 4 * 256 : 2 * 256) + sch * 8; kreg = *(const u32x4*)src; vreg = *(const u32x4*)(src + 256); }
        { *(LAS u32x4*)(lds + L_KB + skey * KROW + sch * 16) = kreg; const unsigned vw[4] = {vreg.x, vreg.y, vreg.z, vreg.w};
#pragma unroll
            for (int i = 0; i < 4; ++i) { *(LAS bf16_t*)(lds + L_VB + (8 * sch + 2 * i) * VROW + skey * 2) = (bf16_t)(vw[i] & 0xffffu); *(LAS bf16_t*)(lds + L_VB + (8 * sch + 2 * i + 1) * VROW + skey * 2) = (bf16_t)(vw[i] >> 16); } }
        __syncthreads();
        const float b31 = rbl[255];
#pragma unroll 1
        for (int it = 0; it < nitem; ++it) {
            const int buf = it & 1;
            int jn = 0; bool winn = false; const bool hasn = it + 1 < nitem;
            if (hasn) { const bool isw = it + 1 >= nslc; jn = isw ? jw0 + (it + 1 - nslc) : __builtin_ctz(uni); winn = isw; if (!isw) uni &= uni - 1;
                const bf16_t* src = kvb + (size_t)(64 * jn + skey) * LD_NB + (winn ? 4 * 256 : 2 * 256) + sch * 8; kreg = *(const u32x4*)src; vreg = *(const u32x4*)(src + 256); }
            if (wincur && it == nslc && nslc > 0) { const float sc_ = g1 * __builtin_amdgcn_rcpf(l);
#pragma unroll
                for (int i = 0; i < 16; ++i) { y[0][i] += sc_ * o[0][i]; y[1][i] += sc_ * o[1][i]; o[0][i] = 0.f; o[1][i] = 0.f; }
                m = -1e30f; l = 0.f; }
            f32x16 p0, p1;
#pragma unroll
            for (int i = 0; i < 16; ++i) { p0[i] = 0.f; p1[i] = 0.f; }
            { const LAS unsigned char* kb = lds + L_KB + buf * 64 * KROW + r32 * KROW + hi * 16;
#pragma unroll
                for (int ds = 0; ds < 4; ++ds) { const bf16x8 a0 = *(const LAS bf16x8*)(kb + ds * 32), a1 = *(const LAS bf16x8*)(kb + 32 * KROW + ds * 32); p0 = MFMA32(a0, qf[ds], p0); p1 = MFMA32(a1, qf[ds], p1); } }
            const int dj = c - jcur;
            float bm = -1e30f;
            if (!wincur && dj >= 3) {
                const float cst = ((mymask >> jcur) & 1u) ? b31 : NEG;
#pragma unroll
                for (int i = 0; i < 16; ++i) { p0[i] = p0[i] * LOG2E + cst; p1[i] = p1[i] * LOG2E + cst; bm = fmaxf(bm, fmaxf(p0[i], p1[i])); }
            } else {
                const bool lane_ok = wincur || ((mymask >> jcur) & 1u); const int base = 64 * dj + qidx;
#pragma unroll
                for (int i = 0; i < 16; ++i) { const int kk = (i & 3) + 8 * (i >> 2) + 4 * hi; const int d0 = base - kk, d1 = d0 - 32;
                    const bool v0 = lane_ok && (unsigned)d0 < 256u, v1 = lane_ok && (unsigned)d1 < 256u;
                    const float t0 = rbl[(unsigned)d0 < 256u ? d0 : 0], t1 = rbl[(unsigned)d1 < 256u ? d1 : 0];
                    p0[i] = v0 ? p0[i] * LOG2E + t0 : NEG; p1[i] = v1 ? p1[i] * LOG2E + t1 : NEG; bm = fmaxf(bm, fmaxf(p0[i], p1[i])); }
            }
            bm = fmaxf(bm, other_half(bm, hi));
            const float mn = fmaxf(m, bm), alpha = __builtin_amdgcn_exp2f(m - mn); m = mn;
            float ls = 0.f;
#pragma unroll
            for (int i = 0; i < 16; ++i) { p0[i] = __builtin_amdgcn_exp2f(p0[i] - mn); p1[i] = __builtin_amdgcn_exp2f(p1[i] - mn); ls += p0[i] + p1[i]; }
            ls += other_half(ls, hi); l = l * alpha + ls;
            if (__any(alpha != 1.f)) {
#pragma unroll
                for (int i = 0; i < 16; ++i) { o[0][i] *= alpha; o[1][i] *= alpha; } }
            { const LAS unsigned char* vbp = lds + L_VB + buf * 64 * VROW + r32 * VROW + 8 * hi;
#pragma unroll
                for (int ks = 0; ks < 4; ++ks) { const bf16x8 pf = (ks < 2) ? pack8(p0, (ks & 1) * 8) : pack8(p1, (ks & 1) * 8);
#pragma unroll
                    for (int dt = 0; dt < 2; ++dt) { const LAS unsigned char* vp = vbp + dt * 32 * VROW + ks * 32;
                        const u32x2 va = *(const LAS u32x2*)vp, vb = *(const LAS u32x2*)(vp + 16); const u32x4 vw = {va.x, va.y, vb.x, vb.y};
                        o[dt] = MFMA32(__builtin_bit_cast(bf16x8, vw), pf, o[dt]); } } }
            if (hasn) { *(LAS u32x4*)(lds + L_KB + (buf ^ 1) * 64 * KROW + skey * KROW + sch * 16) = kreg; const unsigned vw[4] = {vreg.x, vreg.y, vreg.z, vreg.w};
#pragma unroll
                for (int i = 0; i < 4; ++i) { *(LAS bf16_t*)(lds + L_VB + (buf ^ 1) * 64 * VROW + (8 * sch + 2 * i) * VROW + skey * 2) = (bf16_t)(vw[i] & 0xffffu); *(LAS bf16_t*)(lds + L_VB + (buf ^ 1) * 64 * VROW + (8 * sch + 2 * i + 1) * VROW + skey * 2) = (bf16_t)(vw[i] >> 16); } }
            jcur = jn; wincur = winn;
            __syncthreads();
        }
        { const float sc_ = g2 * __builtin_amdgcn_rcpf(l);
#pragma unroll
            for (int i = 0; i < 16; ++i) { y[0][i] += sc_ * o[0][i]; y[1][i] += sc_ * o[1][i]; } }
        { bf16_t* yp = NBp + trow * LD_NB + h * 64 + 4 * hi;
#pragma unroll
            for (int dt = 0; dt < 2; ++dt)
#pragma unroll
                for (int gq = 0; gq < 4; ++gq) { u32x2 wv; wv.x = pg8::cvt_pk_bf16(y[dt][4 * gq], y[dt][4 * gq + 1]); wv.y = pg8::cvt_pk_bf16(y[dt][4 * gq + 2], y[dt][4 * gq + 3]); *(u32x2*)(yp + 32 * dt + 8 * gq) = wv; } }
        __syncthreads();
    }
}

__device__ __forceinline__ void ph_gla(Ctx& F) {
    const int L = F.L;
    const bf16_t* NBp = (const bf16_t*)(F.ws + WS_NB); bf16_t* GB = (bf16_t*)(F.ws + WS_GB);
    LAS float* sq = (LAS float*)F.lds; LAS float* sk = sq + 128; LAS float* sa = sk + 128; LAS float* so = sa + 128; LAS float* sss = so + 1024;
    const int e = F.tid & 255, half = F.tid >> 8;
    for (int unit = F.bid; unit < 32; unit += F.G) {
        const int b = unit >> 2, h = unit & 3;
        float S[64];
#pragma unroll
        for (int i = 0; i < 64; ++i) S[i] = 0.f;
        float wa[16]; float ba = 0.f;
        if (F.tid < 128) { const float* w = F.ap->in[I_WA2] + (size_t)L * 16 * 512 + h * 128 + F.tid;
#pragma unroll
            for (int r = 0; r < 16; ++r) wa[r] = w[r * 512];
            ba = F.ap->in[I_BA][L * 512 + h * 128 + F.tid]; }
        const float gn = F.ap->in[I_GNORM][L * 256 + e];
#pragma unroll 1
        for (int s = 0; s < NS; ++s) {
            const size_t t = (size_t)b * NS + s; bf16_t* row = GB + t * LD_GB;
            if (F.tid < 128) { const bf16_t* lr = NBp + t * LD_NB + 2608; float z = ba;
#pragma unroll
                for (int r = 0; r < 16; ++r) z += bf1(lr[r]) * wa[r];
                const float ls = (z < 0.f ? z : 0.f) - __logf(1.f + __expf(-fabsf(z)));
                sa[F.tid] = __expf(ls * (1.f / 16.f)); sq[F.tid] = bf1(row[h * 128 + F.tid]) * 0.08838834764831845f; sk[F.tid] = bf1(row[512 + h * 128 + F.tid]); }
            __syncthreads();
            const float v = bf1(row[1024 + h * 256 + e]); float acc = 0.f;
#pragma unroll
            for (int i = 0; i < 64; ++i) { const int dk = half * 64 + i; S[i] = sa[dk] * S[i] + sk[dk] * v; acc += sq[dk] * S[i]; }
            so[(s & 1) * 512 + half * 256 + e] = acc;
            __syncthreads();
            if (F.tid < 256) { const float ov = so[(s & 1) * 512 + e] + so[(s & 1) * 512 + 256 + e]; const float ss = wave_sum(ov * ov);
                if (F.lane == 0) sss[(s & 1) * 4 + F.wave] = ss;
                acc = ov; }
            __syncthreads();
            if (F.tid < 256) { const float tot = sss[(s & 1) * 4] + sss[(s & 1) * 4 + 1] + sss[(s & 1) * 4 + 2] + sss[(s & 1) * 4 + 3];
                bf16_t* op = row + 2048 + h * 256 + e; const float og = bf1(*op);
                *op = (bf16_t)f2bf(acc * __builtin_amdgcn_rsqf(tot * (1.f / 256.f) + EPS) * gn * (og * sigmoidf_(og))); }
        }
        __syncthreads();
    }
}

constexpr size_t WS_ATTG = WS_XA + 12 * MiB;
constexpr size_t WS_DEC = WS_XA + 20 * MiB;
__device__ __forceinline__ void ph_gla1(Ctx& F) {
    const int L = F.L;
    const bf16_t* NBp = (const bf16_t*)(F.ws + WS_NB); bf16_t* GB = (bf16_t*)(F.ws + WS_GB);
    bf16_t* ATT = (bf16_t*)(F.ws + WS_ATTG); float* DEC = (float*)(F.ws + WS_DEC);
    LAS unsigned char* lds = F.lds;
    constexpr int QROW = 272, L_QT = 0, L_KT = 64 * QROW, L_GS = 2 * 64 * QROW;
    const int tid = F.tid, dk = tid & 127, tg = tid >> 7, lane = F.lane, w = F.wave, r32 = lane & 31, hi = lane >> 5;
    for (int unit = F.bid; unit < 1024; unit += F.G) {
        const int bh = unit >> 5, chunk = unit & 31, b = bh >> 2, h = bh & 3; const size_t t0 = (size_t)b * NS + chunk * 64;
        float wa[16];
        { const float* wp = F.ap->in[I_WA2] + (size_t)L * 16 * 512 + h * 128 + dk;
#pragma unroll
            for (int r = 0; r < 16; ++r) wa[r] = wp[r * 512]; }
        const float ba = F.ap->in[I_BA][L * 512 + h * 128 + dk];
        float bl[16]; float cs = 0.f;
#pragma unroll
        for (int i = 0; i < 16; ++i) { const bf16_t* lr = NBp + (t0 + tg * 16 + i) * LD_NB + 2608; const u32x4 l0 = *(const u32x4*)lr, l1 = *(const u32x4*)(lr + 8);
            float z = ba; z += bflo(l0.x) * wa[0] + bfhi(l0.x) * wa[1] + bflo(l0.y) * wa[2] + bfhi(l0.y) * wa[3] + bflo(l0.z) * wa[4] + bfhi(l0.z) * wa[5] + bflo(l0.w) * wa[6] + bfhi(l0.w) * wa[7];
            z += bflo(l1.x) * wa[8] + bfhi(l1.x) * wa[9] + bflo(l1.y) * wa[10] + bfhi(l1.y) * wa[11] + bflo(l1.z) * wa[12] + bfhi(l1.z) * wa[13] + bflo(l1.w) * wa[14] + bfhi(l1.w) * wa[15];
            const float ls = (z < 0.f ? z : 0.f) - __logf(1.f + __expf(-fabsf(z))); cs += ls * (1.f / 16.f); bl[i] = cs; }
        ((LAS float*)(lds + L_GS))[tg * 128 + dk] = cs;
        __syncthreads();
        float off = 0.f, tot = 0.f;
#pragma unroll
        for (int gI = 0; gI < 4; ++gI) { const float v = ((const LAS float*)(lds + L_GS))[gI * 128 + dk]; tot += v; off += gI < tg ? v : 0.f; }
#pragma unroll
        for (int i = 0; i < 16; ++i) { const int tok = tg * 16 + i; bf16_t* row = GB + (t0 + tok) * LD_GB + h * 128 + dk; const float bb = bl[i] + off;
            const float q = bf1(row[0]) * 0.08838834764831845f, k = bf1(row[512]);
            const unsigned qt = f2bf(q * __expf(bb)), kt = f2bf(k * __expf(-bb)), ke = f2bf(k * __expf(tot - bb));
            *(LAS bf16_t*)(lds + L_QT + tok * QROW + dk * 2) = (bf16_t)qt; *(LAS bf16_t*)(lds + L_KT + tok * QROW + dk * 2) = (bf16_t)kt;
            row[0] = (bf16_t)qt; row[512] = (bf16_t)ke; }
        if (tg == 0) DEC[((size_t)bh * 32 + chunk) * 128 + dk] = __expf(tot);
        __syncthreads();
        if (w < 4) { const int ti = w >> 1, tj = w & 1; f32x16 acc;
#pragma unroll
            for (int i = 0; i < 16; ++i) acc[i] = 0.f;
            if (!(ti == 0 && tj == 1)) {
#pragma unroll
                for (int ds = 0; ds < 8; ++ds) { const bf16x8 a = *(const LAS bf16x8*)(lds + L_QT + (32 * ti + r32) * QROW + ds * 32 + hi * 16), bq = *(const LAS bf16x8*)(lds + L_KT + (32 * tj + r32) * QROW + ds * 32 + hi * 16);
                    acc = MFMA32(a, bq, acc); } }
            bf16_t* ap = ATT + ((size_t)bh * 32 + chunk) * 4096; const int col = 32 * tj + r32;
#pragma unroll
            for (int i = 0; i < 16; ++i) { const int rowi = 32 * ti + (i & 3) + 8 * (i >> 2) + 4 * hi; ap[rowi * 64 + col] = (bf16_t)f2bf(col <= rowi ? acc[i] : 0.f); } }
        __syncthreads();
    }
}
__device__ __forceinline__ void ph_gla2(Ctx& F) {
    const int L = F.L;
    bf16_t* GB = (bf16_t*)(F.ws + WS_GB); const bf16_t* ATT = (const bf16_t*)(F.ws + WS_ATTG); const float* DEC = (const float*)(F.ws + WS_DEC);
    LAS unsigned char* lds = F.lds;
    constexpr int QROW = 272, TROW = 144, G_QT = 0, G_KE = 64 * QROW, G_AT = G_KE + 128 * TROW, G_VT = G_AT + 64 * TROW, G_DEC = G_VT + 256 * TROW, G_SS = G_DEC + 512, G_END = G_SS + 2048;
    static_assert(G_END <= 140000, "gla LDS map");
    const int tid = F.tid, lane = F.lane, w = F.wave, r32 = lane & 31, hi = lane >> 5, eb = 32 * w;
    for (int unit = F.bid; unit < 32; unit += F.G) {
        const int bh = unit, b = bh >> 2, h = bh & 3;
        f32x16 S[4];
#pragma unroll
        for (int t = 0; t < 4; ++t)
#pragma unroll
            for (int i = 0; i < 16; ++i) S[t][i] = 0.f;
        const float* gnp = F.ap->in[I_GNORM] + L * 256 + eb + 4 * hi;
        u32x4 pq[2], pk[2], pa, pv[4]; float pd = 0.f;
#define GLA_LOAD(CH) do { int tl_ = tid; asm volatile("" : "+v"(tl_)); const size_t t0_ = (size_t)b * NS + (CH) * 64; \
            { const bf16_t* src = GB + (t0_ + (tl_ >> 4)) * LD_GB + h * 128 + (tl_ & 15) * 8; pq[0] = *(const u32x4*)src; pk[0] = *(const u32x4*)(src + 512); pq[1] = *(const u32x4*)(src + (size_t)32 * LD_GB); pk[1] = *(const u32x4*)(src + (size_t)32 * LD_GB + 512); } \
            pa = *(const u32x4*)(ATT + ((size_t)bh * 32 + (CH)) * 4096 + tl_ * 8); \
            { const bf16_t* src = GB + (t0_ + (tl_ >> 5)) * LD_GB + 1024 + h * 256 + (tl_ & 31) * 8; pv[0] = *(const u32x4*)src; pv[1] = *(const u32x4*)(src + (size_t)16 * LD_GB); pv[2] = *(const u32x4*)(src + (size_t)32 * LD_GB); pv[3] = *(const u32x4*)(src + (size_t)48 * LD_GB); } \
            if (tl_ < 128) pd = DEC[((size_t)bh * 32 + (CH)) * 128 + tl_]; } while (0)
#define GLA_T8(PTR, V) do { const unsigned vw_[4] = {(V).x, (V).y, (V).z, (V).w}; \
            _Pragma("unroll") for (int i_ = 0; i_ < 4; ++i_) { *(LAS bf16_t*)((PTR) + (2 * i_) * TROW) = (bf16_t)(vw_[i_] & 0xffffu); *(LAS bf16_t*)((PTR) + (2 * i_ + 1) * TROW) = (bf16_t)(vw_[i_] >> 16); } } while (0)
#define GLA_STAGE() do { int tl_ = tid; asm volatile("" : "+v"(tl_)); \
            { LAS unsigned char* qd = lds + G_QT + (tl_ >> 4) * QROW + (tl_ & 15) * 16; *(LAS u32x4*)qd = pq[0]; *(LAS u32x4*)(qd + 32 * QROW) = pq[1]; \
              LAS unsigned char* kd = lds + G_KE + (8 * (tl_ & 15)) * TROW + (tl_ >> 4) * 2; GLA_T8(kd, pk[0]); GLA_T8(kd + 64, pk[1]); } \
            *(LAS u32x4*)(lds + G_AT + (tl_ >> 3) * TROW + (tl_ & 7) * 16) = pa; \
            { LAS unsigned char* vd = lds + G_VT + (8 * (tl_ & 31)) * TROW + (tl_ >> 5) * 2; GLA_T8(vd, pv[0]); GLA_T8(vd + 32, pv[1]); GLA_T8(vd + 64, pv[2]); GLA_T8(vd + 96, pv[3]); } \
            if (tl_ < 128) ((LAS float*)(lds + G_DEC))[tl_] = pd; } while (0)
        GLA_LOAD(0);
        GLA_STAGE();
#pragma unroll 1
        for (int chunk = 0; chunk < 32; ++chunk) {
            __syncthreads();
            if (chunk + 1 < 32) GLA_LOAD(chunk + 1);
            bf16x8 vf[4];
#pragma unroll
            for (int ks = 0; ks < 4; ++ks) vf[ks] = *(const LAS bf16x8*)(lds + G_VT + (eb + r32) * TROW + ks * 32 + hi * 16);
            f32x16 o[2];
#pragma unroll
            for (int i = 0; i < 16; ++i) { o[0][i] = 0.f; o[1][i] = 0.f; }
#pragma unroll
            for (int tt = 0; tt < 2; ++tt)
#pragma unroll
                for (int ks = 0; ks < 4; ++ks) { if (tt == 0 && ks >= 2) continue; const bf16x8 af = *(const LAS bf16x8*)(lds + G_AT + (32 * tt + r32) * TROW + ks * 32 + hi * 16); o[tt] = MFMA32(vf[ks], af, o[tt]); }
            __builtin_amdgcn_sched_barrier(0);
#pragma unroll
            for (int t = 0; t < 4; ++t)
#pragma unroll
                for (int s2 = 0; s2 < 2; ++s2) { const bf16x8 sa = pack8(S[t], 8 * s2);
#pragma unroll
                    for (int tt = 0; tt < 2; ++tt) { const LAS unsigned char* qp = lds + G_QT + (32 * tt + r32) * QROW + (32 * t + 16 * s2 + 4 * hi) * 2;
                        const u32x2 qa = *(const LAS u32x2*)qp, qb = *(const LAS u32x2*)(qp + 16); const u32x4 qw = {qa.x, qa.y, qb.x, qb.y};
                        o[tt] = MFMA32(sa, __builtin_bit_cast(bf16x8, qw), o[tt]); }
                    __builtin_amdgcn_sched_barrier(0); }
#pragma unroll
            for (int t = 0; t < 4; ++t) {
#pragma unroll
                for (int i = 0; i < 16; ++i) S[t][i] *= ((const LAS float*)(lds + G_DEC))[32 * t + (i & 3) + 8 * (i >> 2) + 4 * hi];
#pragma unroll
                for (int ks = 0; ks < 4; ++ks) { const bf16x8 kf = *(const LAS bf16x8*)(lds + G_KE + (32 * t + r32) * TROW + ks * 32 + hi * 16); S[t] = MFMA32(kf, vf[ks], S[t]); }
                __builtin_amdgcn_sched_barrier(0); }
#pragma unroll
            for (int tt = 0; tt < 2; ++tt) { float ss = 0.f;
#pragma unroll
                for (int i = 0; i < 16; ++i) ss += o[tt][i] * o[tt][i];
                ss += other_half(ss, hi); if (hi == 0) ((LAS float*)(lds + G_SS))[w * 64 + 32 * tt + r32] = ss; }
            __syncthreads();
            if (chunk + 1 < 32) GLA_STAGE();
            const size_t t0 = (size_t)b * NS + chunk * 64;
#pragma unroll
            for (int tt = 0; tt < 2; ++tt) { float tot = 0.f;
#pragma unroll
                for (int ww = 0; ww < 8; ++ww) tot += ((const LAS float*)(lds + G_SS))[ww * 64 + 32 * tt + r32];
                const float rstd = __builtin_amdgcn_rsqf(tot * (1.f / 256.f) + EPS);
                bf16_t* op = GB + (t0 + 32 * tt + r32) * LD_GB + 2048 + h * 256 + eb + 4 * hi;
#pragma unroll
                for (int gq = 0; gq < 4; ++gq) { const u32x2 ow = *(const u32x2*)(op + 8 * gq); const float og[4] = {bflo(ow.x), bfhi(ow.x), bflo(ow.y), bfhi(ow.y)}; float r[4];
#pragma unroll
                    for (int k = 0; k < 4; ++k) r[k] = o[tt][4 * gq + k] * rstd * gnp[8 * gq + k] * (og[k] * sigmoidf_(og[k]));
                    u32x2 wv; wv.x = pg8::cvt_pk_bf16(r[0], r[1]); wv.y = pg8::cvt_pk_bf16(r[2], r[3]); *(u32x2*)(op + 8 * gq) = wv; } }
        }
        __syncthreads();
#undef GLA_LOAD
#undef GLA_T8
#undef GLA_STAGE
    }
}

template <bool WITH_H> __device__ __forceinline__ void ph_res(Ctx& F, const float* xsrc, const float* gz, const float* gh) {
    const float* Z = (const float*)(F.ws + WS_XA); bf16_t* H = (bf16_t*)(F.ws + WS_H); float* out = F.out;
    const int gw = F.bid * NWAVES + F.wave, NGW = F.G * NWAVES;
    for (int m = gw; m < NT; m += NGW) {
        const f32x4* zr = (const f32x4*)(Z + (size_t)m * ND) + F.lane; const f32x4* xr = (const f32x4*)(xsrc + (size_t)m * ND) + F.lane;
        f32x4 z[4], x[4]; float s = 0.f;
#pragma unroll
        for (int j = 0; j < 4; ++j) { z[j] = zr[64 * j]; x[j] = xr[64 * j]; s += (z[j].x * z[j].x + z[j].y * z[j].y) + (z[j].z * z[j].z + z[j].w * z[j].w); }
        const float rstd = __builtin_amdgcn_rsqf(wave_sum(s) * (1.f / ND) + EPS); float s2 = 0.f;
#pragma unroll
        for (int j = 0; j < 4; ++j) { const f32x4 gg = ((const f32x4*)gz + F.lane)[64 * j]; x[j] = x[j] + z[j] * rstd * gg; ((f32x4*)(out + (size_t)m * ND) + F.lane)[64 * j] = x[j];
            s2 += (x[j].x * x[j].x + x[j].y * x[j].y) + (x[j].z * x[j].z + x[j].w * x[j].w); }
        if (WITH_H) { const float r2 = __builtin_amdgcn_rsqf(wave_sum(s2) * (1.f / ND) + EPS); unsigned long long* o8 = (unsigned long long*)(H + (size_t)m * ND) + F.lane;
#pragma unroll
            for (int j = 0; j < 4; ++j) { const f32x4 gg = ((const f32x4*)gh + F.lane)[64 * j];
                o8[64 * j] = (unsigned long long)pk2(x[j].x * r2 * gg.x, x[j].y * r2 * gg.y) | ((unsigned long long)pk2(x[j].z * r2 * gg.z, x[j].w * r2 * gg.w) << 32); } }
    }
}

template <int p> __device__ __forceinline__ void run_phase(Ctx& F, const int L) {
    using namespace pg8;
    unsigned char* ws = F.ws;
        F.L = L; F.xin = (L == 0) ? F.ap->in[I_X] : F.out;
        const float* ng = F.ap->in[I_NORMG] + (size_t)L * 4 * ND;
        StaticOrder S;
        switch (p) {
        case PH_PRE: if constexpr (PH_ON(PH_PRE)) { ph_pre(F); } break;
        case PH_G1: if constexpr (PH_ON(PH_G1)) { { Gemm g{(const bf16_t*)(ws + WS_H), (const bf16_t*)(ws + W_G1), 1024, 1024, 1024, 128}; S.init(64, 8, F.G, F.bid);
            EpiStore<0> E{{(bf16_t*)(ws + WS_XA), 1024, 0}, {(bf16_t*)(ws + WS_GA), 1024, 4}, {nullptr, 0, 0}, 4, 1 << 30, 0, 1.f, 0};
            gemm_phase<EpiStore<0>, true, StaticOrder>(F.lds, g, S, E, F.tid); } } break;
        case PH_LCONV: if constexpr (PH_ON(PH_LCONV)) { ph_lconv(F); } break;
        case PH_LGATE: if constexpr (PH_ON(PH_LGATE)) { { Gemm g{(const bf16_t*)(ws + WS_XC), (const bf16_t*)(ws + W_LRU), 1024, 1024, 1024, 128}; S.init(64, 8, F.G, F.bid);
            EpiLru E{(const bf16_t*)(ws + WS_XC), (bf16_t*)(ws + WS_LA), (bf16_t*)(ws + WS_U), F.ap->in[I_LRUB] + (size_t)L * 2048, (const float*)(ws + WS_CTL) + CT_C8};
            gemm_phase<EpiLru, true, StaticOrder>(F.lds, g, S, E, F.tid); } } break;
        case PH_LSCAN: if constexpr (PH_ON(PH_LSCAN)) { ph_lscan(F); } break;
        case PH_G23: if constexpr (PH_ON(PH_G23)) { { Gemm g{(const bf16_t*)(ws + WS_H), (const bf16_t*)(ws + W_G23), 1024, 1024, 1024, 128}; S.init(64, 23, F.G, F.bid);
            EpiStore<0> E{{(bf16_t*)(ws + WS_NB), LD_NB, 0}, {(bf16_t*)(ws + WS_GB), LD_GB, 11}, {nullptr, 0, 0}, 11, 1 << 30, 4, 0.125f, 0};
            gemm_phase<EpiStore<0>, true, StaticOrder>(F.lds, g, S, E, F.tid); } } break;
        case PH_CMP1: if constexpr (PH_ON(PH_CMP1)) { {
            Gemm g{(const bf16_t*)(ws + WS_NB) + 1024, (const bf16_t*)(ws + W_C1), 16 * LD_NB, 1024, 1024, LD_NB * 2}; CmpOrder CS{F.G, F.bid, 0};
            EpiStore<0> E{{(bf16_t*)(ws + WS_HID), 512, 0}, {nullptr, 0, 0}, {nullptr, 0, 0}, 1 << 30, 1 << 30, 0, 1.f, (size_t)1024 * 512};
            gemm_phase<EpiStore<0>, false, CmpOrder>(F.lds, g, CS, E, F.tid); } } break;
        case PH_CMP2: if constexpr (PH_ON(PH_CMP2)) { ph_cmp2g(F); } break;
        case PH_SEL: if constexpr (PH_ON(PH_SEL)) { if constexpr (MK_NAIVE_ATT) ph_sel(F); if constexpr (!MK_NAIVE_GLA) ph_gla1(F); } break;
        case PH_ATT: if constexpr (PH_ON(PH_ATT)) { if constexpr (MK_NAIVE_ATT) ph_att(F); else ph_att_mfma(F); } break;
        case PH_GLA: if constexpr (PH_ON(PH_GLA)) { if constexpr (MK_NAIVE_GLA) ph_gla(F); else ph_gla2(F); } break;
        case PH_G4: if constexpr (PH_ON(PH_G4)) { { Gemm g{(const bf16_t*)(ws + WS_H), (const bf16_t*)(ws + W_G4), 1024, 1024, 1024, 128}; S.init(64, 12, F.G, F.bid);
            EpiStore<2> E{{(bf16_t*)(ws + WS_XA), 1024, 0}, {(bf16_t*)(ws + WS_NB) + 1024, LD_NB, 4}, {(bf16_t*)(ws + WS_GB), LD_GB, 8}, 4, 8, 0, 1.f, 0};
            gemm_phase<EpiStore<2>, true, StaticOrder>(F.lds, g, S, E, F.tid); } } break;
        case PH_BR: if constexpr (PH_ON(PH_BR)) { { S.init(64, 4, F.G, F.bid); bf16_t* MO = (bf16_t*)(ws + WS_GB) + 1024;
            { Gemm g{(const bf16_t*)(ws + WS_GA), (const bf16_t*)(ws + W_BR), 1024, 1024, 1024, 128}; EpiBranch<true> E{(const bf16_t*)(ws + WS_XA), 1024, MO, LD_GB}; gemm_phase<EpiBranch<true>, false, StaticOrder>(F.lds, g, S, E, F.tid); }
            { Gemm g{(const bf16_t*)(ws + WS_NB), (const bf16_t*)(ws + W_BR) + (size_t)ND * ND, LD_NB, 1024, 1024, 128}; EpiBranch<false> E{(const bf16_t*)(ws + WS_NB) + 1024, LD_NB, MO, LD_GB}; gemm_phase<EpiBranch<false>, false, StaticOrder>(F.lds, g, S, E, F.tid); }
            { Gemm g{(const bf16_t*)(ws + WS_GB) + 2048, (const bf16_t*)(ws + W_BR) + (size_t)2 * ND * ND, LD_GB, 1024, 1024, 128}; EpiBranch<false> E{(const bf16_t*)(ws + WS_GB), LD_GB, MO, LD_GB}; gemm_phase<EpiBranch<false>, false, StaticOrder>(F.lds, g, S, E, F.tid); } } } break;
        case PH_OUT: if constexpr (PH_ON(PH_OUT)) { { Gemm g{(const bf16_t*)(ws + WS_GB) + 1024, (const bf16_t*)(ws + W_OUT), LD_GB, 1024, 1024, 128}; S.init(64, 4, F.G, F.bid);
            EpiF32 E{(float*)(ws + WS_XA), 1024}; gemm_phase<EpiF32, false, StaticOrder>(F.lds, g, S, E, F.tid); } } break;
        case PH_RES1: if constexpr (PH_ON(PH_RES1)) { ph_res<true>(F, F.xin, ng + 1 * ND, ng + 2 * ND); } break;
        case PH_FI: if constexpr (PH_ON(PH_FI)) { { Gemm g{(const bf16_t*)(ws + WS_H), (const bf16_t*)(ws + W_FI), 1024, 1024, 1024, 128}; S.init(64, 22, F.G, F.bid);
            EpiSwiGLU E{(bf16_t*)(ws + WS_NB), DFF}; gemm_phase<EpiSwiGLU, true, StaticOrder>(F.lds, g, S, E, F.tid); } } break;
        case PH_FO: if constexpr (PH_ON(PH_FO)) { { Gemm g{(const bf16_t*)(ws + WS_NB), (const bf16_t*)(ws + W_FO), DFF, DFF, DFF, 128}; S.init(64, 4, F.G, F.bid);
            EpiF32 E{(float*)(ws + WS_XA), 1024}; gemm_phase<EpiF32, false, StaticOrder>(F.lds, g, S, E, F.tid); } } break;
        case PH_RES2: if constexpr (PH_ON(PH_RES2)) { ph_res<false>(F, F.out, ng + 3 * ND, nullptr); } break;
        }
}
constexpr int LDS_BYTES = 147456;
template <bool COOP> __global__ void __launch_bounds__(NTHR, 2) mk_fwd(Args args) {
    extern __shared__ __attribute__((aligned(16))) unsigned char lds_raw[];
    Ctx F; F.lds = (LAS unsigned char*)lds_raw; F.ldsg = lds_raw;
    F.tid = threadIdx.x; F.lane = F.tid & 63; F.wave = __builtin_amdgcn_readfirstlane(F.tid >> 6); F.G = gridDim.x; F.bid = blockIdx.x;
    const int lo = args.ph_lo, hi = args.ph_hi;
#define MK_PHASE(L_, P_) if (lo <= (L_) * NPH + (P_) && (L_) * NPH + (P_) < hi) { \
        { int bid_ = blockIdx.x; asm volatile("" : "+s"(bid_)); F.bid = bid_; \
          int tid_ = threadIdx.x; asm volatile("" : "+v"(tid_)); F.tid = tid_; F.lane = tid_ & 63; F.wave = __builtin_amdgcn_readfirstlane(tid_ >> 6); \
          unsigned long long apl_ = (unsigned long long)__builtin_amdgcn_kernarg_segment_ptr(); asm volatile("" : "+s"(apl_)); F.ap = (ArgsP)apl_; \
          F.ws = F.ap->ws; F.out = F.ap->out; F.G = gridDim.x; } \
        run_phase<P_>(F, L_); \
        if (COOP) { if ((L_) * NPH + (P_) + 1 < hi) cg::this_grid().sync(); } }
#define MK_LAYER(L_) MK_PHASE(L_, 0) MK_PHASE(L_, 1) MK_PHASE(L_, 2) MK_PHASE(L_, 3) MK_PHASE(L_, 4) MK_PHASE(L_, 5) MK_PHASE(L_, 6) MK_PHASE(L_, 7) MK_PHASE(L_, 8) \
        MK_PHASE(L_, 9) MK_PHASE(L_, 10) MK_PHASE(L_, 11) MK_PHASE(L_, 12) MK_PHASE(L_, 13) MK_PHASE(L_, 14) MK_PHASE(L_, 15) MK_PHASE(L_, 16) MK_PHASE(L_, 17)
    MK_LAYER(0)
    MK_LAYER(1)
}

extern "C" void kernel_launch(void* const* d_in, const int* in_sizes, int n_in, void* d_out, int out_size, void* d_ws, size_t ws_size, hipStream_t stream) {
    static int grid = 0;
    if (grid == 0) {
        if (n_in != 19 || out_size != NT * ND || ws_size < WS_END) { fprintf(stderr, "kernel_launch: unexpected shapes/workspace (n_in %d out %d ws %zu need %zu)\n", n_in, out_size, ws_size, (size_t)WS_END); grid = -1; return; }
        int dev = 0, cus = 0, per_cu = 0;
        hipGetDevice(&dev); hipDeviceGetAttribute(&cus, hipDeviceAttributeMultiprocessorCount, dev);
        hipFuncSetAttribute((const void*)mk_fwd<true>, hipFuncAttributeMaxDynamicSharedMemorySize, LDS_BYTES);
        hipFuncSetAttribute((const void*)mk_fwd<false>, hipFuncAttributeMaxDynamicSharedMemorySize, LDS_BYTES);
        hipOccupancyMaxActiveBlocksPerMultiprocessor(&per_cu, (const void*)mk_fwd<true>, NTHR, LDS_BYTES);
        if (per_cu < 1) { fprintf(stderr, "kernel_launch: occupancy query says %d blocks/CU\n", per_cu); per_cu = 1; }
        (void)hipGetLastError();
        grid = cus;
    }
    if (grid < 0) return;
    Args a{};
    for (int i = 0; i < 19; ++i) a.in[i] = (const float*)d_in[i];
    a.out = (float*)d_out; a.ws = (unsigned char*)d_ws;
#if MK_COOP
    a.ph_lo = 0; a.ph_hi = 2 * NPH;
    void* kargs[] = {&a};
    hipError_t e = hipLaunchCooperativeKernel((const void*)mk_fwd<true>, dim3(grid), dim3(NTHR), kargs, LDS_BYTES, stream);
    if (e != hipSuccess) fprintf(stderr, "cooperative launch failed: %s (grid %d)\n", hipGetErrorString(e), grid);
#else
    for (int ph = 0; ph < 2 * NPH; ++ph) {
        a.ph_lo = ph; a.ph_hi = ph + 1;
        hipLaunchKernelGGL(mk_fwd<false>, dim3(grid), dim3(NTHR), LDS_BYTES, stream, a);
    }
#endif
}
```

```cpp
#include <hip/hip_runtime.h>
#include <hip/hip_cooperative_groups.h>
#include <cstdio>
#include <cstdint>
namespace cg = cooperative_groups;

#ifndef MK_COOP
#define MK_COOP 1
#endif
#ifndef MK_DUP
#define MK_DUP 0u
#endif
#ifndef MK_DRY
#define MK_DRY 0u
#endif
#ifndef MK_XSYNC
#define MK_XSYNC 0
#endif
#ifndef MK_PM
#define MK_PM 0xFFFFFFFFu
#endif
#define PH_ON(p) (((MK_PM) >> (p)) & 1u)

#define LAS __attribute__((address_space(3)))
typedef unsigned short bf16_t;
typedef short bf16x8 __attribute__((ext_vector_type(8)));
typedef float f32x4 __attribute__((ext_vector_type(4)));
typedef float f32x2 __attribute__((ext_vector_type(2)));
typedef unsigned u32x4 __attribute__((ext_vector_type(4)));
typedef unsigned u32x2 __attribute__((ext_vector_type(2)));

constexpr int NB_ = 8, NS = 2048, ND = 1024, NT = NB_ * NS;
constexpr int IN_W = 10816, DFF = 2816;
constexpr int LD_NB = 2816, LD_GB = 3072;
constexpr float EPS = 1e-6f;
constexpr int NTHR = 512, NWAVES = 8;

constexpr size_t MiB = 1u << 20;
constexpr size_t WS_CTL = 0;
constexpr size_t WS_W = 1 * MiB;
constexpr size_t W_G1 = WS_W;
constexpr size_t W_G23 = W_G1 + 4 * MiB;
constexpr size_t W_G4 = W_G23 + 5888ull * 1024 * 2;
constexpr size_t W_LRU = W_G4 + 6 * MiB;
constexpr size_t W_BR = W_LRU + 4 * MiB;
constexpr size_t W_OUT = W_BR + 6 * MiB;
constexpr size_t W_FI = W_OUT + 2 * MiB;
constexpr size_t W_FO = W_FI + 11 * MiB;
constexpr size_t W_C1 = W_FO + 1024ull * 2816 * 2;
constexpr size_t W_END = W_C1 + 2 * MiB;
constexpr size_t WS_H = 54 * MiB;
constexpr size_t WS_XA = 86 * MiB;
constexpr size_t WS_GA = 118 * MiB;
constexpr size_t WS_NB = 150 * MiB;
constexpr size_t WS_GB = 238 * MiB;
constexpr size_t WS_END = 334 * MiB;
static_assert(W_END <= WS_H, "weights region");
constexpr size_t WS_XC = WS_NB, WS_LA = WS_NB + 32 * MiB, WS_U = WS_NB + 64 * MiB;
constexpr size_t WS_HID = WS_XA + 23 * MiB + 512 * 1024;
constexpr size_t WS_KC = WS_XA + 22 * MiB + 512 * 1024;
constexpr int CT_C8 = 0;
constexpr int CT_RB = 1024;
constexpr int CT_C1 = 4096;
constexpr int CT_C1P = 8192;

__device__ __forceinline__ unsigned f2bf(float f) { unsigned u = __float_as_uint(f); return (u + 0x7fffu + ((u >> 16) & 1u)) >> 16; }
__device__ __forceinline__ unsigned pk2(float lo, float hi) { return f2bf(lo) | (f2bf(hi) << 16); }
__device__ __forceinline__ float bflo(unsigned w) { return __uint_as_float(w << 16); }
__device__ __forceinline__ float bfhi(unsigned w) { return __uint_as_float(w & 0xffff0000u); }
__device__ __forceinline__ float bf1(bf16_t h) { return __uint_as_float((unsigned)h << 16); }
__device__ __forceinline__ float sigmoidf_(float x) { return __builtin_amdgcn_rcpf(1.f + __expf(-x)); }
__device__ __forceinline__ float gelu_tanh(float x) { const float u = 1.5957691216057308f * (x + 0.044715f * x * x * x); return x * sigmoidf_(u); }
__device__ __forceinline__ float wave_sum(float v) {
    v += __int_as_float(__builtin_amdgcn_ds_swizzle(__float_as_int(v), 0x041f));
    v += __int_as_float(__builtin_amdgcn_ds_swizzle(__float_as_int(v), 0x081f));
    v += __int_as_float(__builtin_amdgcn_ds_swizzle(__float_as_int(v), 0x101f));
    v += __int_as_float(__builtin_amdgcn_ds_swizzle(__float_as_int(v), 0x201f));
    v += __int_as_float(__builtin_amdgcn_ds_swizzle(__float_as_int(v), 0x401f));
    auto rr = __builtin_amdgcn_permlane32_swap(__float_as_uint(v), __float_as_uint(v), false, false);
    return __uint_as_float(rr[0]) + __uint_as_float(rr[1]);
}
__device__ __forceinline__ int rel_bucket(int n) {
    if (n < 16) return n;
    int b = 16;
    b += (n >= 19) + (n >= 21) + (n >= 24) + (n >= 27) + (n >= 31) + (n >= 35) + (n >= 40) + (n >= 46) + (n >= 52) + (n >= 59) + (n >= 67) + (n >= 77) + (n >= 87) + (n >= 99) + (n >= 113);
    return b;
}

namespace pg8 {
constexpr int BM = 256, BK = 64, HALF = 128, HTB = HALF * BK * 2, STAGE_BYTES = 8 * HTB, NXCD = 8, WGM = 8;
__device__ __forceinline__ int lds_byte(int r, int c) { const int st = (r >> 4) * 2 + (c >> 5), rr = r & 15, cc = c & 31, ob = rr * 64 + cc * 2; return st * 1024 + (ob ^ (((ob >> 9) & 1) << 5)); }
__device__ __forceinline__ void stage_rc(int b, int& R, int& C) { const int st = b / 1024, sb = b % 1024, swz = sb ^ (((sb >> 9) & 1) << 5); R = (st >> 1) * 16 + swz / 64; C = (st & 1) * 32 + (swz % 64) / 2; }
__device__ __forceinline__ int perm32(int rho) { const int n = rho >> 4, i = rho & 15; return 8 * (i >> 2) + 4 * n + (i & 3); }

struct Unit { int pm, pn, z; };
struct Gemm { const bf16_t* A; const bf16_t* Bt; int lda, ldb, K, kstepA; };

struct StaticOrder {
    int nM, nN, nwg, G, c;
    __device__ void init(int nM_, int nN_, int G_, int c_) { nM = nM_; nN = nN_; nwg = nM * nN; G = G_; c = c_; }
    __device__ bool next(int i, Unit& u) const {
        const long L = (long)i * G + c; if (L >= nwg) return false;
        int wgid = (int)L; { const int q = nwg / NXCD, r = nwg % NXCD, xcd = wgid % NXCD, off = wgid / NXCD; wgid = (xcd < r ? xcd * (q + 1) : r * (q + 1) + (xcd - r) * q) + off; }
        const int nig = WGM * nN, gid = wgid / nig, fm = gid * WGM, gsz = (nM - fm) < WGM ? (nM - fm) : WGM;
        u.pm = fm + ((wgid % nig) % gsz); u.pn = (wgid % nig) / gsz; u.z = 0; return true;
    }
    __device__ __forceinline__ size_t aoff(const Unit& u, size_t ta) const { return (size_t)u.pm * ta; }
    __device__ __forceinline__ size_t boff(const Unit& u, size_t tb) const { return (size_t)u.pn * tb; }
};
struct LruOrder : StaticOrder {
    __device__ __forceinline__ size_t aoff(const Unit& u, size_t ta) const { return (size_t)u.pm * ta + (size_t)(u.pn >> 1) * 512; }
};
struct CmpOrder {
    int G, c, base;
    __device__ bool next(int i, Unit& u) const { if (i > 0) return false; const int k = c - base; if (k < 0 || k >= 64) return false; u.z = k >> 3; u.pm = (k & 7) >> 1; u.pn = k & 1; return true; }
    __device__ __forceinline__ size_t aoff(const Unit& u, size_t ta) const { return (size_t)u.pm * ta + (size_t)((u.z >> 2) * 256 + (u.z & 3) * 64) * 2; }
    __device__ __forceinline__ size_t boff(const Unit& u, size_t tb) const { return (size_t)u.pn * tb + (size_t)(u.z >> 2) * 512 * 1024 * 2; }
};

typedef __bf16 bf16x2_t __attribute__((ext_vector_type(2)));
__device__ __forceinline__ unsigned cvt_pk_bf16(float lo, float hi) { const f32x2 v = {lo, hi}; const bf16x2_t b = __builtin_convertvector(v, bf16x2_t); return __builtin_bit_cast(unsigned, b); }

struct Seg { bf16_t* base; int ld; int tile0; };
template <int ACT  > struct EpiStore {
    static constexpr bool PERM = true;
    Seg s0, s1, s2; int t1, t2; int nscale; float scale; size_t zs;
    __device__ __forceinline__ void operator()(const f32x4 (&acc)[2][2][4][2], const Unit& u, int wr, int wc, int fr, int fq) const {
        const bool c1_ = u.pn < t1, c2_ = u.pn < t2;
        bf16_t* const pb0 = s0.base; bf16_t* const pb1 = s1.base; bf16_t* const pb2 = s2.base; const int l0 = s0.ld, l1 = s1.ld, l2 = s2.ld, q0 = s0.tile0, q1 = s1.tile0, q2 = s2.tile0;
        bf16_t* base = (c1_ ? pb0 : (c2_ ? pb1 : pb2)) + (size_t)u.z * zs; const int ld = c1_ ? l0 : (c2_ ? l1 : l2), t0 = c1_ ? q0 : (c2_ ? q1 : q2);
        const float sc = u.pn < nscale ? scale : 1.f;
        const int row0 = u.pm * BM + wr * 64 + fr, col0 = (u.pn - t0) * BM + wc * 32 + 8 * fq;
#pragma unroll
        for (int ai = 0; ai < 2; ++ai)
#pragma unroll
            for (int m = 0; m < 4; ++m) { bf16_t* rowp = base + (size_t)(row0 + ai * HALF + m * 16) * ld + col0;
#pragma unroll
                for (int bj = 0; bj < 2; ++bj) { f32x4 v0 = acc[ai][bj][m][0] * sc, v1 = acc[ai][bj][m][1] * sc;
                    if (ACT == 2) {
#pragma unroll
                        for (int j = 0; j < 4; ++j) { v0[j] = sigmoidf_(v0[j]); v1[j] = sigmoidf_(v1[j]); } }
                    u32x4 w; w.x = cvt_pk_bf16(v0[0], v0[1]); w.y = cvt_pk_bf16(v0[2], v0[3]); w.z = cvt_pk_bf16(v1[0], v1[1]); w.w = cvt_pk_bf16(v1[2], v1[3]);
                    *(u32x4*)(rowp + bj * HALF) = w; }
                if (ACT != 0) __builtin_amdgcn_sched_barrier(0); }
    }
};
struct EpiLru {
    static constexpr bool PERM = false;
    const bf16_t* XC; bf16_t* LA; bf16_t* U; const float* bg; const float* c8;
    __device__ __forceinline__ void operator()(const f32x4 (&acc)[2][2][4][2], const Unit& u, int wr, int wc, int fr, int fq) const {
        const int row0 = u.pm * BM + wr * 64 + fr, ch0 = u.pn * HALF + wc * 32 + 4 * fq;
#pragma unroll
        for (int n = 0; n < 2; ++n) { const int ch = ch0 + n * 16;
            const f32x4 br = *(const f32x4*)(bg + ch), bi = *(const f32x4*)(bg + 1024 + ch), cc = *(const f32x4*)(c8 + ch);
            u32x2 xw = *(const u32x2*)(XC + (size_t)row0 * 1024 + ch);
#pragma unroll
            for (int it = 0; it < 8; ++it) { const int ai = it >> 2, m = it & 3; const size_t off = (size_t)(row0 + ai * HALF + m * 16) * 1024 + ch;
                u32x2 xn = xw; if (it < 7) xn = *(const u32x2*)(XC + (size_t)(row0 + ((it + 1) >> 2) * HALF + ((it + 1) & 3) * 16) * 1024 + ch);
                const float xv[4] = {bflo(xw.x), bfhi(xw.x), bflo(xw.y), bfhi(xw.y)};
                float la[4], uu[4];
#pragma unroll
                for (int j = 0; j < 4; ++j) { const float r = sigmoidf_(acc[ai][0][m][n][j] + br[j]), ig = sigmoidf_(acc[ai][1][m][n][j] + bi[j]);
                    la[j] = cc[j] * r; uu[j] = __builtin_amdgcn_sqrtf(fmaxf(1.f - __expf(2.f * la[j]), 0.f)) * (ig * xv[j]); }
                u32x2 wl, wu; wl.x = cvt_pk_bf16(la[0], la[1]); wl.y = cvt_pk_bf16(la[2], la[3]); wu.x = cvt_pk_bf16(uu[0], uu[1]); wu.y = cvt_pk_bf16(uu[2], uu[3]);
                *(u32x2*)(LA + off) = wl; *(u32x2*)(U + off) = wu; xw = xn;
                __builtin_amdgcn_sched_barrier(0); } }
    }
};
__device__ __forceinline__ u32x4 ld16_agent(const void* p) {
    const unsigned long long* q = (const unsigned long long*)p;
    const unsigned long long a = __hip_atomic_load(q, __ATOMIC_RELAXED, __HIP_MEMORY_SCOPE_AGENT), b = __hip_atomic_load(q + 1, __ATOMIC_RELAXED, __HIP_MEMORY_SCOPE_AGENT);
    return (u32x4){(unsigned)a, (unsigned)(a >> 32), (unsigned)b, (unsigned)(b >> 32)};
}
template <bool FIRST> struct EpiBranch {
    static constexpr bool PERM = true;
    const bf16_t* G; int ldg; bf16_t* O; int ldo;
    __device__ __forceinline__ void operator()(const f32x4 (&acc)[2][2][4][2], const Unit& u, int wr, int wc, int fr, int fq) const {
        const int row0 = u.pm * BM + wr * 64 + fr, col0 = u.pn * BM + wc * 32 + 8 * fq;
        u32x4 gw[2], ow[2];
#pragma unroll
        for (int bj = 0; bj < 2; ++bj) { gw[bj] = *(const u32x4*)(G + (size_t)row0 * ldg + col0 + bj * HALF); if (!FIRST) ow[bj] = *(const u32x4*)(O + (size_t)row0 * ldo + col0 + bj * HALF); }
#pragma unroll
        for (int it = 0; it < 8; ++it) { const int ai = it >> 2, m = it & 3; const size_t r = (size_t)(row0 + ai * HALF + m * 16);
            u32x4 gn[2], on[2];
#pragma unroll
            for (int bj = 0; bj < 2; ++bj) { gn[bj] = gw[bj]; on[bj] = ow[bj]; }
            if (it < 7) { const size_t rn = (size_t)(row0 + ((it + 1) >> 2) * HALF + ((it + 1) & 3) * 16);
#pragma unroll
                for (int bj = 0; bj < 2; ++bj) { gn[bj] = *(const u32x4*)(G + rn * ldg + col0 + bj * HALF); if (!FIRST) on[bj] = *(const u32x4*)(O + rn * ldo + col0 + bj * HALF); } }
#pragma unroll
            for (int bj = 0; bj < 2; ++bj) { const u32x4 g4 = gw[bj];
                float v[8] = {acc[ai][bj][m][0][0] * bflo(g4.x), acc[ai][bj][m][0][1] * bfhi(g4.x), acc[ai][bj][m][0][2] * bflo(g4.y), acc[ai][bj][m][0][3] * bfhi(g4.y),
                              acc[ai][bj][m][1][0] * bflo(g4.z), acc[ai][bj][m][1][1] * bfhi(g4.z), acc[ai][bj][m][1][2] * bflo(g4.w), acc[ai][bj][m][1][3] * bfhi(g4.w)};
                if (!FIRST) { const u32x4 o4 = ow[bj]; v[0] += bflo(o4.x); v[1] += bfhi(o4.x); v[2] += bflo(o4.y); v[3] += bfhi(o4.y); v[4] += bflo(o4.z); v[5] += bfhi(o4.z); v[6] += bflo(o4.w); v[7] += bfhi(o4.w); }
                u32x4 w; w.x = cvt_pk_bf16(v[0], v[1]); w.y = cvt_pk_bf16(v[2], v[3]); w.z = cvt_pk_bf16(v[4], v[5]); w.w = cvt_pk_bf16(v[6], v[7]);
                *(u32x4*)(O + r * ldo + col0 + bj * HALF) = w; }
#pragma unroll
            for (int bj = 0; bj < 2; ++bj) { gw[bj] = gn[bj]; ow[bj] = on[bj]; }
            __builtin_amdgcn_sched_barrier(0); }
    }
};
struct EpiF32 {
    static constexpr bool PERM = false;
    float* O; int ldc;
    __device__ __forceinline__ void operator()(const f32x4 (&acc)[2][2][4][2], const Unit& u, int wr, int wc, int fr, int fq) const {
        const int row0 = u.pm * BM + wr * 64 + fr, col0 = u.pn * BM + wc * 32 + 4 * fq;
#pragma unroll
        for (int ai = 0; ai < 2; ++ai)
#pragma unroll
            for (int m = 0; m < 4; ++m) { float* rowp = O + (size_t)(row0 + ai * HALF + m * 16) * ldc + col0;
#pragma unroll
                for (int bj = 0; bj < 2; ++bj)
#pragma unroll
                    for (int n = 0; n < 2; ++n) *(f32x4*)(rowp + bj * HALF + n * 16) = acc[ai][bj][m][n]; }
    }
};
struct EpiSwiGLU {
    static constexpr bool PERM = true;
    bf16_t* O; int ldc;
    __device__ __forceinline__ void operator()(const f32x4 (&acc)[2][2][4][2], const Unit& u, int wr, int wc, int fr, int fq) const {
        const int row0 = u.pm * BM + wr * 64 + fr, col0 = u.pn * HALF + wc * 32 + 8 * fq;
#pragma unroll
        for (int ai = 0; ai < 2; ++ai)
#pragma unroll
            for (int m = 0; m < 4; ++m) { bf16_t* rowp = O + (size_t)(row0 + ai * HALF + m * 16) * ldc + col0;
                float v[8];
#pragma unroll
                for (int n = 0; n < 2; ++n)
#pragma unroll
                    for (int j = 0; j < 4; ++j) { const float g = acc[ai][0][m][n][j], up = acc[ai][1][m][n][j]; v[n * 4 + j] = g * sigmoidf_(g) * up; }
                u32x4 w; w.x = cvt_pk_bf16(v[0], v[1]); w.y = cvt_pk_bf16(v[2], v[3]); w.z = cvt_pk_bf16(v[4], v[5]); w.w = cvt_pk_bf16(v[6], v[7]);
                *(u32x4*)rowp = w; }
    }
};

template <class Epi, bool ALIGN_EPI, class Sched>
__device__ __forceinline__ void gemm_phase(LAS unsigned char* lds, const Gemm g, const Sched& S, const Epi& E, const int tid) {
    const int wid = __builtin_amdgcn_readfirstlane(tid >> 6), lane = tid & 63, wr = wid >> 2, wc = wid & 3, fr = lane & 15, fq = lane >> 4;
    const int K = g.K, nt = K / BK;
    unsigned voffA[2], voffB[2];
#pragma unroll
    for (int i = 0; i < 2; ++i) { int R, C; stage_rc(tid * 16 + i * 8192, R, C); const int Rb = Epi::PERM ? ((R & ~31) + perm32(R & 31)) : R;
        voffA[i] = (unsigned)(R * g.lda + C) * 2u; voffB[i] = (unsigned)(Rb * g.ldb + C) * 2u; }
    const size_t kstep = (size_t)(BK * 2), kstA = (size_t)g.kstepA;
    const size_t hstepA = (size_t)HALF * g.lda * 2, hstepB = (size_t)HALF * g.ldb * 2;
    const size_t tstepA = 2 * hstepA, tstepB = 2 * hstepB;
    const unsigned ldsw = (unsigned)wid * 1024u;
    const int aoff = lds_byte(wr * 64 + fr, fq * 8), boff = lds_byte(wc * 32 + fr, fq * 8);
#define PG8_SA(b, h) (((b) * 2 + (h)) * HTB)
#define PG8_SB(b, h) ((4 + (b) * 2 + (h)) * HTB)
#define PG8_STAGE(bufoff, gbase, voff) do { _Pragma("unroll") for (int _i = 0; _i < 2; ++_i) \
        __builtin_amdgcn_global_load_lds((const unsigned*)((const char*)(gbase) + (voff)[_i]), (LAS unsigned*)(lds + (bufoff) + ldsw + _i * 8192), 16, 0, 0); } while (0)
#define PG8_LDA(dst, b, h) do { _Pragma("unroll") for (int m = 0; m < 4; ++m) _Pragma("unroll") for (int k = 0; k < 2; ++k) dst[m][k] = *(const LAS bf16x8*)(lds + PG8_SA(b, h) + aoff + m * 2048 + k * 1024); } while (0)
#define PG8_LDB(dst, b, h) do { _Pragma("unroll") for (int n = 0; n < 2; ++n) _Pragma("unroll") for (int k = 0; k < 2; ++k) dst[n][k] = *(const LAS bf16x8*)(lds + PG8_SB(b, h) + boff + n * 2048 + k * 1024); } while (0)
#define PG8_MMA(ai, bj, At, Bt) do { __builtin_amdgcn_s_setprio(1); _Pragma("unroll") for (int m = 0; m < 4; ++m) _Pragma("unroll") for (int n = 0; n < 2; ++n) _Pragma("unroll") for (int k = 0; k < 2; ++k) \
        acc[ai][bj][m][n] = __builtin_amdgcn_mfma_f32_16x16x32_bf16(Bt[n][k], At[m][k], acc[ai][bj][m][n], 0, 0, 0); __builtin_amdgcn_s_setprio(0); } while (0)
#define PG8_WAIT_V(n) asm volatile("s_waitcnt vmcnt(" #n ")" ::: "memory")
#define PG8_WAIT_L(n) asm volatile("s_waitcnt lgkmcnt(" #n ")" ::: "memory")
#define PG8_BAR __builtin_amdgcn_s_barrier()
#define PG8_SCHED __builtin_amdgcn_sched_barrier(0)
#define PG8_AOFF(u_) (S.aoff((u_), tstepA))
#define PG8_BOFF(u_) (S.boff((u_), tstepB))
    Unit cur, nxt; int ui = 0;
    if (!S.next(0, cur)) return;
    f32x4 acc[2][2][4][2];
#pragma unroll
    for (int a = 0; a < 2; ++a)
#pragma unroll
        for (int b = 0; b < 2; ++b)
#pragma unroll
            for (int m = 0; m < 4; ++m)
#pragma unroll
                for (int n = 0; n < 2; ++n) acc[a][b][m][n] = (f32x4){0.f, 0.f, 0.f, 0.f};
    bf16x8 At[4][2], B0[2][2], B1[2][2];
    const char* cA = (const char*)g.A + PG8_AOFF(cur); const char* cB = (const char*)g.Bt + PG8_BOFF(cur);
    PG8_STAGE(PG8_SB(0, 0), cB, voffB); PG8_STAGE(PG8_SB(0, 1), cB + hstepB, voffB); PG8_STAGE(PG8_SA(0, 0), cA, voffA); PG8_STAGE(PG8_SA(0, 1), cA + hstepA, voffA);
    if (wr == 1) PG8_BAR;
    PG8_WAIT_V(2); PG8_BAR;
    PG8_STAGE(PG8_SB(1, 0), cB + kstep, voffB); PG8_STAGE(PG8_SA(1, 0), cA + kstA, voffA); PG8_STAGE(PG8_SB(1, 1), cB + hstepB + kstep, voffB);
    PG8_WAIT_V(6); PG8_BAR;
    for (;;) {
        const bool has_next = S.next(ui + 1, nxt);
        const char* nA = has_next ? (const char*)g.A + PG8_AOFF(nxt) : cA; const char* nB = has_next ? (const char*)g.Bt + PG8_BOFF(nxt) : cB;
        for (int t = 0; t < nt; t += 2) {
            const bool last = (t == nt - 2);
            const char* a1 = cA + (size_t)(t + 1) * kstA;
            const char* a2 = last ? nA : cA + (size_t)(t + 2) * kstA; const char* b2 = last ? nB : cB + (size_t)(t + 2) * kstep;
            const char* a3 = a2 + kstA; const char* b3 = b2 + kstep;
            PG8_LDB(B0, 0, 0); PG8_LDB(B1, 0, 1); PG8_SCHED; PG8_LDA(At, 0, 0); PG8_STAGE(PG8_SA(1, 1), a1 + hstepA, voffA);
            PG8_WAIT_V(8); PG8_WAIT_L(0); PG8_BAR; PG8_MMA(0, 0, At, B0); PG8_MMA(0, 1, At, B1); PG8_BAR; PG8_SCHED;
            PG8_LDA(At, 0, 1); PG8_STAGE(PG8_SB(0, 0), b2, voffB); PG8_STAGE(PG8_SB(0, 1), b2 + hstepB, voffB); PG8_STAGE(PG8_SA(0, 0), a2, voffA);
            PG8_WAIT_V(8); PG8_WAIT_L(0); PG8_BAR; PG8_MMA(1, 0, At, B0); PG8_MMA(1, 1, At, B1); PG8_BAR; PG8_SCHED;
            PG8_LDB(B0, 1, 0); PG8_LDB(B1, 1, 1); PG8_SCHED; PG8_LDA(At, 1, 0); PG8_STAGE(PG8_SA(0, 1), a2 + hstepA, voffA);
            PG8_WAIT_V(8); PG8_WAIT_L(0); PG8_BAR; PG8_MMA(0, 0, At, B0); PG8_MMA(0, 1, At, B1); PG8_BAR; PG8_SCHED;
            PG8_LDA(At, 1, 1); PG8_STAGE(PG8_SB(1, 0), b3, voffB); PG8_STAGE(PG8_SB(1, 1), b3 + hstepB, voffB); PG8_STAGE(PG8_SA(1, 0), a3, voffA);
            PG8_WAIT_V(8); PG8_WAIT_L(0); PG8_BAR; PG8_MMA(1, 0, At, B0); PG8_MMA(1, 1, At, B1); PG8_BAR; PG8_SCHED;
        }
        if constexpr (ALIGN_EPI) { if (wr == 0) PG8_BAR; }
        E(acc, cur, wr, wc, fr, fq);
        if (!has_next) break;
#pragma unroll
        for (int a = 0; a < 2; ++a)
#pragma unroll
            for (int b = 0; b < 2; ++b)
#pragma unroll
                for (int m = 0; m < 4; ++m)
#pragma unroll
                    for (int n = 0; n < 2; ++n) acc[a][b][m][n] = (f32x4){0.f, 0.f, 0.f, 0.f};
        cur = nxt; cA = nA; cB = nB; ++ui;
        if constexpr (ALIGN_EPI) { if (wr == 1) PG8_BAR; }
    }
    PG8_WAIT_V(0);
    if constexpr (!ALIGN_EPI) { if (wr == 0) PG8_BAR; }
    PG8_BAR;
#undef PG8_SA
#undef PG8_SB
#undef PG8_STAGE
#undef PG8_LDA
#undef PG8_LDB
#undef PG8_MMA
#undef PG8_WAIT_V
#undef PG8_WAIT_L
#undef PG8_BAR
#undef PG8_SCHED
#undef PG8_AOFF
#undef PG8_BOFF
}
}

struct Args { const float* in[19]; float* out; unsigned char* ws; int ph_lo, ph_hi; };
enum { I_X = 0, I_REL, I_NORMG, I_WIN, I_CONVW, I_CONVB, I_LRUW, I_LRUB, I_LAM, I_CPOS, I_CW1, I_CW2, I_WA2, I_BA, I_GNORM, I_WBR, I_WOUT, I_WFI, I_WFO };
enum { PH_PRE = 0, PH_G1, PH_LCONV, PH_LGATE, PH_LSCAN, PH_G23, PH_M1, PH_M2, PH_M3, PH_GLA, PH_G4, PH_BR, PH_OUT, PH_RES1, PH_FI, PH_FO, PH_RES2, NPH };

typedef const Args __attribute__((address_space(4)))* ArgsP;
struct Ctx {
    ArgsP ap; float* out; unsigned char* ws; LAS unsigned char* lds; unsigned char* ldsg;
    int tid, lane, wave, G, bid, L; bool dry;
    const float* xin;
};

template <int MODE> __device__ __forceinline__ int srccol(int n) {
    if (MODE == 0) return n;
    if (MODE == 1) { if (n < 2560) return 2048 + n; if (n < 2608) return 4608 + (n - 2560); if (n < 2624) return 7728 + (n - 2608); if (n < 2816) return -1; return 4656 + (n - 2816); }
    if (MODE == 2) return 7744 + n;
      { const int t = n >> 8, j = n & 255; return j < 128 ? t * 128 + j : DFF + t * 128 + (j - 128); }
}
template <int MODE> __device__ __forceinline__ void tr_item(const float* W, int ldw, bf16_t* WT, int ldd, int nblk, int item, LAS float* scr, int lane) {
    const int kb = item / nblk, nb = item % nblk, k0 = 64 * kb, n0 = 32 * nb;
    const int sc = srccol<MODE>(n0 + (lane & 31));
#pragma unroll 8
    for (int i = 0; i < 32; ++i) { const int kk = 2 * i + (lane >> 5); scr[kk * 33 + (lane & 31)] = sc >= 0 ? W[(size_t)(k0 + kk) * ldw + sc] : 0.f; }
    asm volatile("s_waitcnt lgkmcnt(0)" ::: "memory");
    const int c = lane & 7;
#pragma unroll
    for (int j = 0; j < 4; ++j) { const int n = (lane >> 3) + 8 * j; const LAS float* s = scr + (8 * c) * 33 + n;
        u32x4 o; o.x = pk2(s[0 * 33], s[1 * 33]); o.y = pk2(s[2 * 33], s[3 * 33]); o.z = pk2(s[4 * 33], s[5 * 33]); o.w = pk2(s[6 * 33], s[7 * 33]);
        *(u32x4*)(WT + (size_t)(n0 + n) * ldd + k0 + 8 * c) = o; }
    asm volatile("s_waitcnt lgkmcnt(0)" ::: "memory");
}
__device__ __forceinline__ void rms_row_to_bf16(const float* xrow, const float* g, bf16_t* orow, int lane) {
    const f32x4* xr = (const f32x4*)xrow + lane; const f32x4* gr = (const f32x4*)g + lane;
    f32x4 v[4]; float s = 0.f;
#pragma unroll
    for (int j = 0; j < 4; ++j) { v[j] = xr[64 * j]; s += (v[j].x * v[j].x + v[j].y * v[j].y) + (v[j].z * v[j].z + v[j].w * v[j].w); }
    const float rstd = __builtin_amdgcn_rsqf(wave_sum(s) * (1.f / ND) + EPS);
    unsigned long long* o8 = (unsigned long long*)orow + lane;
#pragma unroll
    for (int j = 0; j < 4; ++j) { const f32x4 gg = gr[64 * j]; o8[64 * j] = (unsigned long long)pk2(v[j].x * rstd * gg.x, v[j].y * rstd * gg.y) | ((unsigned long long)pk2(v[j].z * rstd * gg.z, v[j].w * rstd * gg.w) << 32); }
}
__device__ __forceinline__ void ph_pre(Ctx& F) {
    const int L = F.L;
    LAS float* scr = (LAS float*)(F.lds + F.wave * 16384);
    const int gw = F.bid * NWAVES + F.wave, NGW = F.G * NWAVES;
    const float* win = F.ap->in[I_WIN] + (size_t)L * ND * IN_W;
    constexpr int I_G1 = 64 * 16, I_G23 = 184 * 16, I_G4 = 96 * 16, I_BR1 = 32 * 16, I_OUT = 32 * 16, I_FI = 176 * 16, I_FO = 32 * 44;
    constexpr int I_C1 = 8 * 16;
    constexpr int NITEMS = I_G1 + I_G23 + I_G4 + 3 * I_BR1 + I_OUT + I_FI + I_FO + 4 * I_C1;
    for (int it = gw; it < NITEMS; it += NGW) {
        int r = it;
        if (r < I_G1) { tr_item<0>(win, IN_W, (bf16_t*)(F.ws + W_G1), 1024, 64, r, scr, F.lane); continue; } r -= I_G1;
        if (r < I_G23) { tr_item<1>(win, IN_W, (bf16_t*)(F.ws + W_G23), 1024, 184, r, scr, F.lane); continue; } r -= I_G23;
        if (r < I_G4) { tr_item<2>(win, IN_W, (bf16_t*)(F.ws + W_G4), 1024, 96, r, scr, F.lane); continue; } r -= I_G4;
        if (r < 3 * I_BR1) { const int b = r / I_BR1; tr_item<0>(F.ap->in[I_WBR] + ((size_t)L * 3 + b) * ND * ND, ND, (bf16_t*)(F.ws + W_BR) + (size_t)b * ND * ND, 1024, 32, r % I_BR1, scr, F.lane); continue; } r -= 3 * I_BR1;
        if (r < I_OUT) { tr_item<0>(F.ap->in[I_WOUT] + (size_t)L * ND * ND, ND, (bf16_t*)(F.ws + W_OUT), 1024, 32, r, scr, F.lane); continue; } r -= I_OUT;
        if (r < I_FI) { tr_item<3>(F.ap->in[I_WFI] + (size_t)L * ND * 2 * DFF, 2 * DFF, (bf16_t*)(F.ws + W_FI), 1024, 176, r, scr, F.lane); continue; } r -= I_FI;
        if (r < I_FO) { tr_item<0>(F.ap->in[I_WFO] + (size_t)L * DFF * ND, ND, (bf16_t*)(F.ws + W_FO), DFF, 32, r, scr, F.lane); continue; } r -= I_FO;
        { const int q = r / I_C1, kv = q >> 1, half = q & 1;
          tr_item<0>(F.ap->in[I_CW1] + ((size_t)(L * 2 + kv) * 2048 + 1024 * half) * 256, 256, (bf16_t*)(F.ws + W_C1) + ((size_t)kv * 512 + 256 * half) * 1024, 1024, 8, r % I_C1, scr, F.lane); }
    }
    if (F.bid < 64) { const int kv = F.tid >> 8, n = F.tid & 255, k0 = 32 * F.bid; const float* w1 = F.ap->in[I_CW1] + ((size_t)(L * 2 + kv) * 2048 + k0) * 256 + n; const float* pos = F.ap->in[I_CPOS] + (size_t)(L * 2 + kv) * 2048 + k0;
        float a0 = 0.f, a1 = 0.f;
#pragma unroll
        for (int k = 0; k < 32; k += 2) { a0 += pos[k] * w1[(size_t)k * 256]; a1 += pos[k + 1] * w1[(size_t)(k + 1) * 256]; }
        ((float*)(F.ws + WS_CTL))[CT_C1P + F.bid * 512 + F.tid] = a0 + a1; }
    {
        const float* lw = F.ap->in[I_LRUW] + (size_t)L * 2 * 8 * 128 * 128; bf16_t* wt = (bf16_t*)(F.ws + W_LRU);
        for (int it = F.bid * NTHR + F.tid; it < 2048 * 32; it += F.G * NTHR) {
            const int row = it >> 5, kc = (it & 31) * 8, blk = row >> 8, g2 = (row >> 7) & 1, e = row & 127;
            u32x4 o = (u32x4){0u, 0u, 0u, 0u};
            if ((kc >> 7) == (blk & 1)) { const int c0 = kc & 127; const float* s = lw + ((size_t)(g2 * 8 + blk) * 128 + c0) * 128 + e;
                o.x = pk2(s[0], s[128]); o.y = pk2(s[256], s[384]); o.z = pk2(s[512], s[640]); o.w = pk2(s[768], s[896]); }
            *(u32x4*)(wt + (size_t)row * 256 + kc) = o;
        }
    }
    {
        float* ctl = (float*)(F.ws + WS_CTL);
        const int gt = F.bid * NTHR + F.tid;
        if (gt < 1024) { const float lam = F.ap->in[I_LAM][L * 1024 + gt]; const float e = __expf(-lam); const float sp = e < 0.03f ? e * (1.f - e * (0.5f - e * (0.33333333f - 0.25f * e))) : __logf(1.f + e); ctl[CT_C8 + gt] = -8.f * sp; }
        else if (gt < 1024 + 2048) { const int i = gt - 1024, h = i >> 7, d = i & 127; ctl[CT_RB + i] = F.ap->in[I_REL][rel_bucket(d) * 16 + h]; }
    }
    const float* g0 = F.ap->in[I_NORMG] + (size_t)(L * 4 + 0) * ND; bf16_t* H = (bf16_t*)(F.ws + WS_H);
    for (int m = gw; m < NT; m += NGW) rms_row_to_bf16(F.xin + (size_t)m * ND, g0, H + (size_t)m * ND, F.lane);
}

__device__ __forceinline__ void ph_lconv(Ctx& F) {
    const int L = F.L;
    const bf16_t* XA = (const bf16_t*)(F.ws + WS_XA); bf16_t* XC = (bf16_t*)(F.ws + WS_XC);
    const float* cw = F.ap->in[I_CONVW] + (size_t)L * 4 * 1024; const float* cb = F.ap->in[I_CONVB] + (size_t)L * 1024;
    for (int idx = F.bid * NTHR + F.tid; idx < NT * 128; idx += F.G * NTHR) {
        const int t = idx >> 7, c8 = (idx & 127) * 8, s = t & (NS - 1);
        float acc[8];
#pragma unroll
        for (int i = 0; i < 8; ++i) acc[i] = cb[c8 + i];
#pragma unroll
        for (int j = 0; j < 4; ++j) { if (s - 3 + j >= 0) { const u32x4 w = *(const u32x4*)(XA + (size_t)(t - 3 + j) * 1024 + c8); const float* ww = cw + j * 1024 + c8;
                acc[0] += ww[0] * bflo(w.x); acc[1] += ww[1] * bfhi(w.x); acc[2] += ww[2] * bflo(w.y); acc[3] += ww[3] * bfhi(w.y);
                acc[4] += ww[4] * bflo(w.z); acc[5] += ww[5] * bfhi(w.z); acc[6] += ww[6] * bflo(w.w); acc[7] += ww[7] * bfhi(w.w); } }
        u32x4 o; o.x = pk2(acc[0], acc[1]); o.y = pk2(acc[2], acc[3]); o.z = pk2(acc[4], acc[5]); o.w = pk2(acc[6], acc[7]);
        *(u32x4*)(XC + (size_t)t * 1024 + c8) = o;
    }
}

__device__ __forceinline__ void ph_lscan(Ctx& F) {
    const bf16_t* LA = (const bf16_t*)(F.ws + WS_LA); const bf16_t* U = (const bf16_t*)(F.ws + WS_U); bf16_t* GA = (bf16_t*)(F.ws + WS_GA);
    LAS float* sA = (LAS float*)F.lds; LAS float* sH = sA + 32 * 32;
    const int chunk = F.tid >> 4, cl = F.tid & 15;
    for (int unit = F.bid; unit < NB_ * 32; unit += F.G) {
        const int b = unit >> 5, c = (unit & 31) * 32 + cl * 2;
        const size_t base = ((size_t)b * NS + chunk * 64) * 1024 + c;
        float s0 = 0.f, s1 = 0.f, h0 = 0.f, h1 = 0.f;
        for (int i = 0; i < 64; ++i) { const unsigned lw = *(const unsigned*)(LA + base + (size_t)i * 1024), uw = *(const unsigned*)(U + base + (size_t)i * 1024);
            const float l0 = bflo(lw), l1 = bfhi(lw); s0 += l0; s1 += l1; h0 = __expf(l0) * h0 + bflo(uw); h1 = __expf(l1) * h1 + bfhi(uw); }
        sA[chunk * 32 + cl * 2] = s0; sA[chunk * 32 + cl * 2 + 1] = s1; sH[chunk * 32 + cl * 2] = h0; sH[chunk * 32 + cl * 2 + 1] = h1;
        __syncthreads();
        h0 = 0.f; h1 = 0.f;
        for (int k = 0; k < chunk; ++k) { h0 = __expf(sA[k * 32 + cl * 2]) * h0 + sH[k * 32 + cl * 2]; h1 = __expf(sA[k * 32 + cl * 2 + 1]) * h1 + sH[k * 32 + cl * 2 + 1]; }
        for (int i = 0; i < 64; ++i) { const unsigned lw = *(const unsigned*)(LA + base + (size_t)i * 1024), uw = *(const unsigned*)(U + base + (size_t)i * 1024);
            h0 = __expf(bflo(lw)) * h0 + bflo(uw); h1 = __expf(bfhi(lw)) * h1 + bfhi(uw);
            unsigned* gp = (unsigned*)(GA + base + (size_t)i * 1024); const unsigned gw = *gp;
            if (!F.dry) *gp = pk2(h0 * gelu_tanh(bflo(gw)), h1 * gelu_tanh(bfhi(gw))); }
        __syncthreads();
    }
}

__device__ __forceinline__ void ph_cmp2g(Ctx& F) {
    const int L = F.L;
    const bf16_t* P = (const bf16_t*)(F.ws + WS_HID); bf16_t* KC = (bf16_t*)(F.ws + WS_KC); const float* c1 = (const float*)(F.ws + WS_CTL) + CT_C1;
    LAS float* hid = (LAS float*)F.lds;
    for (int unit = F.bid; unit < 2 * 32 * 16; unit += F.G) {
        const int cg = unit & 15, bg = (unit >> 4) & 31, kv = unit >> 9, b = bg >> 2, g = bg & 3;
        const bf16_t* Pb = P + ((size_t)(kv * 4 + g) * 1024 + b * 128) * 512;
#pragma unroll
        for (int it = 0; it < 4; ++it) { const int e = F.tid + it * 512, cl = e >> 8, n = e & 255, c = cg * 8 + cl;
            float v = 0.f; if (c < 127) v = gelu_tanh(bf1(Pb[(size_t)c * 512 + n]) + bf1(Pb[(size_t)(c + 1) * 512 + 256 + n]) + c1[kv * 256 + n]);
            hid[cl * 256 + n] = v; }
        __syncthreads();
        { const int cl = F.tid >> 6, d = F.tid & 63, c = cg * 8 + cl; const float* w2 = F.ap->in[I_CW2] + (size_t)(L * 2 + kv) * 256 * 64 + d; float acc = 0.f;
#pragma unroll 8
            for (int n = 0; n < 256; ++n) acc += hid[cl * 256 + n] * w2[n * 64];
            KC[((size_t)(kv * 32 + bg) * 128 + c) * 64 + d] = (bf16_t)f2bf(c < 127 ? acc : 0.f); }
        __syncthreads();
    }
}
typedef float f32x16 __attribute__((ext_vector_type(16)));
#define MFMA32(a, b, c) __builtin_amdgcn_mfma_f32_32x32x16_bf16((a), (b), (c), 0, 0, 0)
namespace att {
constexpr int KROW = 144, VROW = 136, KCROW = 144, VCROW = 264;
constexpr int L_KB = 0, L_VB = 2 * 64 * KROW, L_KC = L_VB + 2 * 64 * VROW, L_VC = L_KC + 128 * KCROW, L_RB = L_VC + 64 * VCROW, L_IMP = L_RB + 4 * 256 * 4, L_SEL = L_IMP + 4 * 64 * 33 * 4, L_END = L_SEL + 66 * 4;
static_assert(L_END <= 140000, "attention LDS map");
constexpr float LOG2E = 1.4426950408889634f;
}
__device__ __forceinline__ float other_half(float v, int hi) { auto rr = __builtin_amdgcn_permlane32_swap(__float_as_uint(v), __float_as_uint(v), false, false); return __uint_as_float(hi ? rr[0] : rr[1]); }
__device__ __forceinline__ bf16x8 pack8(const f32x16& p, const int s8) {
    u32x4 w; w.x = pg8::cvt_pk_bf16(p[s8], p[s8 + 1]); w.y = pg8::cvt_pk_bf16(p[s8 + 2], p[s8 + 3]); w.z = pg8::cvt_pk_bf16(p[s8 + 4], p[s8 + 5]); w.w = pg8::cvt_pk_bf16(p[s8 + 6], p[s8 + 7]);
    return __builtin_bit_cast(bf16x8, w);
}
__device__ __forceinline__ void ph_att_mfma(Ctx& F) {
    using namespace att;
    bf16_t* NBp = (bf16_t*)(F.ws + WS_NB); const bf16_t* KCg = (const bf16_t*)(F.ws + WS_KC);
    const float* RB = (const float*)(F.ws + WS_CTL) + CT_RB;
    LAS unsigned char* lds = F.lds;
    const int tid = F.tid, lane = F.lane, w = F.wave, r32 = lane & 31, hi = lane >> 5, hr = w >> 1, qh = w & 1;
    const float NEG = -__builtin_inff();
    for (int unit = F.bid; unit < 1024; unit += F.G) {
        const int bg = unit & 31, c = 31 - (unit >> 5), b = bg >> 2, g = bg & 3, h = g * 4 + hr;
        const int s0 = 64 * c, qidx = 32 * qh + r32, s = s0 + qidx;
        const size_t trow = (size_t)b * NS + s;
        { const bf16_t* kc = KCg + (size_t)bg * 128 * 64; const bf16_t* vc = KCg + (size_t)(32 + bg) * 128 * 64;
#pragma unroll
            for (int it = 0; it < 2; ++it) { const int e = tid + it * 512, key = e >> 3, ch = e & 7;
                const u32x4 kv = *(const u32x4*)(kc + key * 64 + ch * 8); *(LAS u32x4*)(lds + L_KC + key * KCROW + ch * 16) = kv;
                const u32x4 vv = *(const u32x4*)(vc + key * 64 + ch * 8); const unsigned vw[4] = {vv.x, vv.y, vv.z, vv.w};
#pragma unroll
                for (int i = 0; i < 4; ++i) { *(LAS bf16_t*)(lds + L_VC + (8 * ch + 2 * i) * VCROW + key * 2) = (bf16_t)(vw[i] & 0xffffu); *(LAS bf16_t*)(lds + L_VC + (8 * ch + 2 * i + 1) * VCROW + key * 2) = (bf16_t)(vw[i] >> 16); } }
#pragma unroll
            for (int it = 0; it < 2; ++it) { const int e = tid + it * 512, hh = e >> 8, d = e & 255; ((LAS float*)(lds + L_RB))[e] = RB[(g * 4 + hh) * 128 + (d < 127 ? d : 127)] * LOG2E; } }
        bf16x8 qf[4];
#pragma unroll
        for (int ds = 0; ds < 4; ++ds) qf[ds] = *(const bf16x8*)(NBp + trow * LD_NB + h * 64 + 16 * ds + 8 * hi);
        float g0, g1, g2; { const bf16_t* gp = NBp + trow * LD_NB + 2560 + h; g0 = sigmoidf_(bf1(gp[0])); g1 = sigmoidf_(bf1(gp[16])); g2 = sigmoidf_(bf1(gp[32])); }
        const LAS float* rbl = (const LAS float*)(lds + L_RB) + hr * 256;
        __syncthreads();
        f32x16 y[2], o[2];
#pragma unroll
        for (int i = 0; i < 16; ++i) { y[0][i] = 0.f; y[1][i] = 0.f; o[0][i] = 0.f; o[1][i] = 0.f; }
        {
            f32x16 sc[4];
#pragma unroll
            for (int sub = 0; sub < 4; ++sub) {
#pragma unroll
                for (int i = 0; i < 16; ++i) sc[sub][i] = 0.f;
#pragma unroll
                for (int ds = 0; ds < 4; ++ds) { const bf16x8 a = *(const LAS bf16x8*)(lds + L_KC + (32 * sub + r32) * KCROW + ds * 32 + hi * 16); sc[sub] = MFMA32(a, qf[ds], sc[sub]); } }
            float mx = NEG;
#pragma unroll
            for (int sub = 0; sub < 4; ++sub)
#pragma unroll
                for (int i = 0; i < 16; ++i) { const int cc = 32 * sub + (i & 3) + 8 * (i >> 2) + 4 * hi; const int dist = s - 16 * cc - 31;
                    const float tb = rbl[dist < 0 ? 0 : (dist > 255 ? 255 : dist)]; const float x = dist >= 0 ? sc[sub][i] * LOG2E + tb : NEG; sc[sub][i] = x; mx = fmaxf(mx, x); }
            mx = fmaxf(mx, other_half(mx, hi)); const float mu = mx == NEG ? 0.f : mx;
            float l = 0.f;
#pragma unroll
            for (int sub = 0; sub < 4; ++sub)
#pragma unroll
                for (int i = 0; i < 16; ++i) { const float p = __builtin_amdgcn_exp2f(sc[sub][i] - mu); sc[sub][i] = p; l += p; }
            l += other_half(l, hi); const float inv = l > 0.f ? __builtin_amdgcn_rcpf(l) : 0.f;
#pragma unroll
            for (int sub = 0; sub < 4; ++sub)
#pragma unroll
                for (int i = 0; i < 16; ++i) sc[sub][i] *= inv;
            { LAS float* imp = (LAS float*)(lds + L_IMP) + (hr * 64 + qidx) * 33; float tprev = 0.f;
#pragma unroll
                for (int sub = 0; sub < 4; ++sub)
#pragma unroll
                    for (int gq = 0; gq < 4; ++gq) { const float t = 0.5f * sc[sub][4 * gq + 3]; const float G = sc[sub][4 * gq] + sc[sub][4 * gq + 1] + sc[sub][4 * gq + 2] + t;
                        const float to = other_half(t, hi);
                        imp[8 * sub + 2 * gq + hi] = G + (hi ? to : tprev); tprev = to; } }
#pragma unroll
            for (int ks = 0; ks < 8; ++ks) { const bf16x8 pf = pack8(sc[ks >> 1], (ks & 1) * 8);
#pragma unroll
                for (int dt = 0; dt < 2; ++dt) { const LAS unsigned char* vp = lds + L_VC + (32 * dt + r32) * VCROW + (16 * ks + 4 * hi) * 2;
                    const u32x2 va = *(const LAS u32x2*)vp, vb = *(const LAS u32x2*)(vp + 16); const u32x4 vw = {va.x, va.y, vb.x, vb.y};
                    o[dt] = MFMA32(__builtin_bit_cast(bf16x8, vw), pf, o[dt]); } }
#pragma unroll
            for (int i = 0; i < 16; ++i) { y[0][i] = g0 * o[0][i]; y[1][i] = g0 * o[1][i]; o[0][i] = 0.f; o[1][i] = 0.f; }
        }
        __syncthreads();
        if (w == 0) {
            unsigned mask;
            if (c <= 7) mask = (2u << c) - 1u;
            else {
                const LAS float* imp = (const LAS float*)(lds + L_IMP) + lane * 33; float tot[32];
#pragma unroll
                for (int j = 0; j < 32; ++j) tot[j] = imp[j] + imp[64 * 33 + j] + imp[2 * 64 * 33 + j] + imp[3 * 64 * 33 + j];
                mask = 1u | (1u << c) | (1u << (c - 1));
#pragma unroll 1
                for (int k = 0; k < 5; ++k) { float best = -1.f; int bj = 1;
#pragma unroll
                    for (int j = 1; j < 30; ++j) { const bool ok = (j <= c - 2) && !((mask >> j) & 1u) && tot[j] > best; best = ok ? tot[j] : best; bj = ok ? j : bj; }
                    mask |= 1u << bj; } }
            ((LAS unsigned*)(lds + L_SEL))[lane] = mask;
            unsigned un = mask;
            un |= (unsigned)__builtin_amdgcn_ds_swizzle((int)un, 0x041f); un |= (unsigned)__builtin_amdgcn_ds_swizzle((int)un, 0x081f); un |= (unsigned)__builtin_amdgcn_ds_swizzle((int)un, 0x101f);
            un |= (unsigned)__builtin_amdgcn_ds_swizzle((int)un, 0x201f); un |= (unsigned)__builtin_amdgcn_ds_swizzle((int)un, 0x401f);
            { auto rr = __builtin_amdgcn_permlane32_swap(un, un, false, false); un = rr[0] | rr[1]; }
            if (lane == 0) ((LAS unsigned*)(lds + L_SEL))[64] = un;
        }
        __syncthreads();
        const unsigned mymask = ((const LAS unsigned*)(lds + L_SEL))[qidx];
        unsigned uni = (unsigned)__builtin_amdgcn_readfirstlane((int)((const LAS unsigned*)(lds + L_SEL))[64]);
        const bf16_t* kvb = NBp + (size_t)b * NS * LD_NB + 1024 + g * 64;
        const int skey = tid >> 3, sch = tid & 7;
        const int nslc = __builtin_popcount(uni), jw0 = c - 4 > 0 ? c - 4 : 0, nitem = nslc + (c - jw0 + 1);
        float m = -1e30f, l = 0.f;
        u32x4 kreg, vreg;
        int jcur; bool wincur;
        { const bool isw = nslc == 0; jcur = isw ? jw0 : __builtin_ctz(uni); wincur = isw; if (!isw) uni &= uni - 1; }
        { const bf16_t* src = kvb + (size_t)(64 * jcur + skey) * LD_NB + (wincur ? 4 * 256 : 2 * 256) + sch * 8; kreg = *(const u32x4*)src; vreg = *(const u32x4*)(src + 256); }
        { *(LAS u32x4*)(lds + L_KB + skey * KROW + sch * 16) = kreg; const unsigned vw[4] = {vreg.x, vreg.y, vreg.z, vreg.w};
#pragma unroll
            for (int i = 0; i < 4; ++i) { *(LAS bf16_t*)(lds + L_VB + (8 * sch + 2 * i) * VROW + skey * 2) = (bf16_t)(vw[i] & 0xffffu); *(LAS bf16_t*)(lds + L_VB + (8 * sch + 2 * i + 1) * VROW + skey * 2) = (bf16_t)(vw[i] >> 16); } }
        __syncthreads();
        const float b31 = rbl[255];
#pragma unroll 1
        for (int it = 0; it < nitem; ++it) {
            const int buf = it & 1;
            int jn = 0; bool winn = false; const bool hasn = it + 1 < nitem;
            if (hasn) { const bool isw = it + 1 >= nslc; jn = isw ? jw0 + (it + 1 - nslc) : __builtin_ctz(uni); winn = isw; if (!isw) uni &= uni - 1;
                const bf16_t* src = kvb + (size_t)(64 * jn + skey) * LD_NB + (winn ? 4 * 256 : 2 * 256) + sch * 8; kreg = *(const u32x4*)src; vreg = *(const u32x4*)(src + 256); }
            if (wincur && it == nslc && nslc > 0) { const float sc_ = g1 * __builtin_amdgcn_rcpf(l);
#pragma unroll
                for (int i = 0; i < 16; ++i) { y[0][i] += sc_ * o[0][i]; y[1][i] += sc_ * o[1][i]; o[0][i] = 0.f; o[1][i] = 0.f; }
                m = -1e30f; l = 0.f; }
            f32x16 p0, p1;
#pragma unroll
            for (int i = 0; i < 16; ++i) { p0[i] = 0.f; p1[i] = 0.f; }
            { const LAS unsigned char* kb = lds + L_KB + buf * 64 * KROW + r32 * KROW + hi * 16;
#pragma unroll
                for (int ds = 0; ds < 4; ++ds) { const bf16x8 a0 = *(const LAS bf16x8*)(kb + ds * 32), a1 = *(const LAS bf16x8*)(kb + 32 * KROW + ds * 32); p0 = MFMA32(a0, qf[ds], p0); p1 = MFMA32(a1, qf[ds], p1); } }
            const int dj = c - jcur;
            float bm = -1e30f;
            if (!wincur && dj >= 3) {
                const float cst = ((mymask >> jcur) & 1u) ? b31 : NEG;
#pragma unroll
                for (int i = 0; i < 16; ++i) { p0[i] = p0[i] * LOG2E + cst; p1[i] = p1[i] * LOG2E + cst; bm = fmaxf(bm, fmaxf(p0[i], p1[i])); }
            } else {
                const bool lane_ok = wincur || ((mymask >> jcur) & 1u); const int base = 64 * dj + qidx;
#pragma unroll
                for (int i = 0; i < 16; ++i) { const int kk = (i & 3) + 8 * (i >> 2) + 4 * hi; const int d0 = base - kk, d1 = d0 - 32;
                    const bool v0 = lane_ok && (unsigned)d0 < 256u, v1 = lane_ok && (unsigned)d1 < 256u;
                    const float t0 = rbl[(unsigned)d0 < 256u ? d0 : 0], t1 = rbl[(unsigned)d1 < 256u ? d1 : 0];
                    p0[i] = v0 ? p0[i] * LOG2E + t0 : NEG; p1[i] = v1 ? p1[i] * LOG2E + t1 : NEG; bm = fmaxf(bm, fmaxf(p0[i], p1[i])); }
            }
            bm = fmaxf(bm, other_half(bm, hi));
            const float mn = fmaxf(m, bm), alpha = __builtin_amdgcn_exp2f(m - mn); m = mn;
            float ls = 0.f;
#pragma unroll
            for (int i = 0; i < 16; ++i) { p0[i] = __builtin_amdgcn_exp2f(p0[i] - mn); p1[i] = __builtin_amdgcn_exp2f(p1[i] - mn); ls += p0[i] + p1[i]; }
            ls += other_half(ls, hi); l = l * alpha + ls;
            if (__any(alpha != 1.f)) {
#pragma unroll
                for (int i = 0; i < 16; ++i) { o[0][i] *= alpha; o[1][i] *= alpha; } }
            { const LAS unsigned char* vbp = lds + L_VB + buf * 64 * VROW + r32 * VROW + 8 * hi;
#pragma unroll
                for (int ks = 0; ks < 4; ++ks) { const bf16x8 pf = (ks < 2) ? pack8(p0, (ks & 1) * 8) : pack8(p1, (ks & 1) * 8);
#pragma unroll
                    for (int dt = 0; dt < 2; ++dt) { const LAS unsigned char* vp = vbp + dt * 32 * VROW + ks * 32;
                        const u32x2 va = *(const LAS u32x2*)vp, vb = *(const LAS u32x2*)(vp + 16); const u32x4 vw = {va.x, va.y, vb.x, vb.y};
                        o[dt] = MFMA32(__builtin_bit_cast(bf16x8, vw), pf, o[dt]); } } }
            if (hasn) { *(LAS u32x4*)(lds + L_KB + (buf ^ 1) * 64 * KROW + skey * KROW + sch * 16) = kreg; const unsigned vw[4] = {vreg.x, vreg.y, vreg.z, vreg.w};
#pragma unroll
                for (int i = 0; i < 4; ++i) { *(LAS bf16_t*)(lds + L_VB + (buf ^ 1) * 64 * VROW + (8 * sch + 2 * i) * VROW + skey * 2) = (bf16_t)(vw[i] & 0xffffu); *(LAS bf16_t*)(lds + L_VB + (buf ^ 1) * 64 * VROW + (8 * sch + 2 * i + 1) * VROW + skey * 2) = (bf16_t)(vw[i] >> 16); } }
            jcur = jn; wincur = winn;
            __syncthreads();
        }
        { const float sc_ = g2 * __builtin_amdgcn_rcpf(l);
#pragma unroll
            for (int i = 0; i < 16; ++i) { y[0][i] += sc_ * o[0][i]; y[1][i] += sc_ * o[1][i]; } }
        { bf16_t* yp = NBp + trow * LD_NB + h * 64 + 4 * hi;
#pragma unroll
            for (int dt = 0; dt < 2; ++dt)
#pragma unroll
                for (int gq = 0; gq < 4; ++gq) { u32x2 wv; wv.x = pg8::cvt_pk_bf16(y[dt][4 * gq], y[dt][4 * gq + 1]); wv.y = pg8::cvt_pk_bf16(y[dt][4 * gq + 2], y[dt][4 * gq + 3]); if (!F.dry) *(u32x2*)(yp + 32 * dt + 8 * gq) = wv; } }
        __syncthreads();
    }
}

constexpr size_t WS_ATTG = WS_XA + 14 * MiB;
constexpr size_t WS_DEC = WS_XA + 22 * MiB;
constexpr size_t WS_PSC = WS_XA;
__device__ __forceinline__ void ph_gla1(Ctx& F) {
    const int u_first = F.bid < 64 ? 2 * F.bid : 128 + (F.bid - 64), u_step = F.bid < 64 ? 1 : (F.G - 64), u_end = F.bid < 64 ? 2 * F.bid + 2 : 1024;
    const int L = F.L;
    const bf16_t* NBp = (const bf16_t*)(F.ws + WS_NB); bf16_t* GB = (bf16_t*)(F.ws + WS_GB);
    bf16_t* ATT = (bf16_t*)(F.ws + WS_ATTG); float* DEC = (float*)(F.ws + WS_DEC);
    LAS unsigned char* lds = F.lds;
    constexpr int QROW = 272, L_QT = 0, L_KT = 64 * QROW, L_GS = 2 * 64 * QROW;
    const int tid = F.tid, dk = tid & 127, tg = tid >> 7, lane = F.lane, w = F.wave, r32 = lane & 31, hi = lane >> 5;
    for (int unit = u_first; unit < u_end; unit += u_step) {
        const int bh = unit >> 5, chunk = unit & 31, b = bh >> 2, h = bh & 3; const size_t t0 = (size_t)b * NS + chunk * 64;
        float wa[16];
        { const float* wp = F.ap->in[I_WA2] + (size_t)L * 16 * 512 + h * 128 + dk;
#pragma unroll
            for (int r = 0; r < 16; ++r) wa[r] = wp[r * 512]; }
        const float ba = F.ap->in[I_BA][L * 512 + h * 128 + dk];
        float bl[16]; float cs = 0.f;
#pragma unroll
        for (int i = 0; i < 16; ++i) { const bf16_t* lr = NBp + (t0 + tg * 16 + i) * LD_NB + 2608; const u32x4 l0 = *(const u32x4*)lr, l1 = *(const u32x4*)(lr + 8);
            float z = ba; z += bflo(l0.x) * wa[0] + bfhi(l0.x) * wa[1] + bflo(l0.y) * wa[2] + bfhi(l0.y) * wa[3] + bflo(l0.z) * wa[4] + bfhi(l0.z) * wa[5] + bflo(l0.w) * wa[6] + bfhi(l0.w) * wa[7];
            z += bflo(l1.x) * wa[8] + bfhi(l1.x) * wa[9] + bflo(l1.y) * wa[10] + bfhi(l1.y) * wa[11] + bflo(l1.z) * wa[12] + bfhi(l1.z) * wa[13] + bflo(l1.w) * wa[14] + bfhi(l1.w) * wa[15];
            const float ls = (z < 0.f ? z : 0.f) - __logf(1.f + __expf(-fabsf(z))); cs += ls * (1.f / 16.f); bl[i] = cs; }
        ((LAS float*)(lds + L_GS))[tg * 128 + dk] = cs;
        __syncthreads();
        float off = 0.f, tot = 0.f;
#pragma unroll
        for (int gI = 0; gI < 4; ++gI) { const float v = ((const LAS float*)(lds + L_GS))[gI * 128 + dk]; tot += v; off += gI < tg ? v : 0.f; }
#pragma unroll
        for (int i = 0; i < 16; ++i) { const int tok = tg * 16 + i; bf16_t* row = GB + (t0 + tok) * LD_GB + h * 128 + dk; const float bb = bl[i] + off;
            const float q = bf1(row[0]) * 0.08838834764831845f, k = bf1(row[512]);
            const unsigned qt = f2bf(q * __expf(bb)), kt = f2bf(k * __expf(-bb)), ke = f2bf(k * __expf(tot - bb));
            *(LAS bf16_t*)(lds + L_QT + tok * QROW + dk * 2) = (bf16_t)qt; *(LAS bf16_t*)(lds + L_KT + tok * QROW + dk * 2) = (bf16_t)kt;
            if (!F.dry) { row[0] = (bf16_t)qt; row[512] = (bf16_t)ke; } }
        if (tg == 0) DEC[((size_t)bh * 32 + chunk) * 128 + dk] = __expf(tot);
        __syncthreads();
        if (w < 4) { const int ti = w >> 1, tj = w & 1; f32x16 acc;
#pragma unroll
            for (int i = 0; i < 16; ++i) acc[i] = 0.f;
            if (!(ti == 0 && tj == 1)) {
#pragma unroll
                for (int ds = 0; ds < 8; ++ds) { const bf16x8 a = *(const LAS bf16x8*)(lds + L_QT + (32 * ti + r32) * QROW + ds * 32 + hi * 16), bq = *(const LAS bf16x8*)(lds + L_KT + (32 * tj + r32) * QROW + ds * 32 + hi * 16);
                    acc = MFMA32(a, bq, acc); } }
            bf16_t* ap = ATT + ((size_t)bh * 32 + chunk) * 4096; const int col = 32 * tj + r32;
#pragma unroll
            for (int i = 0; i < 16; ++i) { const int rowi = 32 * ti + (i & 3) + 8 * (i >> 2) + 4 * hi; ap[rowi * 64 + col] = (bf16_t)f2bf(col <= rowi ? acc[i] : 0.f); } }
        __syncthreads();
    }
}
typedef short v4i16_t __attribute__((ext_vector_type(4)));
__device__ __forceinline__ bf16x8 tr_frag(const LAS unsigned char* p, const int row4_bytes) {
    const v4i16_t a = __builtin_amdgcn_ds_read_tr16_b64_v4i16((LAS v4i16_t*)p), b = __builtin_amdgcn_ds_read_tr16_b64_v4i16((LAS v4i16_t*)(p + row4_bytes));
    return __builtin_shufflevector(a, b, 0, 1, 2, 3, 4, 5, 6, 7);
}
template <int MODE> __device__ __forceinline__ void ph_gla_sc(Ctx& F) {
    const int L = F.L;
    bf16_t* GB = (bf16_t*)(F.ws + WS_GB); const bf16_t* ATT = (const bf16_t*)(F.ws + WS_ATTG); const float* DEC = (const float*)(F.ws + WS_DEC); bf16_t* PSC = (bf16_t*)(F.ws + WS_PSC);
    LAS unsigned char* lds = F.lds;
    constexpr int QROW = 272, KROW = 320, AROW = 144, VROW = 576;
    constexpr int G_QT = 0, G_KE = 64 * QROW, G_AT = G_KE + 64 * KROW, G_V = G_AT + 64 * AROW, G_DEC = G_V + 64 * VROW, G_SS = G_DEC + 512, G_END = G_SS + 2048;
    static_assert(G_END <= 140000, "gla LDS map");
    const int tid = F.tid, lane = F.lane, w = F.wave, r32 = lane & 31, hi = lane >> 5, eb = 32 * w;
    const int trq = (lane & 15) >> 2, trp = lane & 3, trg = (lane >> 4) & 1;
    for (int unit = F.bid; unit < 256; unit += F.G) {
        const int bh = unit >> 3, sc = unit & 7, b = bh >> 2, h = bh & 3;
        if (MODE == 1 && sc == 7) continue;
        f32x16 S[4];
        if (MODE == 3 && sc > 0) { const bf16_t* ps = PSC + ((size_t)bh * 7 + sc - 1) * 32768 + eb + r32;
#pragma unroll
            for (int t = 0; t < 4; ++t)
#pragma unroll
                for (int i = 0; i < 16; ++i) S[t][i] = bf1(ps[(32 * t + (i & 3) + 8 * (i >> 2) + 4 * hi) * 256]); }
        else {
#pragma unroll
            for (int t = 0; t < 4; ++t)
#pragma unroll
                for (int i = 0; i < 16; ++i) S[t][i] = 0.f; }
        const float* gnp = F.ap->in[I_GNORM] + L * 256 + eb + 4 * hi;
        u32x4 pq[2], pk[2], pa, pv[4]; float pd = 0.f;
#define GLA_LOAD(CH) do { int tl_ = tid; asm volatile("" : "+v"(tl_)); const size_t t0_ = (size_t)b * NS + (CH) * 64; \
            { const bf16_t* src = GB + (t0_ + (tl_ >> 4)) * LD_GB + h * 128 + (tl_ & 15) * 8; if (MODE == 3) { pq[0] = *(const u32x4*)src; pq[1] = *(const u32x4*)(src + (size_t)32 * LD_GB); } pk[0] = *(const u32x4*)(src + 512); pk[1] = *(const u32x4*)(src + (size_t)32 * LD_GB + 512); } \
            if (MODE == 3) pa = *(const u32x4*)(ATT + ((size_t)bh * 32 + (CH)) * 4096 + tl_ * 8); \
            { const bf16_t* src = GB + (t0_ + (tl_ >> 5)) * LD_GB + 1024 + h * 256 + (tl_ & 31) * 8; pv[0] = *(const u32x4*)src; pv[1] = *(const u32x4*)(src + (size_t)16 * LD_GB); pv[2] = *(const u32x4*)(src + (size_t)32 * LD_GB); pv[3] = *(const u32x4*)(src + (size_t)48 * LD_GB); } \
            if (tl_ < 128) pd = DEC[((size_t)bh * 32 + (CH)) * 128 + tl_]; } while (0)
#define GLA_STAGE() do { int tl_ = tid; asm volatile("" : "+v"(tl_)); \
            if (MODE == 3) { LAS unsigned char* qd = lds + G_QT + (tl_ >> 4) * QROW + (tl_ & 15) * 16; *(LAS u32x4*)qd = pq[0]; *(LAS u32x4*)(qd + 32 * QROW) = pq[1]; } \
            { LAS unsigned char* kd = lds + G_KE + (tl_ >> 4) * KROW + (tl_ & 15) * 16; *(LAS u32x4*)kd = pk[0]; *(LAS u32x4*)(kd + 32 * KROW) = pk[1]; } \
            if (MODE == 3) *(LAS u32x4*)(lds + G_AT + (tl_ >> 3) * AROW + (tl_ & 7) * 16) = pa; \
            { LAS unsigned char* vd = lds + G_V + (tl_ >> 5) * VROW + (tl_ & 31) * 16; *(LAS u32x4*)vd = pv[0]; *(LAS u32x4*)(vd + 16 * VROW) = pv[1]; *(LAS u32x4*)(vd + 32 * VROW) = pv[2]; *(LAS u32x4*)(vd + 48 * VROW) = pv[3]; } \
            if (tl_ < 128) ((LAS float*)(lds + G_DEC))[tl_] = pd; } while (0)
        GLA_LOAD(4 * sc);
        GLA_STAGE();
#pragma unroll 1
        for (int cc = 0; cc < 4; ++cc) {
            const int chunk = 4 * sc + cc;
            __syncthreads();
            if (cc + 1 < 4) GLA_LOAD(chunk + 1);
            bf16x8 vf[4];
#pragma unroll
            for (int ks = 0; ks < 4; ++ks) vf[ks] = tr_frag(lds + G_V + (16 * ks + 8 * hi + trq) * VROW + (eb + 16 * trg + 4 * trp) * 2, 4 * VROW);
            f32x16 o[2];
            if (MODE == 3) {
#pragma unroll
                for (int i = 0; i < 16; ++i) { o[0][i] = 0.f; o[1][i] = 0.f; }
#pragma unroll
                for (int tt = 0; tt < 2; ++tt)
#pragma unroll
                    for (int ks = 0; ks < 4; ++ks) { if (tt == 0 && ks >= 2) continue; const bf16x8 af = *(const LAS bf16x8*)(lds + G_AT + (32 * tt + r32) * AROW + ks * 32 + hi * 16); o[tt] = MFMA32(vf[ks], af, o[tt]); }
                __builtin_amdgcn_sched_barrier(0);
#pragma unroll
                for (int t = 0; t < 4; ++t)
#pragma unroll
                    for (int s2 = 0; s2 < 2; ++s2) { const bf16x8 sa = pack8(S[t], 8 * s2);
#pragma unroll
                        for (int tt = 0; tt < 2; ++tt) { const LAS unsigned char* qp = lds + G_QT + (32 * tt + r32) * QROW + (32 * t + 16 * s2 + 4 * hi) * 2;
                            const u32x2 qa = *(const LAS u32x2*)qp, qb = *(const LAS u32x2*)(qp + 16); const u32x4 qw = {qa.x, qa.y, qb.x, qb.y};
                            o[tt] = MFMA32(sa, __builtin_bit_cast(bf16x8, qw), o[tt]); }
                        __builtin_amdgcn_sched_barrier(0); }
            }
#pragma unroll
            for (int t = 0; t < 4; ++t) {
#pragma unroll
                for (int i = 0; i < 16; ++i) S[t][i] *= ((const LAS float*)(lds + G_DEC))[32 * t + (i & 3) + 8 * (i >> 2) + 4 * hi];
#pragma unroll
                for (int ks = 0; ks < 4; ++ks) { const bf16x8 kf = tr_frag(lds + G_KE + (16 * ks + 8 * hi + trq) * KROW + (32 * t + 16 * trg + 4 * trp) * 2, 4 * KROW); S[t] = MFMA32(kf, vf[ks], S[t]); }
                __builtin_amdgcn_sched_barrier(0); }
            if (MODE == 3) {
#pragma unroll
                for (int tt = 0; tt < 2; ++tt) { float ss = 0.f;
#pragma unroll
                    for (int i = 0; i < 16; ++i) ss += o[tt][i] * o[tt][i];
                    ss += other_half(ss, hi); if (hi == 0) ((LAS float*)(lds + G_SS))[w * 64 + 32 * tt + r32] = ss; } }
            __syncthreads();
            if (cc + 1 < 4) GLA_STAGE();
            if (MODE == 3) {
                const size_t t0 = (size_t)b * NS + chunk * 64;
#pragma unroll
                for (int tt = 0; tt < 2; ++tt) { float tot = 0.f;
#pragma unroll
                    for (int ww = 0; ww < 8; ++ww) tot += ((const LAS float*)(lds + G_SS))[ww * 64 + 32 * tt + r32];
                    const float rstd = __builtin_amdgcn_rsqf(tot * (1.f / 256.f) + EPS);
                    bf16_t* op = GB + (t0 + 32 * tt + r32) * LD_GB + 2048 + h * 256 + eb + 4 * hi;
#pragma unroll
                    for (int gq = 0; gq < 4; ++gq) { const u32x2 ow = *(const u32x2*)(op + 8 * gq); const float og[4] = {bflo(ow.x), bfhi(ow.x), bflo(ow.y), bfhi(ow.y)}; float r[4];
#pragma unroll
                        for (int k = 0; k < 4; ++k) r[k] = o[tt][4 * gq + k] * rstd * gnp[8 * gq + k] * (og[k] * sigmoidf_(og[k]));
                        u32x2 wv; wv.x = pg8::cvt_pk_bf16(r[0], r[1]); wv.y = pg8::cvt_pk_bf16(r[2], r[3]); if (!F.dry) *(u32x2*)(op + 8 * gq) = wv; } } }
        }
        if (MODE == 1) { bf16_t* ps = PSC + ((size_t)bh * 7 + sc) * 32768 + eb + r32;
#pragma unroll
            for (int t = 0; t < 4; ++t)
#pragma unroll
                for (int i = 0; i < 16; ++i) ps[(32 * t + (i & 3) + 8 * (i >> 2) + 4 * hi) * 256] = (bf16_t)f2bf(S[t][i]); }
        __syncthreads();
#undef GLA_LOAD
#undef GLA_STAGE
    }
}
__device__ __forceinline__ void ph_gla_scan(Ctx& F) {
    bf16_t* PSC = (bf16_t*)(F.ws + WS_PSC); const float* DEC = (const float*)(F.ws + WS_DEC);
    for (int it = F.bid * NTHR + F.tid; it < 32 * 32768; it += F.G * NTHR) { const int bh = it >> 15, idx = it & 32767, dk = idx >> 8; float s = 0.f;
#pragma unroll
        for (int sc = 0; sc < 7; ++sc) { const float* d = DEC + ((size_t)bh * 32 + 4 * sc) * 128 + dk; const float D = d[0] * d[128] * d[256] * d[384];
            bf16_t* pp = PSC + ((size_t)bh * 7 + sc) * 32768 + idx; s = D * s + bf1(*pp); *pp = (bf16_t)f2bf(s); } }
}

template <bool WITH_H> __device__ __forceinline__ void ph_res(Ctx& F, const float* xsrc, const float* gz, const float* gh) {
    const float* Z = (const float*)(F.ws + WS_XA); bf16_t* H = (bf16_t*)(F.ws + WS_H); float* out = F.out;
    const int gw = F.bid * NWAVES + F.wave, NGW = F.G * NWAVES;
    for (int m = gw; m < NT; m += NGW) {
        const f32x4* zr = (const f32x4*)(Z + (size_t)m * ND) + F.lane; const f32x4* xr = (const f32x4*)(xsrc + (size_t)m * ND) + F.lane;
        f32x4 z[4], x[4]; float s = 0.f;
#pragma unroll
        for (int j = 0; j < 4; ++j) { z[j] = zr[64 * j]; x[j] = xr[64 * j]; s += (z[j].x * z[j].x + z[j].y * z[j].y) + (z[j].z * z[j].z + z[j].w * z[j].w); }
        const float rstd = __builtin_amdgcn_rsqf(wave_sum(s) * (1.f / ND) + EPS); float s2 = 0.f;
#pragma unroll
        for (int j = 0; j < 4; ++j) { const f32x4 gg = ((const f32x4*)gz + F.lane)[64 * j]; x[j] = x[j] + z[j] * rstd * gg; if (!F.dry) ((f32x4*)(out + (size_t)m * ND) + F.lane)[64 * j] = x[j];
            s2 += (x[j].x * x[j].x + x[j].y * x[j].y) + (x[j].z * x[j].z + x[j].w * x[j].w); }
        if (WITH_H) { const float r2 = __builtin_amdgcn_rsqf(wave_sum(s2) * (1.f / ND) + EPS); unsigned long long* o8 = (unsigned long long*)(H + (size_t)m * ND) + F.lane;
#pragma unroll
            for (int j = 0; j < 4; ++j) { const f32x4 gg = ((const f32x4*)gh + F.lane)[64 * j];
                o8[64 * j] = (unsigned long long)pk2(x[j].x * r2 * gg.x, x[j].y * r2 * gg.y) | ((unsigned long long)pk2(x[j].z * r2 * gg.z, x[j].w * r2 * gg.w) << 32); } }
    }
}

#define XB_TMO      128
#define XB_XCNT(j)  (256  + 64 * (j))
#define XB_XSUB(j)  (1280 + 64 * (j))
#define XB_XGEN(j)  (2304 + 64 * (j))
#define XB_TOP      3328
#define XB_TOPGEN   3392
#define XCD_BAR_WORDS 3456
#define XB_SPIN_CAP (1u << 18)
constexpr size_t WS_BAR = 256 * 1024;
__device__ __forceinline__ unsigned xb_ld(unsigned* p)              { return __hip_atomic_load(p, __ATOMIC_RELAXED, __HIP_MEMORY_SCOPE_AGENT); }
__device__ __forceinline__ unsigned xb_add(unsigned* p, unsigned v) { return __hip_atomic_fetch_add(p, v, __ATOMIC_RELAXED, __HIP_MEMORY_SCOPE_AGENT); }
__device__ __forceinline__ unsigned xb_xcc_id() { return (unsigned)__builtin_amdgcn_s_getreg((3 << 11) | 20) & 0xFu; }
#define XB_SPIN(cond, bar) do { unsigned _sp = 0; while (cond) { __builtin_amdgcn_s_sleep(1); \
    if ((++_sp & 255u) == 0u) { if (xb_ld(&(bar)[XB_TMO])) break; if (_sp > XB_SPIN_CAP) { atomicAdd(&(bar)[XB_TMO], 1u); break; } } } } while (0)
struct XcdBarrier { unsigned* bar; unsigned x; volatile LAS unsigned* st; };
__device__ __forceinline__ XcdBarrier xcd_barrier_post(unsigned* bar, volatile LAS unsigned* st) {
    XcdBarrier b; b.bar = bar; b.x = xb_xcc_id(); b.st = st;
    if (threadIdx.x == 0) (void)xb_add(&bar[XB_XCNT(b.x)], 1u);
    return b;
}
__device__ __forceinline__ void xcd_barrier_complete(unsigned* bar, unsigned x, unsigned& nloc, unsigned& nx) {
    const unsigned G = gridDim.x * gridDim.y * gridDim.z;
    unsigned sum, cnt, mine, sp = 0u;
    for (;;) {
        sum = 0u; cnt = 0u; mine = 0u;
#pragma unroll
        for (unsigned j = 0; j < 16; ++j) { const unsigned c = xb_ld(&bar[XB_XCNT(j)]); sum += c; cnt += (c > 0u) ? 1u : 0u; mine = (j == x) ? c : mine; }
        if (sum == G) break;
        __builtin_amdgcn_s_sleep(1);
        if ((++sp & 255u) == 0u) { if (xb_ld(&bar[XB_TMO])) break; if (sp > XB_SPIN_CAP) { atomicAdd(&bar[XB_TMO], 1u); break; } }
    }
    nloc = mine > 0u ? mine : 1u; nx = cnt > 0u ? cnt : 1u;
}
__device__ __forceinline__ void xcd_barrier(const XcdBarrier& b) {
    asm volatile("s_waitcnt vmcnt(0)" ::: "memory");
    __syncthreads();
    if (threadIdx.x == 0) {
        unsigned* bar = b.bar;
        __builtin_amdgcn_s_waitcnt(0);
        unsigned nloc = b.st[0], nx = b.st[1];
        if (nloc == 0u) { xcd_barrier_complete(bar, b.x, nloc, nx); b.st[0] = nloc; b.st[1] = nx; }
        const unsigned old = xb_add(&bar[XB_XSUB(b.x)], 1u);
        const unsigned gen = old / nloc;
        if (old + 1u == (gen + 1u) * nloc) {
            __builtin_amdgcn_fence(__ATOMIC_RELEASE, "agent");
            asm volatile("s_waitcnt vmcnt(0)" ::: "memory");
            const unsigned og = xb_add(&bar[XB_TOP], 1u);
            const unsigned tg = og / nx;
            if (og + 1u == (tg + 1u) * nx) xb_add(&bar[XB_TOPGEN], 1u);
            else XB_SPIN(xb_ld(&bar[XB_TOPGEN]) == tg, bar);
            __builtin_amdgcn_fence(__ATOMIC_ACQUIRE, "agent");
            xb_add(&bar[XB_XGEN(b.x)], 1u);
            asm volatile("s_waitcnt vmcnt(0)" ::: "memory");
        } else {
            XB_SPIN(xb_ld(&bar[XB_XGEN(b.x)]) == gen, bar);
            __builtin_amdgcn_fence(__ATOMIC_ACQUIRE, "agent");
            asm volatile("s_waitcnt vmcnt(0)" ::: "memory");
        }
    }
    __syncthreads();
}

template <int p> __device__ __forceinline__ void run_phase(Ctx& F, const int L) {
    using namespace pg8;
    unsigned char* ws = F.ws;
        F.L = L; F.xin = (L == 0) ? F.ap->in[I_X] : F.out;
        const float* ng = F.ap->in[I_NORMG] + (size_t)L * 4 * ND;
        StaticOrder S;
        switch (p) {
        case PH_PRE: if constexpr (PH_ON(PH_PRE)) { ph_pre(F); } break;
        case PH_G1: if constexpr (PH_ON(PH_G1)) { { Gemm g{(const bf16_t*)(ws + WS_H), (const bf16_t*)(ws + W_G1), 1024, 1024, 1024, 128}; S.init(64, 8, F.G, F.bid);
            EpiStore<0> E{{(bf16_t*)(ws + WS_XA), 1024, 0}, {(bf16_t*)(ws + WS_GA), 1024, 4}, {nullptr, 0, 0}, 4, 1 << 30, 0, 1.f, 0};
            gemm_phase<EpiStore<0>, true, StaticOrder>(F.lds, g, S, E, F.tid); } } break;
        case PH_LCONV: if constexpr (PH_ON(PH_LCONV)) { ph_lconv(F); } break;
        case PH_LGATE: if constexpr (PH_ON(PH_LGATE)) { { int k256 = 256; asm volatile("" : "+s"(k256));
            Gemm g{(const bf16_t*)(ws + WS_XC), (const bf16_t*)(ws + W_LRU), 1024, k256, k256, 128}; LruOrder LS; LS.init(64, 8, F.G, F.bid);
            EpiLru E{(const bf16_t*)(ws + WS_XC), (bf16_t*)(ws + WS_LA), (bf16_t*)(ws + WS_U), F.ap->in[I_LRUB] + (size_t)L * 2048, (const float*)(ws + WS_CTL) + CT_C8};
            gemm_phase<EpiLru, true, LruOrder>(F.lds, g, LS, E, F.tid); } } break;
        case PH_LSCAN: if constexpr (PH_ON(PH_LSCAN)) { ph_lscan(F); } break;
        case PH_G23: if constexpr (PH_ON(PH_G23)) { { Gemm g{(const bf16_t*)(ws + WS_H), (const bf16_t*)(ws + W_G23), 1024, 1024, 1024, 128}; S.init(64, 23, F.G, F.bid);
            EpiStore<0> E{{(bf16_t*)(ws + WS_NB), LD_NB, 0}, {(bf16_t*)(ws + WS_GB), LD_GB, 11}, {nullptr, 0, 0}, 11, 1 << 30, 4, 0.125f, 0};
            gemm_phase<EpiStore<0>, true, StaticOrder>(F.lds, g, S, E, F.tid); } } break;
        case PH_M1: if constexpr (PH_ON(PH_M1)) { {
            Gemm g{(const bf16_t*)(ws + WS_NB) + 1024, (const bf16_t*)(ws + W_C1), 16 * LD_NB, 1024, 1024, LD_NB * 2}; CmpOrder CS{F.G, F.bid, 0};
            EpiStore<0> E{{(bf16_t*)(ws + WS_HID), 512, 0}, {nullptr, 0, 0}, {nullptr, 0, 0}, 1 << 30, 1 << 30, 0, 1.f, (size_t)1024 * 512};
            gemm_phase<EpiStore<0>, false, CmpOrder>(F.lds, g, CS, E, F.tid); }
            if (F.bid == F.G - 1) { float* ctl = (float*)(ws + WS_CTL); float a = 0.f;
#pragma unroll 8
                for (int j = 0; j < 64; ++j) a += ctl[CT_C1P + j * 512 + F.tid];
                ctl[CT_C1 + F.tid] = a; }
            ph_gla1(F); } break;
        case PH_M2: if constexpr (PH_ON(PH_M2)) { ph_cmp2g(F); ph_gla_sc<1>(F); } break;
        case PH_M3: if constexpr (PH_ON(PH_M3)) { ph_gla_scan(F); ph_att_mfma(F); } break;
        case PH_GLA: if constexpr (PH_ON(PH_GLA)) { ph_gla_sc<3>(F); } break;
        case PH_G4: if constexpr (PH_ON(PH_G4)) { { Gemm g{(const bf16_t*)(ws + WS_H), (const bf16_t*)(ws + W_G4), 1024, 1024, 1024, 128}; S.init(64, 12, F.G, F.bid);
            EpiStore<2> E{{(bf16_t*)(ws + WS_XA), 1024, 0}, {(bf16_t*)(ws + WS_NB) + 1024, LD_NB, 4}, {(bf16_t*)(ws + WS_GB), LD_GB, 8}, 4, 8, 0, 1.f, 0};
            gemm_phase<EpiStore<2>, true, StaticOrder>(F.lds, g, S, E, F.tid); } } break;
        case PH_BR: if constexpr (PH_ON(PH_BR)) { { S.init(64, 4, F.G, F.bid); bf16_t* MO = (bf16_t*)(ws + WS_GB) + 1024;
            { Gemm g{(const bf16_t*)(ws + WS_GA), (const bf16_t*)(ws + W_BR), 1024, 1024, 1024, 128}; EpiBranch<true> E{(const bf16_t*)(ws + WS_XA), 1024, MO, LD_GB}; gemm_phase<EpiBranch<true>, false, StaticOrder>(F.lds, g, S, E, F.tid); }
            { Gemm g{(const bf16_t*)(ws + WS_NB), (const bf16_t*)(ws + W_BR) + (size_t)ND * ND, LD_NB, 1024, 1024, 128}; EpiBranch<false> E{(const bf16_t*)(ws + WS_NB) + 1024, LD_NB, MO, LD_GB}; gemm_phase<EpiBranch<false>, false, StaticOrder>(F.lds, g, S, E, F.tid); }
            { Gemm g{(const bf16_t*)(ws + WS_GB) + 2048, (const bf16_t*)(ws + W_BR) + (size_t)2 * ND * ND, LD_GB, 1024, 1024, 128}; EpiBranch<false> E{(const bf16_t*)(ws + WS_GB), LD_GB, MO, LD_GB}; gemm_phase<EpiBranch<false>, false, StaticOrder>(F.lds, g, S, E, F.tid); } } } break;
        case PH_OUT: if constexpr (PH_ON(PH_OUT)) { { Gemm g{(const bf16_t*)(ws + WS_GB) + 1024, (const bf16_t*)(ws + W_OUT), LD_GB, 1024, 1024, 128}; S.init(64, 4, F.G, F.bid);
            EpiF32 E{(float*)(ws + WS_XA), 1024}; gemm_phase<EpiF32, false, StaticOrder>(F.lds, g, S, E, F.tid); } } break;
        case PH_RES1: if constexpr (PH_ON(PH_RES1)) { ph_res<true>(F, F.xin, ng + 1 * ND, ng + 2 * ND); } break;
        case PH_FI: if constexpr (PH_ON(PH_FI)) { { Gemm g{(const bf16_t*)(ws + WS_H), (const bf16_t*)(ws + W_FI), 1024, 1024, 1024, 128}; S.init(64, 22, F.G, F.bid);
            EpiSwiGLU E{(bf16_t*)(ws + WS_NB), DFF}; gemm_phase<EpiSwiGLU, true, StaticOrder>(F.lds, g, S, E, F.tid); } } break;
        case PH_FO: if constexpr (PH_ON(PH_FO)) { { Gemm g{(const bf16_t*)(ws + WS_NB), (const bf16_t*)(ws + W_FO), DFF, DFF, DFF, 128}; S.init(64, 4, F.G, F.bid);
            EpiF32 E{(float*)(ws + WS_XA), 1024}; gemm_phase<EpiF32, false, StaticOrder>(F.lds, g, S, E, F.tid); } } break;
        case PH_RES2: if constexpr (PH_ON(PH_RES2)) { ph_res<false>(F, F.out, ng + 3 * ND, nullptr); } break;
        }
}
constexpr int LDS_BYTES = 147456;
template <bool COOP> __global__ void __launch_bounds__(NTHR, 2) mk_fwd(Args args) {
    extern __shared__ __attribute__((aligned(16))) unsigned char lds_raw[];
    Ctx F; F.lds = (LAS unsigned char*)lds_raw; F.ldsg = lds_raw;
    F.tid = threadIdx.x; F.lane = F.tid & 63; F.wave = __builtin_amdgcn_readfirstlane(F.tid >> 6); F.G = gridDim.x; F.bid = blockIdx.x;
    const int lo = args.ph_lo, hi = args.ph_hi;
    volatile LAS unsigned* xst = (volatile LAS unsigned*)(F.lds + LDS_BYTES - 64);
    if (threadIdx.x < 16) xst[threadIdx.x] = 0u;
    __syncthreads();
    XcdBarrier xbar; xbar.bar = nullptr; xbar.x = 0; xbar.st = xst;
    if (COOP) xbar = xcd_barrier_post((unsigned*)(args.ws + WS_CTL + WS_BAR), xst);
#define MK_SEAM(IDX_) do { if ((IDX_) == 0) cg::this_grid().sync(); else xcd_barrier(xbar); } while (0)
#define MK_PHASE(L_, P_) if (lo <= (L_) * NPH + (P_) && (L_) * NPH + (P_) < hi) { \
        { int bid_ = blockIdx.x; asm volatile("" : "+s"(bid_)); F.bid = bid_; \
          int tid_ = threadIdx.x; asm volatile("" : "+v"(tid_)); F.tid = tid_; F.lane = tid_ & 63; F.wave = __builtin_amdgcn_readfirstlane(tid_ >> 6); \
          unsigned long long apl_ = (unsigned long long)__builtin_amdgcn_kernarg_segment_ptr(); asm volatile("" : "+s"(apl_)); F.ap = (ArgsP)apl_; \
          F.ws = F.ap->ws; F.out = F.ap->out; F.G = gridDim.x; } \
        if constexpr (COOP && (((MK_DRY) >> (P_)) & 1u)) { F.dry = true; run_phase<P_>(F, L_); xcd_barrier(xbar); } \
        F.dry = false; run_phase<P_>(F, L_); \
        if constexpr (COOP && (((MK_DUP) >> (P_)) & 1u)) { xcd_barrier(xbar); run_phase<P_>(F, L_); } \
        if constexpr (COOP && MK_XSYNC > 0) { for (int x_ = 0; x_ < MK_XSYNC; ++x_) xcd_barrier(xbar); } \
        if (COOP) { if ((L_) * NPH + (P_) + 1 < hi) MK_SEAM((L_) * NPH + (P_)); } }
#define MK_LAYER(L_) MK_PHASE(L_, 0) MK_PHASE(L_, 1) MK_PHASE(L_, 2) MK_PHASE(L_, 3) MK_PHASE(L_, 4) MK_PHASE(L_, 5) MK_PHASE(L_, 6) MK_PHASE(L_, 7) MK_PHASE(L_, 8) \
        MK_PHASE(L_, 9) MK_PHASE(L_, 10) MK_PHASE(L_, 11) MK_PHASE(L_, 12) MK_PHASE(L_, 13) MK_PHASE(L_, 14) MK_PHASE(L_, 15) MK_PHASE(L_, 16)
    MK_LAYER(0)
    MK_LAYER(1)
}

extern "C" void kernel_launch(void* const* d_in, const int* in_sizes, int n_in, void* d_out, int out_size, void* d_ws, size_t ws_size, hipStream_t stream) {
    static int grid = 0;
    if (grid == 0) {
        if (n_in != 19 || out_size != NT * ND || ws_size < WS_END) { fprintf(stderr, "kernel_launch: unexpected shapes/workspace (n_in %d out %d ws %zu need %zu)\n", n_in, out_size, ws_size, (size_t)WS_END); grid = -1; return; }
        int dev = 0, cus = 0, per_cu = 0;
        hipGetDevice(&dev); hipDeviceGetAttribute(&cus, hipDeviceAttributeMultiprocessorCount, dev);
        hipFuncSetAttribute((const void*)mk_fwd<true>, hipFuncAttributeMaxDynamicSharedMemorySize, LDS_BYTES);
        hipFuncSetAttribute((const void*)mk_fwd<false>, hipFuncAttributeMaxDynamicSharedMemorySize, LDS_BYTES);
        hipOccupancyMaxActiveBlocksPerMultiprocessor(&per_cu, (const void*)mk_fwd<true>, NTHR, LDS_BYTES);
        if (per_cu < 1) { fprintf(stderr, "kernel_launch: occupancy query says %d blocks/CU\n", per_cu); per_cu = 1; }
        (void)hipGetLastError();
        grid = cus;
    }
    if (grid < 0) return;
    Args a{};
    for (int i = 0; i < 19; ++i) a.in[i] = (const float*)d_in[i];
    a.out = (float*)d_out; a.ws = (unsigned char*)d_ws;
#if MK_COOP
    a.ph_lo = 0; a.ph_hi = 2 * NPH;
    if (hipMemsetAsync((char*)d_ws + WS_CTL + WS_BAR, 0, 16384, stream) != hipSuccess) { fprintf(stderr, "kernel_launch: memset of barrier words failed\n"); return; }
    void* kargs[] = {&a};
    hipError_t e = hipLaunchCooperativeKernel((const void*)mk_fwd<true>, dim3(grid), dim3(NTHR), kargs, LDS_BYTES, stream);
    if (e != hipSuccess) fprintf(stderr, "cooperative launch failed: %s (grid %d)\n", hipGetErrorString(e), grid);
#else
    for (int ph = 0; ph < 2 * NPH; ++ph) {
        a.ph_lo = ph; a.ph_hi = ph + 1;
        hipLaunchKernelGGL(mk_fwd<false>, dim3(grid), dim3(NTHR), LDS_BYTES, stream, a);
    }
#endif
}
```

```cpp
#include <hip/hip_runtime.h>
#include <hip/hip_cooperative_groups.h>
#include <cstdio>
#include <cstdint>
namespace cg = cooperative_groups;

#ifndef MK_COOP
#define MK_COOP 1
#endif
#ifndef MK_DUP
#define MK_DUP 0u
#endif
#ifndef MK_DRY
#define MK_DRY 0u
#endif
#ifndef MK_XSYNC
#define MK_XSYNC 0
#endif
#ifndef MK_PM
#define MK_PM 0xFFFFFFFFu
#endif
#define PH_ON(p) (((MK_PM) >> (p)) & 1u)

#define LAS __attribute__((address_space(3)))
typedef unsigned short bf16_t;
typedef short bf16x8 __attribute__((ext_vector_type(8)));
typedef float f32x4 __attribute__((ext_vector_type(4)));
typedef float f32x2 __attribute__((ext_vector_type(2)));
typedef unsigned u32x4 __attribute__((ext_vector_type(4)));
typedef unsigned u32x2 __attribute__((ext_vector_type(2)));

constexpr int NB_ = 8, NS = 2048, ND = 1024, NT = NB_ * NS;
constexpr int IN_W = 10816, DFF = 2816;
constexpr int LD_NB = 2816, LD_GB = 3072;
constexpr float EPS = 1e-6f;
constexpr int NTHR = 512, NWAVES = 8;

constexpr size_t MiB = 1u << 20;
constexpr size_t WS_CTL = 0;
constexpr size_t WS_W = 1 * MiB;
constexpr size_t W_G1 = WS_W;
constexpr size_t W_G23 = W_G1 + 4 * MiB;
constexpr size_t W_G4 = W_G23 + 5888ull * 1024 * 2;
constexpr size_t W_LRU = W_G4 + 6 * MiB;
constexpr size_t W_BR = W_LRU + 4 * MiB;
constexpr size_t W_OUT = W_BR + 6 * MiB;
constexpr size_t W_FI = W_OUT + 2 * MiB;
constexpr size_t W_FO = W_FI + 11 * MiB;
constexpr size_t W_C1 = W_FO + 1024ull * 2816 * 2;
constexpr size_t W_END = W_C1 + 2 * MiB;
constexpr size_t WS_H = 54 * MiB;
constexpr size_t WS_XA = 86 * MiB;
constexpr size_t WS_GA = 118 * MiB;
constexpr size_t WS_NB = 150 * MiB;
constexpr size_t WS_GB = 238 * MiB;
constexpr size_t WS_END = 334 * MiB;
static_assert(W_END <= WS_H, "weights region");
constexpr size_t WS_XC = WS_NB, WS_LA = WS_NB + 32 * MiB, WS_U = WS_NB + 64 * MiB;
constexpr size_t WS_HID = WS_XA + 23 * MiB + 512 * 1024;
constexpr size_t WS_KC = WS_XA + 22 * MiB + 512 * 1024;
constexpr int CT_C8 = 0;
constexpr int CT_RB = 1024;
constexpr int CT_C1 = 4096;
constexpr int CT_C1P = 8192;

__device__ __forceinline__ unsigned f2bf(float f) { unsigned u = __float_as_uint(f); return (u + 0x7fffu + ((u >> 16) & 1u)) >> 16; }
__device__ __forceinline__ unsigned pk2(float lo, float hi) { return f2bf(lo) | (f2bf(hi) << 16); }
__device__ __forceinline__ float bflo(unsigned w) { return __uint_as_float(w << 16); }
__device__ __forceinline__ float bfhi(unsigned w) { return __uint_as_float(w & 0xffff0000u); }
__device__ __forceinline__ float bf1(bf16_t h) { return __uint_as_float((unsigned)h << 16); }
__device__ __forceinline__ float sigmoidf_(float x) { return __builtin_amdgcn_rcpf(1.f + __expf(-x)); }
__device__ __forceinline__ float gelu_tanh(float x) { const float u = 1.5957691216057308f * (x + 0.044715f * x * x * x); return x * sigmoidf_(u); }
__device__ __forceinline__ float wave_sum(float v) {
    v += __int_as_float(__builtin_amdgcn_ds_swizzle(__float_as_int(v), 0x041f));
    v += __int_as_float(__builtin_amdgcn_ds_swizzle(__float_as_int(v), 0x081f));
    v += __int_as_float(__builtin_amdgcn_ds_swizzle(__float_as_int(v), 0x101f));
    v += __int_as_float(__builtin_amdgcn_ds_swizzle(__float_as_int(v), 0x201f));
    v += __int_as_float(__builtin_amdgcn_ds_swizzle(__float_as_int(v), 0x401f));
    auto rr = __builtin_amdgcn_permlane32_swap(__float_as_uint(v), __float_as_uint(v), false, false);
    return __uint_as_float(rr[0]) + __uint_as_float(rr[1]);
}
__device__ __forceinline__ int rel_bucket(int n) {
    if (n < 16) return n;
    int b = 16;
    b += (n >= 19) + (n >= 21) + (n >= 24) + (n >= 27) + (n >= 31) + (n >= 35) + (n >= 40) + (n >= 46) + (n >= 52) + (n >= 59) + (n >= 67) + (n >= 77) + (n >= 87) + (n >= 99) + (n >= 113);
    return b;
}

namespace pg8 {
constexpr int BM = 256, BK = 64, HALF = 128, HTB = HALF * BK * 2, STAGE_BYTES = 8 * HTB, NXCD = 8, WGM = 8;
__device__ __forceinline__ int lds_byte(int r, int c) { const int st = (r >> 4) * 2 + (c >> 5), rr = r & 15, cc = c & 31, ob = rr * 64 + cc * 2; return st * 1024 + (ob ^ (((ob >> 9) & 1) << 5)); }
__device__ __forceinline__ void stage_rc(int b, int& R, int& C) { const int st = b / 1024, sb = b % 1024, swz = sb ^ (((sb >> 9) & 1) << 5); R = (st >> 1) * 16 + swz / 64; C = (st & 1) * 32 + (swz % 64) / 2; }
__device__ __forceinline__ int perm32(int rho) { const int n = rho >> 4, i = rho & 15; return 8 * (i >> 2) + 4 * n + (i & 3); }

struct Unit { int pm, pn, z; };
struct Gemm { const bf16_t* A; const bf16_t* Bt; int lda, ldb, K, kstepA; };

struct StaticOrder {
    static constexpr bool VARLDA = false;
    int nM, nN, nwg, G, c;
    __device__ void init(int nM_, int nN_, int G_, int c_) { nM = nM_; nN = nN_; nwg = nM * nN; G = G_; c = c_; }
    __device__ bool next(int i, Unit& u) const {
        const long L = (long)i * G + c; if (L >= nwg) return false;
        int wgid = (int)L; { const int q = nwg / NXCD, r = nwg % NXCD, xcd = wgid % NXCD, off = wgid / NXCD; wgid = (xcd < r ? xcd * (q + 1) : r * (q + 1) + (xcd - r) * q) + off; }
        const int nig = WGM * nN, gid = wgid / nig, fm = gid * WGM, gsz = (nM - fm) < WGM ? (nM - fm) : WGM;
        u.pm = fm + ((wgid % nig) % gsz); u.pn = (wgid % nig) / gsz; u.z = 0; return true;
    }
    __device__ __forceinline__ size_t aoff(const Unit& u, size_t ta) const { return (size_t)u.pm * ta; }
    __device__ __forceinline__ size_t boff(const Unit& u, size_t tb) const { return (size_t)u.pn * tb; }
};
struct LruOrder : StaticOrder {
    __device__ __forceinline__ size_t aoff(const Unit& u, size_t ta) const { return (size_t)u.pm * ta + (size_t)(u.pn >> 1) * 512; }
};
struct BrOrder {
    static constexpr bool VARLDA = true;
    StaticOrder so; size_t a1, a2;
    __device__ bool next(int i, Unit& u) const { if (i >= 3) return false; const bool ok = so.next(0, u); u.z = i; return ok; }
    __device__ __forceinline__ unsigned lda2(const Unit& u) const { return u.z == 0 ? 1024u * 2u : (u.z == 1 ? (unsigned)LD_NB * 2u : (unsigned)LD_GB * 2u); }
    __device__ __forceinline__ size_t aoff(const Unit& u, size_t) const { return (size_t)u.pm * 256 * lda2(u) + (u.z == 0 ? (size_t)0 : (u.z == 1 ? a1 : a2)); }
    __device__ __forceinline__ size_t boff(const Unit& u, size_t tb) const { return (size_t)u.pn * tb + (size_t)u.z * ND * ND * 2; }
};
struct CmpOrder {
    static constexpr bool VARLDA = false;
    int G, c, base;
    __device__ bool next(int i, Unit& u) const { if (i > 0) return false; const int k = c - base; if (k < 0 || k >= 64) return false; u.z = k >> 3; u.pm = (k & 7) >> 1; u.pn = k & 1; return true; }
    __device__ __forceinline__ size_t aoff(const Unit& u, size_t ta) const { return (size_t)u.pm * ta + (size_t)((u.z >> 2) * 256 + (u.z & 3) * 64) * 2; }
    __device__ __forceinline__ size_t boff(const Unit& u, size_t tb) const { return (size_t)u.pn * tb + (size_t)(u.z >> 2) * 512 * 1024 * 2; }
};

typedef __bf16 bf16x2_t __attribute__((ext_vector_type(2)));
__device__ __forceinline__ unsigned cvt_pk_bf16(float lo, float hi) { const f32x2 v = {lo, hi}; const bf16x2_t b = __builtin_convertvector(v, bf16x2_t); return __builtin_bit_cast(unsigned, b); }

struct Seg { bf16_t* base; int ld; int tile0; };
template <int ACT  > struct EpiStore {
    static constexpr bool PERM = true;
    Seg s0, s1, s2; int t1, t2; int nscale; float scale; size_t zs;
    __device__ __forceinline__ void operator()(const f32x4 (&acc)[2][2][4][2], const Unit& u, int wr, int wc, int fr, int fq) const {
        const bool c1_ = u.pn < t1, c2_ = u.pn < t2;
        bf16_t* const pb0 = s0.base; bf16_t* const pb1 = s1.base; bf16_t* const pb2 = s2.base; const int l0 = s0.ld, l1 = s1.ld, l2 = s2.ld, q0 = s0.tile0, q1 = s1.tile0, q2 = s2.tile0;
        bf16_t* base = (c1_ ? pb0 : (c2_ ? pb1 : pb2)) + (size_t)u.z * zs; const int ld = c1_ ? l0 : (c2_ ? l1 : l2), t0 = c1_ ? q0 : (c2_ ? q1 : q2);
        const float sc = u.pn < nscale ? scale : 1.f;
        const int row0 = u.pm * BM + wr * 64 + fr, col0 = (u.pn - t0) * BM + wc * 32 + 8 * fq;
#pragma unroll
        for (int ai = 0; ai < 2; ++ai)
#pragma unroll
            for (int m = 0; m < 4; ++m) { bf16_t* rowp = base + (size_t)(row0 + ai * HALF + m * 16) * ld + col0;
#pragma unroll
                for (int bj = 0; bj < 2; ++bj) { f32x4 v0 = acc[ai][bj][m][0] * sc, v1 = acc[ai][bj][m][1] * sc;
                    if (ACT == 2) {
#pragma unroll
                        for (int j = 0; j < 4; ++j) { v0[j] = sigmoidf_(v0[j]); v1[j] = sigmoidf_(v1[j]); } }
                    u32x4 w; w.x = cvt_pk_bf16(v0[0], v0[1]); w.y = cvt_pk_bf16(v0[2], v0[3]); w.z = cvt_pk_bf16(v1[0], v1[1]); w.w = cvt_pk_bf16(v1[2], v1[3]);
                    *(u32x4*)(rowp + bj * HALF) = w; }
                if (ACT != 0) __builtin_amdgcn_sched_barrier(0); }
    }
};
struct EpiLru {
    static constexpr bool PERM = false;
    const bf16_t* XC; bf16_t* LA; bf16_t* U; const float* bg; const float* c8;
    __device__ __forceinline__ void operator()(const f32x4 (&acc)[2][2][4][2], const Unit& u, int wr, int wc, int fr, int fq) const {
        const int row0 = u.pm * BM + wr * 64 + fr, ch0 = u.pn * HALF + wc * 32 + 4 * fq;
#pragma unroll
        for (int n = 0; n < 2; ++n) { const int ch = ch0 + n * 16;
            const f32x4 br = *(const f32x4*)(bg + ch), bi = *(const f32x4*)(bg + 1024 + ch), cc = *(const f32x4*)(c8 + ch);
            u32x2 xw = *(const u32x2*)(XC + (size_t)row0 * 1024 + ch);
#pragma unroll
            for (int it = 0; it < 8; ++it) { const int ai = it >> 2, m = it & 3; const size_t off = (size_t)(row0 + ai * HALF + m * 16) * 1024 + ch;
                u32x2 xn = xw; if (it < 7) xn = *(const u32x2*)(XC + (size_t)(row0 + ((it + 1) >> 2) * HALF + ((it + 1) & 3) * 16) * 1024 + ch);
                const float xv[4] = {bflo(xw.x), bfhi(xw.x), bflo(xw.y), bfhi(xw.y)};
                float la[4], uu[4];
#pragma unroll
                for (int j = 0; j < 4; ++j) { const float r = sigmoidf_(acc[ai][0][m][n][j] + br[j]), ig = sigmoidf_(acc[ai][1][m][n][j] + bi[j]);
                    la[j] = cc[j] * r; uu[j] = __builtin_amdgcn_sqrtf(fmaxf(1.f - __expf(2.f * la[j]), 0.f)) * (ig * xv[j]); }
                u32x2 wl, wu; wl.x = cvt_pk_bf16(la[0], la[1]); wl.y = cvt_pk_bf16(la[2], la[3]); wu.x = cvt_pk_bf16(uu[0], uu[1]); wu.y = cvt_pk_bf16(uu[2], uu[3]);
                *(u32x2*)(LA + off) = wl; *(u32x2*)(U + off) = wu; xw = xn;
                __builtin_amdgcn_sched_barrier(0); } }
    }
};
__device__ __forceinline__ u32x4 ld16_agent(const void* p) {
    const unsigned long long* q = (const unsigned long long*)p;
    const unsigned long long a = __hip_atomic_load(q, __ATOMIC_RELAXED, __HIP_MEMORY_SCOPE_AGENT), b = __hip_atomic_load(q + 1, __ATOMIC_RELAXED, __HIP_MEMORY_SCOPE_AGENT);
    return (u32x4){(unsigned)a, (unsigned)(a >> 32), (unsigned)b, (unsigned)(b >> 32)};
}
struct EpiBranch {
    static constexpr bool PERM = true;
    const bf16_t* G0; const bf16_t* G1; const bf16_t* G2; int ldg0, ldg1, ldg2; bf16_t* O; int ldo;
    __device__ __forceinline__ void operator()(const f32x4 (&acc)[2][2][4][2], const Unit& u, int wr, int wc, int fr, int fq) const {
        const bf16_t* const g0p = G0; const bf16_t* const g1p = G1; const bf16_t* const g2p = G2; const int l0 = ldg0, l1 = ldg1, l2 = ldg2;
        const bf16_t* G = u.z == 0 ? g0p : (u.z == 1 ? g1p : g2p); const int ldg = u.z == 0 ? l0 : (u.z == 1 ? l1 : l2); const bool first = u.z == 0;
        const int row0 = u.pm * BM + wr * 64 + fr, col0 = u.pn * BM + wc * 32 + 8 * fq;
        u32x4 gw[2], ow[2];
#pragma unroll
        for (int bj = 0; bj < 2; ++bj) { gw[bj] = *(const u32x4*)(G + (size_t)row0 * ldg + col0 + bj * HALF); ow[bj] = (u32x4){0u, 0u, 0u, 0u}; if (!first) ow[bj] = *(const u32x4*)(O + (size_t)row0 * ldo + col0 + bj * HALF); }
#pragma unroll
        for (int it = 0; it < 8; ++it) { const int ai = it >> 2, m = it & 3; const size_t r = (size_t)(row0 + ai * HALF + m * 16);
            u32x4 gn[2], on[2];
#pragma unroll
            for (int bj = 0; bj < 2; ++bj) { gn[bj] = gw[bj]; on[bj] = ow[bj]; }
            if (it < 7) { const size_t rn = (size_t)(row0 + ((it + 1) >> 2) * HALF + ((it + 1) & 3) * 16);
#pragma unroll
                for (int bj = 0; bj < 2; ++bj) { gn[bj] = *(const u32x4*)(G + rn * ldg + col0 + bj * HALF); if (!first) on[bj] = *(const u32x4*)(O + rn * ldo + col0 + bj * HALF); } }
#pragma unroll
            for (int bj = 0; bj < 2; ++bj) { const u32x4 g4 = gw[bj]; const u32x4 o4 = ow[bj];
                float v[8] = {acc[ai][bj][m][0][0] * bflo(g4.x) + bflo(o4.x), acc[ai][bj][m][0][1] * bfhi(g4.x) + bfhi(o4.x), acc[ai][bj][m][0][2] * bflo(g4.y) + bflo(o4.y), acc[ai][bj][m][0][3] * bfhi(g4.y) + bfhi(o4.y),
                              acc[ai][bj][m][1][0] * bflo(g4.z) + bflo(o4.z), acc[ai][bj][m][1][1] * bfhi(g4.z) + bfhi(o4.z), acc[ai][bj][m][1][2] * bflo(g4.w) + bflo(o4.w), acc[ai][bj][m][1][3] * bfhi(g4.w) + bfhi(o4.w)};
                u32x4 w; w.x = cvt_pk_bf16(v[0], v[1]); w.y = cvt_pk_bf16(v[2], v[3]); w.z = cvt_pk_bf16(v[4], v[5]); w.w = cvt_pk_bf16(v[6], v[7]);
                *(u32x4*)(O + r * ldo + col0 + bj * HALF) = w; }
#pragma unroll
            for (int bj = 0; bj < 2; ++bj) { gw[bj] = gn[bj]; ow[bj] = on[bj]; }
            __builtin_amdgcn_sched_barrier(0); }
    }
};
struct EpiF32 {
    static constexpr bool PERM = false;
    float* O; int ldc;
    __device__ __forceinline__ void operator()(const f32x4 (&acc)[2][2][4][2], const Unit& u, int wr, int wc, int fr, int fq) const {
        const int row0 = u.pm * BM + wr * 64 + fr, col0 = u.pn * BM + wc * 32 + 4 * fq;
#pragma unroll
        for (int ai = 0; ai < 2; ++ai)
#pragma unroll
            for (int m = 0; m < 4; ++m) { float* rowp = O + (size_t)(row0 + ai * HALF + m * 16) * ldc + col0;
#pragma unroll
                for (int bj = 0; bj < 2; ++bj)
#pragma unroll
                    for (int n = 0; n < 2; ++n) *(f32x4*)(rowp + bj * HALF + n * 16) = acc[ai][bj][m][n]; }
    }
};
struct EpiSwiGLU {
    static constexpr bool PERM = true;
    bf16_t* O; int ldc;
    __device__ __forceinline__ void operator()(const f32x4 (&acc)[2][2][4][2], const Unit& u, int wr, int wc, int fr, int fq) const {
        const int row0 = u.pm * BM + wr * 64 + fr, col0 = u.pn * HALF + wc * 32 + 8 * fq;
#pragma unroll
        for (int ai = 0; ai < 2; ++ai)
#pragma unroll
            for (int m = 0; m < 4; ++m) { bf16_t* rowp = O + (size_t)(row0 + ai * HALF + m * 16) * ldc + col0;
                float v[8];
#pragma unroll
                for (int n = 0; n < 2; ++n)
#pragma unroll
                    for (int j = 0; j < 4; ++j) { const float g = acc[ai][0][m][n][j], up = acc[ai][1][m][n][j]; v[n * 4 + j] = g * sigmoidf_(g) * up; }
                u32x4 w; w.x = cvt_pk_bf16(v[0], v[1]); w.y = cvt_pk_bf16(v[2], v[3]); w.z = cvt_pk_bf16(v[4], v[5]); w.w = cvt_pk_bf16(v[6], v[7]);
                *(u32x4*)rowp = w; }
    }
};

template <class Epi, bool ALIGN_EPI, class Sched>
__device__ __forceinline__ void gemm_phase(LAS unsigned char* lds, const Gemm g, const Sched& S, const Epi& E, const int tid) {
    const int wid = __builtin_amdgcn_readfirstlane(tid >> 6), lane = tid & 63, wr = wid >> 2, wc = wid & 3, fr = lane & 15, fq = lane >> 4;
    const int K = g.K, nt = K / BK;
    unsigned rA[2], cA2[2], voffB[2];
#pragma unroll
    for (int i = 0; i < 2; ++i) { int R, C; stage_rc(tid * 16 + i * 8192, R, C); const int Rb = Epi::PERM ? ((R & ~31) + perm32(R & 31)) : R;
        rA[i] = (unsigned)R; cA2[i] = (unsigned)C * 2u; voffB[i] = (unsigned)(Rb * g.ldb + C) * 2u; }
    const size_t kstep = (size_t)(BK * 2), kstA = (size_t)g.kstepA;
    const size_t hstepB = (size_t)HALF * g.ldb * 2;
    const size_t tstepA = (size_t)2 * HALF * g.lda * 2, tstepB = 2 * hstepB;
    unsigned lda2c = (unsigned)g.lda * 2u, lda2n = lda2c;
    const unsigned ldsw = (unsigned)wid * 1024u;
    const int aoff = lds_byte(wr * 64 + fr, fq * 8), boff = lds_byte(wc * 32 + fr, fq * 8);
#define PG8_SA(b, h) (((b) * 2 + (h)) * HTB)
#define PG8_SB(b, h) ((4 + (b) * 2 + (h)) * HTB)
#define PG8_STAGE(bufoff, gbase, voff) do { _Pragma("unroll") for (int _i = 0; _i < 2; ++_i) \
        __builtin_amdgcn_global_load_lds((const unsigned*)((const char*)(gbase) + (voff)[_i]), (LAS unsigned*)(lds + (bufoff) + ldsw + _i * 8192), 16, 0, 0); } while (0)
#define PG8_STAGEA(bufoff, gbase, l2) do { _Pragma("unroll") for (int _i = 0; _i < 2; ++_i) \
        __builtin_amdgcn_global_load_lds((const unsigned*)((const char*)(gbase) + (rA[_i] * (l2) + cA2[_i])), (LAS unsigned*)(lds + (bufoff) + ldsw + _i * 8192), 16, 0, 0); } while (0)
#define PG8_LDA(dst, b, h) do { _Pragma("unroll") for (int m = 0; m < 4; ++m) _Pragma("unroll") for (int k = 0; k < 2; ++k) dst[m][k] = *(const LAS bf16x8*)(lds + PG8_SA(b, h) + aoff + m * 2048 + k * 1024); } while (0)
#define PG8_LDB(dst, b, h) do { _Pragma("unroll") for (int n = 0; n < 2; ++n) _Pragma("unroll") for (int k = 0; k < 2; ++k) dst[n][k] = *(const LAS bf16x8*)(lds + PG8_SB(b, h) + boff + n * 2048 + k * 1024); } while (0)
#define PG8_MMA(ai, bj, At, Bt) do { __builtin_amdgcn_s_setprio(1); _Pragma("unroll") for (int m = 0; m < 4; ++m) _Pragma("unroll") for (int n = 0; n < 2; ++n) _Pragma("unroll") for (int k = 0; k < 2; ++k) \
        acc[ai][bj][m][n] = __builtin_amdgcn_mfma_f32_16x16x32_bf16(Bt[n][k], At[m][k], acc[ai][bj][m][n], 0, 0, 0); __builtin_amdgcn_s_setprio(0); } while (0)
#define PG8_WAIT_V(n) asm volatile("s_waitcnt vmcnt(" #n ")" ::: "memory")
#define PG8_WAIT_L(n) asm volatile("s_waitcnt lgkmcnt(" #n ")" ::: "memory")
#define PG8_BAR __builtin_amdgcn_s_barrier()
#define PG8_SCHED __builtin_amdgcn_sched_barrier(0)
#define PG8_AOFF(u_) (S.aoff((u_), tstepA))
#define PG8_BOFF(u_) (S.boff((u_), tstepB))
    Unit cur, nxt; int ui = 0;
    if (!S.next(0, cur)) return;
    f32x4 acc[2][2][4][2];
#pragma unroll
    for (int a = 0; a < 2; ++a)
#pragma unroll
        for (int b = 0; b < 2; ++b)
#pragma unroll
            for (int m = 0; m < 4; ++m)
#pragma unroll
                for (int n = 0; n < 2; ++n) acc[a][b][m][n] = (f32x4){0.f, 0.f, 0.f, 0.f};
    bf16x8 At[4][2], B0[2][2], B1[2][2];
    if constexpr (Sched::VARLDA) { lda2c = S.lda2(cur); lda2n = lda2c; }
    const char* cA = (const char*)g.A + PG8_AOFF(cur); const char* cB = (const char*)g.Bt + PG8_BOFF(cur);
    PG8_STAGE(PG8_SB(0, 0), cB, voffB); PG8_STAGE(PG8_SB(0, 1), cB + hstepB, voffB); PG8_STAGEA(PG8_SA(0, 0), cA, lda2c); PG8_STAGEA(PG8_SA(0, 1), cA + (size_t)HALF * lda2c, lda2c);
    if (wr == 1) PG8_BAR;
    PG8_WAIT_V(2); PG8_BAR;
    PG8_STAGE(PG8_SB(1, 0), cB + kstep, voffB); PG8_STAGEA(PG8_SA(1, 0), cA + kstA, lda2c); PG8_STAGE(PG8_SB(1, 1), cB + hstepB + kstep, voffB);
    PG8_WAIT_V(6); PG8_BAR;
    for (;;) {
        const bool has_next = S.next(ui + 1, nxt);
        if constexpr (Sched::VARLDA) lda2n = has_next ? S.lda2(nxt) : lda2c;
        const char* nA = has_next ? (const char*)g.A + PG8_AOFF(nxt) : cA; const char* nB = has_next ? (const char*)g.Bt + PG8_BOFF(nxt) : cB;
        for (int t = 0; t < nt; t += 2) {
            const bool last = (t == nt - 2);
            const char* a1 = cA + (size_t)(t + 1) * kstA;
            const char* a2 = last ? nA : cA + (size_t)(t + 2) * kstA; const char* b2 = last ? nB : cB + (size_t)(t + 2) * kstep;
            const char* a3 = a2 + kstA; const char* b3 = b2 + kstep;
            const unsigned l2x = (Sched::VARLDA && last) ? lda2n : lda2c;
            PG8_LDB(B0, 0, 0); PG8_LDB(B1, 0, 1); PG8_SCHED; PG8_LDA(At, 0, 0); PG8_STAGEA(PG8_SA(1, 1), a1 + (size_t)HALF * lda2c, lda2c);
            PG8_WAIT_V(8); PG8_WAIT_L(0); PG8_BAR; PG8_MMA(0, 0, At, B0); PG8_MMA(0, 1, At, B1); PG8_BAR; PG8_SCHED;
            PG8_LDA(At, 0, 1); PG8_STAGE(PG8_SB(0, 0), b2, voffB); PG8_STAGE(PG8_SB(0, 1), b2 + hstepB, voffB); PG8_STAGEA(PG8_SA(0, 0), a2, l2x);
            PG8_WAIT_V(8); PG8_WAIT_L(0); PG8_BAR; PG8_MMA(1, 0, At, B0); PG8_MMA(1, 1, At, B1); PG8_BAR; PG8_SCHED;
            PG8_LDB(B0, 1, 0); PG8_LDB(B1, 1, 1); PG8_SCHED; PG8_LDA(At, 1, 0); PG8_STAGEA(PG8_SA(0, 1), a2 + (size_t)HALF * l2x, l2x);
            PG8_WAIT_V(8); PG8_WAIT_L(0); PG8_BAR; PG8_MMA(0, 0, At, B0); PG8_MMA(0, 1, At, B1); PG8_BAR; PG8_SCHED;
            PG8_LDA(At, 1, 1); PG8_STAGE(PG8_SB(1, 0), b3, voffB); PG8_STAGE(PG8_SB(1, 1), b3 + hstepB, voffB); PG8_STAGEA(PG8_SA(1, 0), a3, l2x);
            PG8_WAIT_V(8); PG8_WAIT_L(0); PG8_BAR; PG8_MMA(1, 0, At, B0); PG8_MMA(1, 1, At, B1); PG8_BAR; PG8_SCHED;
        }
        if constexpr (ALIGN_EPI) { if (wr == 0) PG8_BAR; }
        E(acc, cur, wr, wc, fr, fq);
        if (!has_next) break;
#pragma unroll
        for (int a = 0; a < 2; ++a)
#pragma unroll
            for (int b = 0; b < 2; ++b)
#pragma unroll
                for (int m = 0; m < 4; ++m)
#pragma unroll
                    for (int n = 0; n < 2; ++n) acc[a][b][m][n] = (f32x4){0.f, 0.f, 0.f, 0.f};
        cur = nxt; cA = nA; cB = nB; ++ui; lda2c = lda2n;
        if constexpr (ALIGN_EPI) { if (wr == 1) PG8_BAR; }
    }
    PG8_WAIT_V(0);
    if constexpr (!ALIGN_EPI) { if (wr == 0) PG8_BAR; }
    PG8_BAR;
#undef PG8_SA
#undef PG8_SB
#undef PG8_STAGE
#undef PG8_STAGEA
#undef PG8_LDA
#undef PG8_LDB
#undef PG8_MMA
#undef PG8_WAIT_V
#undef PG8_WAIT_L
#undef PG8_BAR
#undef PG8_SCHED
#undef PG8_AOFF
#undef PG8_BOFF
}
}

struct Args { const float* in[19]; float* out; unsigned char* ws; int ph_lo, ph_hi; };
enum { I_X = 0, I_REL, I_NORMG, I_WIN, I_CONVW, I_CONVB, I_LRUW, I_LRUB, I_LAM, I_CPOS, I_CW1, I_CW2, I_WA2, I_BA, I_GNORM, I_WBR, I_WOUT, I_WFI, I_WFO };
enum { PH_PRE = 0, PH_G1, PH_LCONV, PH_LGATE, PH_LSCAN, PH_G23, PH_M1, PH_M2, PH_M3, PH_GLA, PH_G4, PH_BR, PH_OUT, PH_RES1, PH_FI, PH_FO, PH_RES2, NPH };

typedef const Args __attribute__((address_space(4)))* ArgsP;
struct Ctx {
    ArgsP ap; float* out; unsigned char* ws; LAS unsigned char* lds; unsigned char* ldsg;
    int tid, lane, wave, G, bid, L; bool dry;
    const float* xin;
};

template <int MODE> __device__ __forceinline__ int srccol(int n) {
    if (MODE == 0) return n;
    if (MODE == 1) { if (n < 2560) return 2048 + n; if (n < 2608) return 4608 + (n - 2560); if (n < 2624) return 7728 + (n - 2608); if (n < 2816) return -1; return 4656 + (n - 2816); }
    if (MODE == 2) return 7744 + n;
      { const int t = n >> 8, j = n & 255; return j < 128 ? t * 128 + j : DFF + t * 128 + (j - 128); }
}
template <int MODE> __device__ __forceinline__ void tr_item(const float* W, int ldw, bf16_t* WT, int ldd, int nblk, int item, LAS float* scr, int lane) {
    const int kb = item / nblk, nb = item % nblk, k0 = 64 * kb, n0 = 32 * nb;
    const int n4 = (lane & 7) * 4, sc = srccol<MODE>(n0 + n4);
    f32x4 v[8];
#pragma unroll
    for (int i = 0; i < 8; ++i) { const int kk = (lane >> 3) + 8 * i; v[i] = sc >= 0 ? *(const f32x4*)(W + (size_t)(k0 + kk) * ldw + sc) : (f32x4){0.f, 0.f, 0.f, 0.f}; }
#pragma unroll
    for (int i = 0; i < 8; ++i) { const int kk = (lane >> 3) + 8 * i; LAS float* d = scr + kk * 33 + n4; d[0] = v[i].x; d[1] = v[i].y; d[2] = v[i].z; d[3] = v[i].w; }
    asm volatile("s_waitcnt lgkmcnt(0)" ::: "memory");
    const int c = lane & 7;
#pragma unroll
    for (int j = 0; j < 4; ++j) { const int n = (lane >> 3) + 8 * j; const LAS float* s = scr + (8 * c) * 33 + n;
        u32x4 o; o.x = pk2(s[0 * 33], s[1 * 33]); o.y = pk2(s[2 * 33], s[3 * 33]); o.z = pk2(s[4 * 33], s[5 * 33]); o.w = pk2(s[6 * 33], s[7 * 33]);
        *(u32x4*)(WT + (size_t)(n0 + n) * ldd + k0 + 8 * c) = o; }
    asm volatile("s_waitcnt lgkmcnt(0)" ::: "memory");
}
__device__ __forceinline__ void rms_row_to_bf16(const float* xrow, const float* g, bf16_t* orow, int lane) {
    const f32x4* xr = (const f32x4*)xrow + lane; const f32x4* gr = (const f32x4*)g + lane;
    f32x4 v[4]; float s = 0.f;
#pragma unroll
    for (int j = 0; j < 4; ++j) { v[j] = xr[64 * j]; s += (v[j].x * v[j].x + v[j].y * v[j].y) + (v[j].z * v[j].z + v[j].w * v[j].w); }
    const float rstd = __builtin_amdgcn_rsqf(wave_sum(s) * (1.f / ND) + EPS);
    unsigned long long* o8 = (unsigned long long*)orow + lane;
#pragma unroll
    for (int j = 0; j < 4; ++j) { const f32x4 gg = gr[64 * j]; o8[64 * j] = (unsigned long long)pk2(v[j].x * rstd * gg.x, v[j].y * rstd * gg.y) | ((unsigned long long)pk2(v[j].z * rstd * gg.z, v[j].w * rstd * gg.w) << 32); }
}
__device__ __forceinline__ void ph_pre(Ctx& F) {
    const int L = F.L;
    LAS float* scr = (LAS float*)(F.lds + F.wave * 16384);
    const int gw = F.bid * NWAVES + F.wave, NGW = F.G * NWAVES;
    const float* win = F.ap->in[I_WIN] + (size_t)L * ND * IN_W;
    constexpr int I_G1 = 64 * 16, I_G23 = 184 * 16, I_G4 = 96 * 16, I_BR1 = 32 * 16, I_OUT = 32 * 16, I_FI = 176 * 16, I_FO = 32 * 44;
    constexpr int I_C1 = 8 * 16;
    constexpr int NITEMS = I_G1 + I_G23 + I_G4 + 3 * I_BR1 + I_OUT + I_FI + I_FO + 4 * I_C1;
    for (int it = gw; it < NITEMS; it += NGW) {
        int r = it;
        if (r < I_G1) { tr_item<0>(win, IN_W, (bf16_t*)(F.ws + W_G1), 1024, 64, r, scr, F.lane); continue; } r -= I_G1;
        if (r < I_G23) { tr_item<1>(win, IN_W, (bf16_t*)(F.ws + W_G23), 1024, 184, r, scr, F.lane); continue; } r -= I_G23;
        if (r < I_G4) { tr_item<2>(win, IN_W, (bf16_t*)(F.ws + W_G4), 1024, 96, r, scr, F.lane); continue; } r -= I_G4;
        if (r < 3 * I_BR1) { const int b = r / I_BR1; tr_item<0>(F.ap->in[I_WBR] + ((size_t)L * 3 + b) * ND * ND, ND, (bf16_t*)(F.ws + W_BR) + (size_t)b * ND * ND, 1024, 32, r % I_BR1, scr, F.lane); continue; } r -= 3 * I_BR1;
        if (r < I_OUT) { tr_item<0>(F.ap->in[I_WOUT] + (size_t)L * ND * ND, ND, (bf16_t*)(F.ws + W_OUT), 1024, 32, r, scr, F.lane); continue; } r -= I_OUT;
        if (r < I_FI) { tr_item<3>(F.ap->in[I_WFI] + (size_t)L * ND * 2 * DFF, 2 * DFF, (bf16_t*)(F.ws + W_FI), 1024, 176, r, scr, F.lane); continue; } r -= I_FI;
        if (r < I_FO) { tr_item<0>(F.ap->in[I_WFO] + (size_t)L * DFF * ND, ND, (bf16_t*)(F.ws + W_FO), DFF, 32, r, scr, F.lane); continue; } r -= I_FO;
        { const int q = r / I_C1, kv = q >> 1, half = q & 1;
          tr_item<0>(F.ap->in[I_CW1] + ((size_t)(L * 2 + kv) * 2048 + 1024 * half) * 256, 256, (bf16_t*)(F.ws + W_C1) + ((size_t)kv * 512 + 256 * half) * 1024, 1024, 8, r % I_C1, scr, F.lane); }
    }
    if (F.bid < 64) { const int kv = F.tid >> 8, n = F.tid & 255, k0 = 32 * F.bid; const float* w1 = F.ap->in[I_CW1] + ((size_t)(L * 2 + kv) * 2048 + k0) * 256 + n; const float* pos = F.ap->in[I_CPOS] + (size_t)(L * 2 + kv) * 2048 + k0;
        float a0 = 0.f, a1 = 0.f;
#pragma unroll
        for (int k = 0; k < 32; k += 2) { a0 += pos[k] * w1[(size_t)k * 256]; a1 += pos[k + 1] * w1[(size_t)(k + 1) * 256]; }
        ((float*)(F.ws + WS_CTL))[CT_C1P + F.bid * 512 + F.tid] = a0 + a1; }
    {
        const float* lw = F.ap->in[I_LRUW] + (size_t)L * 2 * 8 * 128 * 128; bf16_t* wt = (bf16_t*)(F.ws + W_LRU);
        for (int it = F.bid * NTHR + F.tid; it < 2048 * 32; it += F.G * NTHR) {
            const int row = it >> 5, kc = (it & 31) * 8, blk = row >> 8, g2 = (row >> 7) & 1, e = row & 127;
            u32x4 o = (u32x4){0u, 0u, 0u, 0u};
            if ((kc >> 7) == (blk & 1)) { const int c0 = kc & 127; const float* s = lw + ((size_t)(g2 * 8 + blk) * 128 + c0) * 128 + e;
                o.x = pk2(s[0], s[128]); o.y = pk2(s[256], s[384]); o.z = pk2(s[512], s[640]); o.w = pk2(s[768], s[896]); }
            *(u32x4*)(wt + (size_t)row * 256 + kc) = o;
        }
    }
    {
        float* ctl = (float*)(F.ws + WS_CTL);
        const int gt = F.bid * NTHR + F.tid;
        if (gt < 1024) { const float lam = F.ap->in[I_LAM][L * 1024 + gt]; const float e = __expf(-lam); const float sp = e < 0.03f ? e * (1.f - e * (0.5f - e * (0.33333333f - 0.25f * e))) : __logf(1.f + e); ctl[CT_C8 + gt] = -8.f * sp; }
        else if (gt < 1024 + 2048) { const int i = gt - 1024, h = i >> 7, d = i & 127; ctl[CT_RB + i] = F.ap->in[I_REL][rel_bucket(d) * 16 + h]; }
    }
    const float* g0 = F.ap->in[I_NORMG] + (size_t)(L * 4 + 0) * ND; bf16_t* H = (bf16_t*)(F.ws + WS_H);
    if (L == 0) for (int m = gw; m < NT; m += NGW) rms_row_to_bf16(F.xin + (size_t)m * ND, g0, H + (size_t)m * ND, F.lane);
}

__device__ __forceinline__ void ph_lconv(Ctx& F) {
    const int L = F.L;
    const bf16_t* XA = (const bf16_t*)(F.ws + WS_XA); bf16_t* XC = (bf16_t*)(F.ws + WS_XC);
    const float* cw = F.ap->in[I_CONVW] + (size_t)L * 4 * 1024; const float* cb = F.ap->in[I_CONVB] + (size_t)L * 1024;
    for (int idx = F.bid * NTHR + F.tid; idx < (NT / 16) * 128; idx += F.G * NTHR) {
        const int tg = idx >> 7, c8 = (idx & 127) * 8, t0 = tg * 16, s0 = t0 & (NS - 1);
        u32x4 r[19];
#pragma unroll
        for (int i = 0; i < 19; ++i) r[i] = (s0 + i - 3 >= 0) ? *(const u32x4*)(XA + (size_t)(t0 + i - 3) * 1024 + c8) : (u32x4){0u, 0u, 0u, 0u};
        float wv[4][8], bv[8];
#pragma unroll
        for (int i = 0; i < 8; ++i) { bv[i] = cb[c8 + i];
#pragma unroll
            for (int j = 0; j < 4; ++j) wv[j][i] = cw[j * 1024 + c8 + i]; }
#pragma unroll
        for (int t = 0; t < 16; ++t) { float acc[8];
#pragma unroll
            for (int i = 0; i < 8; ++i) acc[i] = bv[i];
#pragma unroll
            for (int j = 0; j < 4; ++j) { const u32x4 w = r[t + j];
                acc[0] += wv[j][0] * bflo(w.x); acc[1] += wv[j][1] * bfhi(w.x); acc[2] += wv[j][2] * bflo(w.y); acc[3] += wv[j][3] * bfhi(w.y);
                acc[4] += wv[j][4] * bflo(w.z); acc[5] += wv[j][5] * bfhi(w.z); acc[6] += wv[j][6] * bflo(w.w); acc[7] += wv[j][7] * bfhi(w.w); }
            u32x4 o; o.x = pk2(acc[0], acc[1]); o.y = pk2(acc[2], acc[3]); o.z = pk2(acc[4], acc[5]); o.w = pk2(acc[6], acc[7]);
            *(u32x4*)(XC + (size_t)(t0 + t) * 1024 + c8) = o; }
    }
}

__device__ __forceinline__ void ph_lscan(Ctx& F) {
    const bf16_t* LA = (const bf16_t*)(F.ws + WS_LA); const bf16_t* U = (const bf16_t*)(F.ws + WS_U); bf16_t* GA = (bf16_t*)(F.ws + WS_GA);
    LAS float* sA = (LAS float*)F.lds; LAS float* sH = sA + 32 * 32;
    const int chunk = F.tid >> 4, cl = F.tid & 15;
    for (int unit = F.bid; unit < NB_ * 32; unit += F.G) {
        const int b = unit >> 5, c = (unit & 31) * 32 + cl * 2;
        const size_t base = ((size_t)b * NS + chunk * 64) * 1024 + c;
        float s0 = 0.f, s1 = 0.f, h0 = 0.f, h1 = 0.f;
#pragma unroll 16
        for (int i = 0; i < 64; ++i) { const unsigned lw = *(const unsigned*)(LA + base + (size_t)i * 1024), uw = *(const unsigned*)(U + base + (size_t)i * 1024);
            const float l0 = bflo(lw), l1 = bfhi(lw); s0 += l0; s1 += l1; h0 = __expf(l0) * h0 + bflo(uw); h1 = __expf(l1) * h1 + bfhi(uw); }
        sA[chunk * 32 + cl * 2] = s0; sA[chunk * 32 + cl * 2 + 1] = s1; sH[chunk * 32 + cl * 2] = h0; sH[chunk * 32 + cl * 2 + 1] = h1;
        __syncthreads();
        h0 = 0.f; h1 = 0.f;
        for (int k = 0; k < chunk; ++k) { h0 = __expf(sA[k * 32 + cl * 2]) * h0 + sH[k * 32 + cl * 2]; h1 = __expf(sA[k * 32 + cl * 2 + 1]) * h1 + sH[k * 32 + cl * 2 + 1]; }
#pragma unroll 8
        for (int i = 0; i < 64; ++i) { const unsigned lw = *(const unsigned*)(LA + base + (size_t)i * 1024), uw = *(const unsigned*)(U + base + (size_t)i * 1024);
            h0 = __expf(bflo(lw)) * h0 + bflo(uw); h1 = __expf(bfhi(lw)) * h1 + bfhi(uw);
            unsigned* gp = (unsigned*)(GA + base + (size_t)i * 1024); const unsigned gw = *gp;
            if (!F.dry) *gp = pk2(h0 * gelu_tanh(bflo(gw)), h1 * gelu_tanh(bfhi(gw))); }
        __syncthreads();
    }
}

__device__ __forceinline__ void ph_cmp2g(Ctx& F) {
    const int L = F.L;
    const bf16_t* P = (const bf16_t*)(F.ws + WS_HID); bf16_t* KC = (bf16_t*)(F.ws + WS_KC); const float* c1 = (const float*)(F.ws + WS_CTL) + CT_C1;
    LAS float* hid = (LAS float*)F.lds;
    for (int unit = F.bid; unit < 2 * 32 * 16; unit += F.G) {
        const int cg = unit & 15, bg = (unit >> 4) & 31, kv = unit >> 9, b = bg >> 2, g = bg & 3;
        const bf16_t* Pb = P + ((size_t)(kv * 4 + g) * 1024 + b * 128) * 512;
#pragma unroll
        for (int it = 0; it < 4; ++it) { const int e = F.tid + it * 512, cl = e >> 8, n = e & 255, c = cg * 8 + cl;
            float v = 0.f; if (c < 127) v = gelu_tanh(bf1(Pb[(size_t)c * 512 + n]) + bf1(Pb[(size_t)(c + 1) * 512 + 256 + n]) + c1[kv * 256 + n]);
            hid[cl * 256 + n] = v; }
        __syncthreads();
        { const int cl = F.tid >> 6, d = F.tid & 63, c = cg * 8 + cl; const float* w2 = F.ap->in[I_CW2] + (size_t)(L * 2 + kv) * 256 * 64 + d; float acc = 0.f;
#pragma unroll 8
            for (int n = 0; n < 256; ++n) acc += hid[cl * 256 + n] * w2[n * 64];
            KC[((size_t)(kv * 32 + bg) * 128 + c) * 64 + d] = (bf16_t)f2bf(c < 127 ? acc : 0.f); }
        __syncthreads();
    }
}
typedef float f32x16 __attribute__((ext_vector_type(16)));
#define MFMA32(a, b, c) __builtin_amdgcn_mfma_f32_32x32x16_bf16((a), (b), (c), 0, 0, 0)
typedef short v4i16_t __attribute__((ext_vector_type(4)));
__device__ __forceinline__ bf16x8 tr_frag(const LAS unsigned char* p, const int row4_bytes) {
    const v4i16_t a = __builtin_amdgcn_ds_read_tr16_b64_v4i16((LAS v4i16_t*)p), b = __builtin_amdgcn_ds_read_tr16_b64_v4i16((LAS v4i16_t*)(p + row4_bytes));
    return __builtin_shufflevector(a, b, 0, 1, 2, 3, 4, 5, 6, 7);
}
namespace att {
constexpr int KROW = 144, VROW = 192, KCROW = 144, VCROW = 192;
constexpr int L_KB = 0, L_VB = 2 * 64 * KROW, L_KC = L_VB + 2 * 64 * VROW, L_VC = L_KC + 128 * KCROW, L_RB = L_VC + 128 * VCROW, L_IMP = L_RB + 4 * 256 * 4, L_SEL = L_IMP + 4 * 64 * 33 * 4, L_END = L_SEL + 66 * 4;
static_assert(L_END <= 140000, "attention LDS map");
constexpr float LOG2E = 1.4426950408889634f;
}
__device__ __forceinline__ float other_half(float v, int hi) { auto rr = __builtin_amdgcn_permlane32_swap(__float_as_uint(v), __float_as_uint(v), false, false); return __uint_as_float(hi ? rr[0] : rr[1]); }
__device__ __forceinline__ bf16x8 pack8(const f32x16& p, const int s8) {
    u32x4 w; w.x = pg8::cvt_pk_bf16(p[s8], p[s8 + 1]); w.y = pg8::cvt_pk_bf16(p[s8 + 2], p[s8 + 3]); w.z = pg8::cvt_pk_bf16(p[s8 + 4], p[s8 + 5]); w.w = pg8::cvt_pk_bf16(p[s8 + 6], p[s8 + 7]);
    return __builtin_bit_cast(bf16x8, w);
}
__device__ __forceinline__ void ph_att_mfma(Ctx& F) {
    using namespace att;
    bf16_t* NBp = (bf16_t*)(F.ws + WS_NB); const bf16_t* KCg = (const bf16_t*)(F.ws + WS_KC);
    const float* RB = (const float*)(F.ws + WS_CTL) + CT_RB;
    LAS unsigned char* lds = F.lds;
    const int tid = F.tid, lane = F.lane, w = F.wave, r32 = lane & 31, hi = lane >> 5, hr = w >> 1, qh = w & 1;
    const int trq = (lane & 15) >> 2, trp = lane & 3, trg = (lane >> 4) & 1;
    const float NEG = -__builtin_inff();
    for (int unit = F.bid; unit < 1024; unit += F.G) {
        const int bg = unit & 31, rnd = unit >> 8, kq = (unit >> 5) & 7, c = rnd == 0 ? 31 - kq : (rnd == 1 ? 16 + kq : (rnd == 2 ? 15 - kq : kq)), b = bg >> 2, g = bg & 3, h = g * 4 + hr;
        const int s0 = 64 * c, qidx = 32 * qh + r32, s = s0 + qidx;
        const size_t trow = (size_t)b * NS + s;
        { const bf16_t* kc = KCg + (size_t)bg * 128 * 64; const bf16_t* vc = KCg + (size_t)(32 + bg) * 128 * 64;
#pragma unroll
            for (int it = 0; it < 2; ++it) { const int e = tid + it * 512, key = e >> 3, ch = e & 7;
                const u32x4 kv = *(const u32x4*)(kc + key * 64 + ch * 8); *(LAS u32x4*)(lds + L_KC + key * KCROW + ch * 16) = kv;
                const u32x4 vv = *(const u32x4*)(vc + key * 64 + ch * 8); *(LAS u32x4*)(lds + L_VC + key * VCROW + ch * 16) = vv; }
#pragma unroll
            for (int it = 0; it < 2; ++it) { const int e = tid + it * 512, hh = e >> 8, d = e & 255; ((LAS float*)(lds + L_RB))[e] = RB[(g * 4 + hh) * 128 + (d < 127 ? d : 127)] * LOG2E; } }
        bf16x8 qf[4];
#pragma unroll
        for (int ds = 0; ds < 4; ++ds) qf[ds] = *(const bf16x8*)(NBp + trow * LD_NB + h * 64 + 16 * ds + 8 * hi);
        float g0, g1, g2; { const bf16_t* gp = NBp + trow * LD_NB + 2560 + h; g0 = sigmoidf_(bf1(gp[0])); g1 = sigmoidf_(bf1(gp[16])); g2 = sigmoidf_(bf1(gp[32])); }
        const LAS float* rbl = (const LAS float*)(lds + L_RB) + hr * 256;
        __syncthreads();
        f32x16 y[2], o[2];
#pragma unroll
        for (int i = 0; i < 16; ++i) { y[0][i] = 0.f; y[1][i] = 0.f; o[0][i] = 0.f; o[1][i] = 0.f; }
        {
            f32x16 sc[4]; const int nck = 4 * c + 3;
#pragma unroll
            for (int sub = 0; sub < 4; ++sub) {
#pragma unroll
                for (int i = 0; i < 16; ++i) sc[sub][i] = 0.f;
                if (32 * sub < nck) {
#pragma unroll
                    for (int ds = 0; ds < 4; ++ds) { const bf16x8 a = *(const LAS bf16x8*)(lds + L_KC + (32 * sub + r32) * KCROW + ds * 32 + hi * 16); sc[sub] = MFMA32(a, qf[ds], sc[sub]); } } }
            float mx = NEG;
#pragma unroll
            for (int sub = 0; sub < 4; ++sub)
#pragma unroll
                for (int i = 0; i < 16; ++i) { const int cc = 32 * sub + (i & 3) + 8 * (i >> 2) + 4 * hi; const int dist = s - 16 * cc - 31;
                    const float tb = rbl[dist < 0 ? 0 : (dist > 255 ? 255 : dist)]; const float x = dist >= 0 ? sc[sub][i] * LOG2E + tb : NEG; sc[sub][i] = x; mx = fmaxf(mx, x); }
            mx = fmaxf(mx, other_half(mx, hi)); const float mu = mx == NEG ? 0.f : mx;
            float l = 0.f;
#pragma unroll
            for (int sub = 0; sub < 4; ++sub)
#pragma unroll
                for (int i = 0; i < 16; ++i) { const float p = __builtin_amdgcn_exp2f(sc[sub][i] - mu); sc[sub][i] = p; l += p; }
            l += other_half(l, hi); const float inv = l > 0.f ? __builtin_amdgcn_rcpf(l) : 0.f;
#pragma unroll
            for (int sub = 0; sub < 4; ++sub)
#pragma unroll
                for (int i = 0; i < 16; ++i) sc[sub][i] *= inv;
            { LAS float* imp = (LAS float*)(lds + L_IMP) + (hr * 64 + qidx) * 33; float tprev = 0.f;
#pragma unroll
                for (int sub = 0; sub < 4; ++sub)
#pragma unroll
                    for (int gq = 0; gq < 4; ++gq) { const float t = 0.5f * sc[sub][4 * gq + 3]; const float G = sc[sub][4 * gq] + sc[sub][4 * gq + 1] + sc[sub][4 * gq + 2] + t;
                        const float to = other_half(t, hi);
                        imp[8 * sub + 2 * gq + hi] = G + (hi ? to : tprev); tprev = to; } }
#pragma unroll
            for (int ks = 0; ks < 8; ++ks) { if (16 * ks >= nck) continue; const bf16x8 pf = pack8(sc[ks >> 1], (ks & 1) * 8);
#pragma unroll
                for (int dt = 0; dt < 2; ++dt) o[dt] = MFMA32(tr_frag(lds + L_VC + (16 * ks + 4 * hi + trq) * VCROW + (32 * dt + 16 * trg + 4 * trp) * 2, 8 * VCROW), pf, o[dt]); }
#pragma unroll
            for (int i = 0; i < 16; ++i) { y[0][i] = g0 * o[0][i]; y[1][i] = g0 * o[1][i]; o[0][i] = 0.f; o[1][i] = 0.f; }
        }
        __syncthreads();
        if (w == 0) {
            unsigned mask;
            if (c <= 7) mask = (2u << c) - 1u;
            else {
                const LAS float* imp = (const LAS float*)(lds + L_IMP) + lane * 33; float tot[32];
#pragma unroll
                for (int j = 0; j < 32; ++j) tot[j] = imp[j] + imp[64 * 33 + j] + imp[2 * 64 * 33 + j] + imp[3 * 64 * 33 + j];
                mask = 1u | (1u << c) | (1u << (c - 1));
#pragma unroll 1
                for (int k = 0; k < 5; ++k) { float best = -1.f; int bj = 1;
#pragma unroll
                    for (int j = 1; j < 30; ++j) { const bool ok = (j <= c - 2) && !((mask >> j) & 1u) && tot[j] > best; best = ok ? tot[j] : best; bj = ok ? j : bj; }
                    mask |= 1u << bj; } }
            ((LAS unsigned*)(lds + L_SEL))[lane] = mask;
            unsigned un = mask;
            un |= (unsigned)__builtin_amdgcn_ds_swizzle((int)un, 0x041f); un |= (unsigned)__builtin_amdgcn_ds_swizzle((int)un, 0x081f); un |= (unsigned)__builtin_amdgcn_ds_swizzle((int)un, 0x101f);
            un |= (unsigned)__builtin_amdgcn_ds_swizzle((int)un, 0x201f); un |= (unsigned)__builtin_amdgcn_ds_swizzle((int)un, 0x401f);
            { auto rr = __builtin_amdgcn_permlane32_swap(un, un, false, false); un = rr[0] | rr[1]; }
            if (lane == 0) ((LAS unsigned*)(lds + L_SEL))[64] = un;
        }
        __syncthreads();
        const unsigned mymask = ((const LAS unsigned*)(lds + L_SEL))[qidx];
        unsigned uni = (unsigned)__builtin_amdgcn_readfirstlane((int)((const LAS unsigned*)(lds + L_SEL))[64]);
        const bf16_t* kvb = NBp + (size_t)b * NS * LD_NB + 1024 + g * 64;
        const int skey = tid >> 3, sch = tid & 7;
        const int nslc = __builtin_popcount(uni), jw0 = c - 4 > 0 ? c - 4 : 0, nitem = nslc + (c - jw0 + 1);
        float m = -1e30f, l = 0.f;
        u32x4 kreg, vreg;
        int jcur; bool wincur;
        { const bool isw = nslc == 0; jcur = isw ? jw0 : __builtin_ctz(uni); wincur = isw; if (!isw) uni &= uni - 1; }
        { const bf16_t* src = kvb + (size_t)(64 * jcur + skey) * LD_NB + (wincur ? 4 * 256 : 2 * 256) + sch * 8; kreg = *(const u32x4*)src; vreg = *(const u32x4*)(src + 256); }
        { *(LAS u32x4*)(lds + L_KB + skey * KROW + sch * 16) = kreg; *(LAS u32x4*)(lds + L_VB + skey * VROW + sch * 16) = vreg; }
        __syncthreads();
        const float b31 = rbl[255];
#pragma unroll 1
        for (int it = 0; it < nitem; ++it) {
            const int buf = it & 1;
            int jn = 0; bool winn = false; const bool hasn = it + 1 < nitem;
            if (hasn) { const bool isw = it + 1 >= nslc; jn = isw ? jw0 + (it + 1 - nslc) : __builtin_ctz(uni); winn = isw; if (!isw) uni &= uni - 1;
                const bf16_t* src = kvb + (size_t)(64 * jn + skey) * LD_NB + (winn ? 4 * 256 : 2 * 256) + sch * 8; kreg = *(const u32x4*)src; vreg = *(const u32x4*)(src + 256); }
            if (wincur && it == nslc && nslc > 0) { const float sc_ = g1 * __builtin_amdgcn_rcpf(l);
#pragma unroll
                for (int i = 0; i < 16; ++i) { y[0][i] += sc_ * o[0][i]; y[1][i] += sc_ * o[1][i]; o[0][i] = 0.f; o[1][i] = 0.f; }
                m = -1e30f; l = 0.f; }
            const bool wave_has = wincur || __any((mymask >> jcur) & 1u);
            if (wave_has) {
            f32x16 p0, p1;
#pragma unroll
            for (int i = 0; i < 16; ++i) { p0[i] = 0.f; p1[i] = 0.f; }
            { const LAS unsigned char* kb = lds + L_KB + buf * 64 * KROW + r32 * KROW + hi * 16;
#pragma unroll
                for (int ds = 0; ds < 4; ++ds) { const bf16x8 a0 = *(const LAS bf16x8*)(kb + ds * 32), a1 = *(const LAS bf16x8*)(kb + 32 * KROW + ds * 32); p0 = MFMA32(a0, qf[ds], p0); p1 = MFMA32(a1, qf[ds], p1); } }
            const int dj = c - jcur;
            float bm = -1e30f;
            if (!wincur && dj >= 3) {
                const float cst = ((mymask >> jcur) & 1u) ? b31 : NEG;
#pragma unroll
                for (int i = 0; i < 16; ++i) { p0[i] = p0[i] * LOG2E + cst; p1[i] = p1[i] * LOG2E + cst; bm = fmaxf(bm, fmaxf(p0[i], p1[i])); }
            } else {
                const bool lane_ok = wincur || ((mymask >> jcur) & 1u); const int base = 64 * dj + qidx;
#pragma unroll
                for (int i = 0; i < 16; ++i) { const int kk = (i & 3) + 8 * (i >> 2) + 4 * hi; const int d0 = base - kk, d1 = d0 - 32;
                    const bool v0 = lane_ok && (unsigned)d0 < 256u, v1 = lane_ok && (unsigned)d1 < 256u;
                    const float t0 = rbl[(unsigned)d0 < 256u ? d0 : 0], t1 = rbl[(unsigned)d1 < 256u ? d1 : 0];
                    p0[i] = v0 ? p0[i] * LOG2E + t0 : NEG; p1[i] = v1 ? p1[i] * LOG2E + t1 : NEG; bm = fmaxf(bm, fmaxf(p0[i], p1[i])); }
            }
            bm = fmaxf(bm, other_half(bm, hi));
            const float mn = fmaxf(m, bm), alpha = __builtin_amdgcn_exp2f(m - mn); m = mn;
            float ls = 0.f;
#pragma unroll
            for (int i = 0; i < 16; ++i) { p0[i] = __builtin_amdgcn_exp2f(p0[i] - mn); p1[i] = __builtin_amdgcn_exp2f(p1[i] - mn); ls += p0[i] + p1[i]; }
            ls += other_half(ls, hi); l = l * alpha + ls;
            if (__any(alpha != 1.f)) {
#pragma unroll
                for (int i = 0; i < 16; ++i) { o[0][i] *= alpha; o[1][i] *= alpha; } }
            { const LAS unsigned char* vbp = lds + L_VB + buf * 64 * VROW + (4 * hi + trq) * VROW + (16 * trg + 4 * trp) * 2;
#pragma unroll
                for (int ks = 0; ks < 4; ++ks) { const bf16x8 pf = (ks < 2) ? pack8(p0, (ks & 1) * 8) : pack8(p1, (ks & 1) * 8);
#pragma unroll
                    for (int dt = 0; dt < 2; ++dt) o[dt] = MFMA32(tr_frag(vbp + 16 * ks * VROW + dt * 64, 8 * VROW), pf, o[dt]); } }
            }
            if (hasn) { *(LAS u32x4*)(lds + L_KB + (buf ^ 1) * 64 * KROW + skey * KROW + sch * 16) = kreg; *(LAS u32x4*)(lds + L_VB + (buf ^ 1) * 64 * VROW + skey * VROW + sch * 16) = vreg; }
            jcur = jn; wincur = winn;
            __syncthreads();
        }
        { const float sc_ = g2 * __builtin_amdgcn_rcpf(l);
#pragma unroll
            for (int i = 0; i < 16; ++i) { y[0][i] += sc_ * o[0][i]; y[1][i] += sc_ * o[1][i]; } }
        { bf16_t* yp = NBp + trow * LD_NB + h * 64 + 4 * hi;
#pragma unroll
            for (int dt = 0; dt < 2; ++dt)
#pragma unroll
                for (int gq = 0; gq < 4; ++gq) { u32x2 wv; wv.x = pg8::cvt_pk_bf16(y[dt][4 * gq], y[dt][4 * gq + 1]); wv.y = pg8::cvt_pk_bf16(y[dt][4 * gq + 2], y[dt][4 * gq + 3]); if (!F.dry) *(u32x2*)(yp + 32 * dt + 8 * gq) = wv; } }
        __syncthreads();
    }
}

constexpr size_t WS_ATTG = WS_XA + 14 * MiB;
constexpr size_t WS_DEC = WS_XA + 22 * MiB;
constexpr size_t WS_PSC = WS_XA;
__device__ __forceinline__ void ph_gla1(Ctx& F) {
    const int u_first = F.bid < 64 ? 2 * F.bid : 128 + (F.bid - 64), u_step = F.bid < 64 ? 1 : (F.G - 64), u_end = F.bid < 64 ? 2 * F.bid + 2 : 1024;
    const int L = F.L;
    const bf16_t* NBp = (const bf16_t*)(F.ws + WS_NB); bf16_t* GB = (bf16_t*)(F.ws + WS_GB);
    bf16_t* ATT = (bf16_t*)(F.ws + WS_ATTG); float* DEC = (float*)(F.ws + WS_DEC);
    LAS unsigned char* lds = F.lds;
    constexpr int QROW = 272, L_QT = 0, L_KT = 64 * QROW, L_GS = 2 * 64 * QROW, L_BV = L_GS + 2048, L_BT = L_BV + 64 * 132 * 4;
    const int tid = F.tid, dk = tid & 127, tg = tid >> 7, lane = F.lane, w = F.wave, r32 = lane & 31, hi = lane >> 5;
    for (int unit = u_first; unit < u_end; unit += u_step) {
        const int bh = unit >> 5, chunk = unit & 31, b = bh >> 2, h = bh & 3; const size_t t0 = (size_t)b * NS + chunk * 64;
        float wa[16];
        { const float* wp = F.ap->in[I_WA2] + (size_t)L * 16 * 512 + h * 128 + dk;
#pragma unroll
            for (int r = 0; r < 16; ++r) wa[r] = wp[r * 512]; }
        const float ba = F.ap->in[I_BA][L * 512 + h * 128 + dk];
        float bl[16]; float cs = 0.f;
#pragma unroll
        for (int i = 0; i < 16; ++i) { const bf16_t* lr = NBp + (t0 + tg * 16 + i) * LD_NB + 2608; const u32x4 l0 = *(const u32x4*)lr, l1 = *(const u32x4*)(lr + 8);
            float z = ba; z += bflo(l0.x) * wa[0] + bfhi(l0.x) * wa[1] + bflo(l0.y) * wa[2] + bfhi(l0.y) * wa[3] + bflo(l0.z) * wa[4] + bfhi(l0.z) * wa[5] + bflo(l0.w) * wa[6] + bfhi(l0.w) * wa[7];
            z += bflo(l1.x) * wa[8] + bfhi(l1.x) * wa[9] + bflo(l1.y) * wa[10] + bfhi(l1.y) * wa[11] + bflo(l1.z) * wa[12] + bfhi(l1.z) * wa[13] + bflo(l1.w) * wa[14] + bfhi(l1.w) * wa[15];
            const float ls = (z < 0.f ? z : 0.f) - __logf(1.f + __expf(-fabsf(z))); cs += ls * (1.f / 16.f); bl[i] = cs; }
        ((LAS float*)(lds + L_GS))[tg * 128 + dk] = cs;
        __syncthreads();
        { float off = 0.f, tot = 0.f;
#pragma unroll
            for (int gI = 0; gI < 4; ++gI) { const float v = ((const LAS float*)(lds + L_GS))[gI * 128 + dk]; tot += v; off += gI < tg ? v : 0.f; }
#pragma unroll
            for (int i = 0; i < 16; ++i) ((LAS float*)(lds + L_BV))[(tg * 16 + i) * 132 + dk] = bl[i] + off;
            if (tg == 0) { ((LAS float*)(lds + L_BT))[dk] = tot; DEC[((size_t)bh * 32 + chunk) * 128 + dk] = __expf(tot); } }
        __syncthreads();
        { const int tok = tid >> 3, ch = tid & 7; bf16_t* row = GB + (t0 + tok) * LD_GB + h * 128;
#pragma unroll
            for (int hf = 0; hf < 2; ++hf) { const int d0 = ch * 8 + hf * 64;
                const u32x4 qv = *(const u32x4*)(row + d0), kv = *(const u32x4*)(row + 512 + d0);
                const LAS float* bp = (const LAS float*)(lds + L_BV) + tok * 132 + d0; const LAS float* tp = (const LAS float*)(lds + L_BT) + d0;
                const unsigned qw[4] = {qv.x, qv.y, qv.z, qv.w}, kw[4] = {kv.x, kv.y, kv.z, kv.w}; unsigned oq[4], okt[4], oke[4];
#pragma unroll
                for (int p = 0; p < 4; ++p) { const float b0 = bp[2 * p], b1 = bp[2 * p + 1], t0f = tp[2 * p], t1f = tp[2 * p + 1];
                    const float q0 = bflo(qw[p]) * 0.08838834764831845f, q1 = bfhi(qw[p]) * 0.08838834764831845f, k0 = bflo(kw[p]), k1 = bfhi(kw[p]);
                    oq[p] = pg8::cvt_pk_bf16(q0 * __expf(b0), q1 * __expf(b1)); okt[p] = pg8::cvt_pk_bf16(k0 * __expf(-b0), k1 * __expf(-b1)); oke[p] = pg8::cvt_pk_bf16(k0 * __expf(t0f - b0), k1 * __expf(t1f - b1)); }
                const u32x4 q4 = {oq[0], oq[1], oq[2], oq[3]}, kt4 = {okt[0], okt[1], okt[2], okt[3]}, ke4 = {oke[0], oke[1], oke[2], oke[3]};
                *(LAS u32x4*)(lds + L_QT + tok * QROW + d0 * 2) = q4; *(LAS u32x4*)(lds + L_KT + tok * QROW + d0 * 2) = kt4;
                if (!F.dry) { *(u32x4*)(row + d0) = q4; *(u32x4*)(row + 512 + d0) = ke4; } } }
        __syncthreads();
        if (w < 4) { const int ti = w >> 1, tj = w & 1; f32x16 acc;
#pragma unroll
            for (int i = 0; i < 16; ++i) acc[i] = 0.f;
            if (!(ti == 0 && tj == 1)) {
#pragma unroll
                for (int ds = 0; ds < 8; ++ds) { const bf16x8 a = *(const LAS bf16x8*)(lds + L_QT + (32 * ti + r32) * QROW + ds * 32 + hi * 16), bq = *(const LAS bf16x8*)(lds + L_KT + (32 * tj + r32) * QROW + ds * 32 + hi * 16);
                    acc = MFMA32(a, bq, acc); } }
            bf16_t* ap = ATT + ((size_t)bh * 32 + chunk) * 4096; const int col = 32 * tj + r32;
#pragma unroll
            for (int i = 0; i < 16; ++i) { const int rowi = 32 * ti + (i & 3) + 8 * (i >> 2) + 4 * hi; ap[rowi * 64 + col] = (bf16_t)f2bf(col <= rowi ? acc[i] : 0.f); } }
        __syncthreads();
    }
}
template <int MODE> __device__ __forceinline__ void ph_gla_sc(Ctx& F) {
    const int L = F.L;
    bf16_t* GB = (bf16_t*)(F.ws + WS_GB); const bf16_t* ATT = (const bf16_t*)(F.ws + WS_ATTG); const float* DEC = (const float*)(F.ws + WS_DEC); bf16_t* PSC = (bf16_t*)(F.ws + WS_PSC);
    LAS unsigned char* lds = F.lds;
    constexpr int QROW = 272, KROW = 320, AROW = 144, VROW = 576;
    constexpr int G_QT = 0, G_KE = 64 * QROW, G_AT = G_KE + 64 * KROW, G_V = G_AT + 64 * AROW, G_DEC = G_V + 64 * VROW, G_SS = G_DEC + 512, G_END = G_SS + 2048;
    static_assert(G_END <= 140000, "gla LDS map");
    const int tid = F.tid, lane = F.lane, w = F.wave, r32 = lane & 31, hi = lane >> 5, eb = 32 * w;
    const int trq = (lane & 15) >> 2, trp = lane & 3, trg = (lane >> 4) & 1;
    for (int unit = F.bid; unit < 256; unit += F.G) {
        const int bh = unit >> 3, sc = unit & 7, b = bh >> 2, h = bh & 3;
        if (MODE == 1 && sc == 7) continue;
        f32x16 S[4];
        if (MODE == 3 && sc > 0) { const bf16_t* ps = PSC + ((size_t)bh * 7 + sc - 1) * 32768 + eb + r32;
#pragma unroll
            for (int t = 0; t < 4; ++t)
#pragma unroll
                for (int i = 0; i < 16; ++i) S[t][i] = bf1(ps[(32 * t + (i & 3) + 8 * (i >> 2) + 4 * hi) * 256]); }
        else {
#pragma unroll
            for (int t = 0; t < 4; ++t)
#pragma unroll
                for (int i = 0; i < 16; ++i) S[t][i] = 0.f; }
        const float* gnp = F.ap->in[I_GNORM] + L * 256 + eb + 4 * hi;
        u32x4 pq[2], pk[2], pa, pv[4]; float pd = 0.f;
#define GLA_LOAD(CH) do { int tl_ = tid; asm volatile("" : "+v"(tl_)); const size_t t0_ = (size_t)b * NS + (CH) * 64; \
            { const bf16_t* src = GB + (t0_ + (tl_ >> 4)) * LD_GB + h * 128 + (tl_ & 15) * 8; if (MODE == 3) { pq[0] = *(const u32x4*)src; pq[1] = *(const u32x4*)(src + (size_t)32 * LD_GB); } pk[0] = *(const u32x4*)(src + 512); pk[1] = *(const u32x4*)(src + (size_t)32 * LD_GB + 512); } \
            if (MODE == 3) pa = *(const u32x4*)(ATT + ((size_t)bh * 32 + (CH)) * 4096 + tl_ * 8); \
            { const bf16_t* src = GB + (t0_ + (tl_ >> 5)) * LD_GB + 1024 + h * 256 + (tl_ & 31) * 8; pv[0] = *(const u32x4*)src; pv[1] = *(const u32x4*)(src + (size_t)16 * LD_GB); pv[2] = *(const u32x4*)(src + (size_t)32 * LD_GB); pv[3] = *(const u32x4*)(src + (size_t)48 * LD_GB); } \
            if (tl_ < 128) pd = DEC[((size_t)bh * 32 + (CH)) * 128 + tl_]; } while (0)
#define GLA_STAGE() do { int tl_ = tid; asm volatile("" : "+v"(tl_)); \
            if (MODE == 3) { LAS unsigned char* qd = lds + G_QT + (tl_ >> 4) * QROW + (tl_ & 15) * 16; *(LAS u32x4*)qd = pq[0]; *(LAS u32x4*)(qd + 32 * QROW) = pq[1]; } \
            { LAS unsigned char* kd = lds + G_KE + (tl_ >> 4) * KROW + (tl_ & 15) * 16; *(LAS u32x4*)kd = pk[0]; *(LAS u32x4*)(kd + 32 * KROW) = pk[1]; } \
            if (MODE == 3) *(LAS u32x4*)(lds + G_AT + (tl_ >> 3) * AROW + (tl_ & 7) * 16) = pa; \
            { LAS unsigned char* vd = lds + G_V + (tl_ >> 5) * VROW + (tl_ & 31) * 16; *(LAS u32x4*)vd = pv[0]; *(LAS u32x4*)(vd + 16 * VROW) = pv[1]; *(LAS u32x4*)(vd + 32 * VROW) = pv[2]; *(LAS u32x4*)(vd + 48 * VROW) = pv[3]; } \
            if (tl_ < 128) ((LAS float*)(lds + G_DEC))[tl_] = pd; } while (0)
        GLA_LOAD(4 * sc);
        GLA_STAGE();
#pragma unroll 1
        for (int cc = 0; cc < 4; ++cc) {
            const int chunk = 4 * sc + cc;
            __syncthreads();
            if (cc + 1 < 4) GLA_LOAD(chunk + 1);
            bf16x8 vf[4];
#pragma unroll
            for (int ks = 0; ks < 4; ++ks) vf[ks] = tr_frag(lds + G_V + (16 * ks + 8 * hi + trq) * VROW + (eb + 16 * trg + 4 * trp) * 2, 4 * VROW);
            f32x16 o[2];
            if (MODE == 3) {
#pragma unroll
                for (int i = 0; i < 16; ++i) { o[0][i] = 0.f; o[1][i] = 0.f; }
#pragma unroll
                for (int tt = 0; tt < 2; ++tt)
#pragma unroll
                    for (int ks = 0; ks < 4; ++ks) { if (tt == 0 && ks >= 2) continue; const bf16x8 af = *(const LAS bf16x8*)(lds + G_AT + (32 * tt + r32) * AROW + ks * 32 + hi * 16); o[tt] = MFMA32(vf[ks], af, o[tt]); }
                __builtin_amdgcn_sched_barrier(0);
#pragma unroll
                for (int t = 0; t < 4; ++t)
#pragma unroll
                    for (int s2 = 0; s2 < 2; ++s2) { const bf16x8 sa = pack8(S[t], 8 * s2);
#pragma unroll
                        for (int tt = 0; tt < 2; ++tt) { const LAS unsigned char* qp = lds + G_QT + (32 * tt + r32) * QROW + (32 * t + 16 * s2 + 4 * hi) * 2;
                            const u32x2 qa = *(const LAS u32x2*)qp, qb = *(const LAS u32x2*)(qp + 16); const u32x4 qw = {qa.x, qa.y, qb.x, qb.y};
                            o[tt] = MFMA32(sa, __builtin_bit_cast(bf16x8, qw), o[tt]); }
                        __builtin_amdgcn_sched_barrier(0); }
            }
#pragma unroll
            for (int t = 0; t < 4; ++t) {
#pragma unroll
                for (int i = 0; i < 16; ++i) S[t][i] *= ((const LAS float*)(lds + G_DEC))[32 * t + (i & 3) + 8 * (i >> 2) + 4 * hi];
#pragma unroll
                for (int ks = 0; ks < 4; ++ks) { const bf16x8 kf = tr_frag(lds + G_KE + (16 * ks + 8 * hi + trq) * KROW + (32 * t + 16 * trg + 4 * trp) * 2, 4 * KROW); S[t] = MFMA32(kf, vf[ks], S[t]); }
                __builtin_amdgcn_sched_barrier(0); }
            if (MODE == 3) {
#pragma unroll
                for (int tt = 0; tt < 2; ++tt) { float ss = 0.f;
#pragma unroll
                    for (int i = 0; i < 16; ++i) ss += o[tt][i] * o[tt][i];
                    ss += other_half(ss, hi); if (hi == 0) ((LAS float*)(lds + G_SS))[w * 64 + 32 * tt + r32] = ss; } }
            __syncthreads();
            if (cc + 1 < 4) GLA_STAGE();
            if (MODE == 3) {
                const size_t t0 = (size_t)b * NS + chunk * 64;
#pragma unroll
                for (int tt = 0; tt < 2; ++tt) { float tot = 0.f;
#pragma unroll
                    for (int ww = 0; ww < 8; ++ww) tot += ((const LAS float*)(lds + G_SS))[ww * 64 + 32 * tt + r32];
                    const float rstd = __builtin_amdgcn_rsqf(tot * (1.f / 256.f) + EPS);
                    bf16_t* op = GB + (t0 + 32 * tt + r32) * LD_GB + 2048 + h * 256 + eb + 4 * hi;
#pragma unroll
                    for (int gq = 0; gq < 4; ++gq) { const u32x2 ow = *(const u32x2*)(op + 8 * gq); const float og[4] = {bflo(ow.x), bfhi(ow.x), bflo(ow.y), bfhi(ow.y)}; float r[4];
#pragma unroll
                        for (int k = 0; k < 4; ++k) r[k] = o[tt][4 * gq + k] * rstd * gnp[8 * gq + k] * (og[k] * sigmoidf_(og[k]));
                        u32x2 wv; wv.x = pg8::cvt_pk_bf16(r[0], r[1]); wv.y = pg8::cvt_pk_bf16(r[2], r[3]); if (!F.dry) *(u32x2*)(op + 8 * gq) = wv; } } }
        }
        if (MODE == 1) { bf16_t* ps = PSC + ((size_t)bh * 7 + sc) * 32768 + eb + r32;
#pragma unroll
            for (int t = 0; t < 4; ++t)
#pragma unroll
                for (int i = 0; i < 16; ++i) ps[(32 * t + (i & 3) + 8 * (i >> 2) + 4 * hi) * 256] = (bf16_t)f2bf(S[t][i]); }
        __syncthreads();
#undef GLA_LOAD
#undef GLA_STAGE
    }
}
__device__ __forceinline__ void ph_gla_scan(Ctx& F) {
    bf16_t* PSC = (bf16_t*)(F.ws + WS_PSC); const float* DEC = (const float*)(F.ws + WS_DEC);
    for (int it = F.bid * NTHR + F.tid; it < 32 * 32768; it += F.G * NTHR) { const int bh = it >> 15, idx = it & 32767, dk = idx >> 8; float s = 0.f;
#pragma unroll
        for (int sc = 0; sc < 7; ++sc) { const float* d = DEC + ((size_t)bh * 32 + 4 * sc) * 128 + dk; const float D = d[0] * d[128] * d[256] * d[384];
            bf16_t* pp = PSC + ((size_t)bh * 7 + sc) * 32768 + idx; s = D * s + bf1(*pp); if (!F.dry) *pp = (bf16_t)f2bf(s); } }
}

template <bool WITH_H> __device__ __forceinline__ void ph_res(Ctx& F, const float* xsrc, const float* gz, const float* gh) {
    const bf16_t* Z = (const bf16_t*)(F.ws + WS_XA); bf16_t* H = (bf16_t*)(F.ws + WS_H); float* out = F.out;
    const int gw = F.bid * NWAVES + F.wave, NGW = F.G * NWAVES;
    for (int m = gw; m < NT; m += NGW) {
        const u32x2* zr = (const u32x2*)(Z + (size_t)m * ND) + F.lane; const f32x4* xr = (const f32x4*)(xsrc + (size_t)m * ND) + F.lane;
        f32x4 z[4], x[4]; float s = 0.f;
#pragma unroll
        for (int j = 0; j < 4; ++j) { const u32x2 zw = zr[64 * j]; z[j] = (f32x4){bflo(zw.x), bfhi(zw.x), bflo(zw.y), bfhi(zw.y)}; x[j] = xr[64 * j]; s += (z[j].x * z[j].x + z[j].y * z[j].y) + (z[j].z * z[j].z + z[j].w * z[j].w); }
        const float rstd = __builtin_amdgcn_rsqf(wave_sum(s) * (1.f / ND) + EPS); float s2 = 0.f;
#pragma unroll
        for (int j = 0; j < 4; ++j) { const f32x4 gg = ((const f32x4*)gz + F.lane)[64 * j]; x[j] = x[j] + z[j] * rstd * gg; if (!F.dry) ((f32x4*)(out + (size_t)m * ND) + F.lane)[64 * j] = x[j];
            s2 += (x[j].x * x[j].x + x[j].y * x[j].y) + (x[j].z * x[j].z + x[j].w * x[j].w); }
        if (WITH_H) { const float r2 = __builtin_amdgcn_rsqf(wave_sum(s2) * (1.f / ND) + EPS); unsigned long long* o8 = (unsigned long long*)(H + (size_t)m * ND) + F.lane;
#pragma unroll
            for (int j = 0; j < 4; ++j) { const f32x4 gg = ((const f32x4*)gh + F.lane)[64 * j];
                o8[64 * j] = (unsigned long long)pk2(x[j].x * r2 * gg.x, x[j].y * r2 * gg.y) | ((unsigned long long)pk2(x[j].z * r2 * gg.z, x[j].w * r2 * gg.w) << 32); } }
    }
}

#define XB_TMO      128
#define XB_XCNT(j)  (256  + 64 * (j))
#define XB_XSUB(j)  (1280 + 64 * (j))
#define XB_XGEN(j)  (2304 + 64 * (j))
#define XB_TOP      3328
#define XB_TOPGEN   3392
#define XCD_BAR_WORDS 3456
#define XB_SPIN_CAP (1u << 18)
constexpr size_t WS_BAR = 256 * 1024;
__device__ __forceinline__ unsigned xb_ld(unsigned* p)              { return __hip_atomic_load(p, __ATOMIC_RELAXED, __HIP_MEMORY_SCOPE_AGENT); }
__device__ __forceinline__ unsigned xb_add(unsigned* p, unsigned v) { return __hip_atomic_fetch_add(p, v, __ATOMIC_RELAXED, __HIP_MEMORY_SCOPE_AGENT); }
__device__ __forceinline__ unsigned xb_xcc_id() { return (unsigned)__builtin_amdgcn_s_getreg((3 << 11) | 20) & 0xFu; }
#define XB_SPIN(cond, bar) do { unsigned _sp = 0; while (cond) { __builtin_amdgcn_s_sleep(1); \
    if ((++_sp & 255u) == 0u) { if (xb_ld(&(bar)[XB_TMO])) break; if (_sp > XB_SPIN_CAP) { atomicAdd(&(bar)[XB_TMO], 1u); break; } } } } while (0)
struct XcdBarrier { unsigned* bar; unsigned x; volatile LAS unsigned* st; };
__device__ __forceinline__ XcdBarrier xcd_barrier_post(unsigned* bar, volatile LAS unsigned* st) {
    XcdBarrier b; b.bar = bar; b.x = xb_xcc_id(); b.st = st;
    if (threadIdx.x == 0) (void)xb_add(&bar[XB_XCNT(b.x)], 1u);
    return b;
}
__device__ __forceinline__ void xcd_barrier_complete(unsigned* bar, unsigned x, unsigned& nloc, unsigned& nx) {
    const unsigned G = gridDim.x * gridDim.y * gridDim.z;
    unsigned sum, cnt, mine, sp = 0u;
    for (;;) {
        sum = 0u; cnt = 0u; mine = 0u;
#pragma unroll
        for (unsigned j = 0; j < 16; ++j) { const unsigned c = xb_ld(&bar[XB_XCNT(j)]); sum += c; cnt += (c > 0u) ? 1u : 0u; mine = (j == x) ? c : mine; }
        if (sum == G) break;
        __builtin_amdgcn_s_sleep(1);
        if ((++sp & 255u) == 0u) { if (xb_ld(&bar[XB_TMO])) break; if (sp > XB_SPIN_CAP) { atomicAdd(&bar[XB_TMO], 1u); break; } }
    }
    nloc = mine > 0u ? mine : 1u; nx = cnt > 0u ? cnt : 1u;
}
__device__ __forceinline__ void xcd_barrier(const XcdBarrier& b) {
    asm volatile("s_waitcnt vmcnt(0)" ::: "memory");
    __syncthreads();
    if (threadIdx.x == 0) {
        unsigned* bar = b.bar;
        __builtin_amdgcn_s_waitcnt(0);
        unsigned nloc = b.st[0], nx = b.st[1];
        if (nloc == 0u) { xcd_barrier_complete(bar, b.x, nloc, nx); b.st[0] = nloc; b.st[1] = nx; }
        const unsigned old = xb_add(&bar[XB_XSUB(b.x)], 1u);
        const unsigned gen = old / nloc;
        if (old + 1u == (gen + 1u) * nloc) {
            __builtin_amdgcn_fence(__ATOMIC_RELEASE, "agent");
            asm volatile("s_waitcnt vmcnt(0)" ::: "memory");
            const unsigned og = xb_add(&bar[XB_TOP], 1u);
            const unsigned tg = og / nx;
            if (og + 1u == (tg + 1u) * nx) xb_add(&bar[XB_TOPGEN], 1u);
            else XB_SPIN(xb_ld(&bar[XB_TOPGEN]) == tg, bar);
            __builtin_amdgcn_fence(__ATOMIC_ACQUIRE, "agent");
            xb_add(&bar[XB_XGEN(b.x)], 1u);
            asm volatile("s_waitcnt vmcnt(0)" ::: "memory");
        } else {
            XB_SPIN(xb_ld(&bar[XB_XGEN(b.x)]) == gen, bar);
            __builtin_amdgcn_fence(__ATOMIC_ACQUIRE, "agent");
            asm volatile("s_waitcnt vmcnt(0)" ::: "memory");
        }
    }
    __syncthreads();
}

template <int p> __device__ __forceinline__ void run_phase(Ctx& F, const int L) {
    using namespace pg8;
    unsigned char* ws = F.ws;
        F.L = L; F.xin = (L == 0) ? F.ap->in[I_X] : F.out;
        const float* ng = F.ap->in[I_NORMG] + (size_t)L * 4 * ND;
        StaticOrder S;
        switch (p) {
        case PH_PRE: if constexpr (PH_ON(PH_PRE)) { ph_pre(F); } break;
        case PH_G1: if constexpr (PH_ON(PH_G1)) { { Gemm g{(const bf16_t*)(ws + WS_H), (const bf16_t*)(ws + W_G1), 1024, 1024, 1024, 128}; S.init(64, 8, F.G, F.bid);
            EpiStore<0> E{{(bf16_t*)(ws + WS_XA), 1024, 0}, {(bf16_t*)(ws + WS_GA), 1024, 4}, {nullptr, 0, 0}, 4, 1 << 30, 0, 1.f, 0};
            gemm_phase<EpiStore<0>, true, StaticOrder>(F.lds, g, S, E, F.tid); } } break;
        case PH_LCONV: if constexpr (PH_ON(PH_LCONV)) { ph_lconv(F); } break;
        case PH_LGATE: if constexpr (PH_ON(PH_LGATE)) { { int k256 = 256; asm volatile("" : "+s"(k256));
            Gemm g{(const bf16_t*)(ws + WS_XC), (const bf16_t*)(ws + W_LRU), 1024, k256, k256, 128}; LruOrder LS; LS.init(64, 8, F.G, F.bid);
            EpiLru E{(const bf16_t*)(ws + WS_XC), (bf16_t*)(ws + WS_LA), (bf16_t*)(ws + WS_U), F.ap->in[I_LRUB] + (size_t)L * 2048, (const float*)(ws + WS_CTL) + CT_C8};
            gemm_phase<EpiLru, true, LruOrder>(F.lds, g, LS, E, F.tid); } } break;
        case PH_LSCAN: if constexpr (PH_ON(PH_LSCAN)) { ph_lscan(F); } break;
        case PH_G23: if constexpr (PH_ON(PH_G23)) { { Gemm g{(const bf16_t*)(ws + WS_H), (const bf16_t*)(ws + W_G23), 1024, 1024, 1024, 128}; S.init(64, 23, F.G, F.bid);
            EpiStore<0> E{{(bf16_t*)(ws + WS_NB), LD_NB, 0}, {(bf16_t*)(ws + WS_GB), LD_GB, 11}, {nullptr, 0, 0}, 11, 1 << 30, 4, 0.125f, 0};
            gemm_phase<EpiStore<0>, true, StaticOrder>(F.lds, g, S, E, F.tid); } } break;
        case PH_M1: if constexpr (PH_ON(PH_M1)) { {
            Gemm g{(const bf16_t*)(ws + WS_NB) + 1024, (const bf16_t*)(ws + W_C1), 16 * LD_NB, 1024, 1024, LD_NB * 2}; CmpOrder CS{F.G, F.bid, 0};
            EpiStore<0> E{{(bf16_t*)(ws + WS_HID), 512, 0}, {nullptr, 0, 0}, {nullptr, 0, 0}, 1 << 30, 1 << 30, 0, 1.f, (size_t)1024 * 512};
            gemm_phase<EpiStore<0>, false, CmpOrder>(F.lds, g, CS, E, F.tid); }
            if (F.bid == F.G - 1) { float* ctl = (float*)(ws + WS_CTL); float a = 0.f;
#pragma unroll 8
                for (int j = 0; j < 64; ++j) a += ctl[CT_C1P + j * 512 + F.tid];
                ctl[CT_C1 + F.tid] = a; }
            ph_gla1(F); } break;
        case PH_M2: if constexpr (PH_ON(PH_M2)) { ph_cmp2g(F); ph_gla_sc<1>(F); } break;
        case PH_M3: if constexpr (PH_ON(PH_M3)) { ph_gla_scan(F); ph_att_mfma(F); } break;
        case PH_GLA: if constexpr (PH_ON(PH_GLA)) { ph_gla_sc<3>(F); } break;
        case PH_G4: if constexpr (PH_ON(PH_G4)) { { Gemm g{(const bf16_t*)(ws + WS_H), (const bf16_t*)(ws + W_G4), 1024, 1024, 1024, 128}; S.init(64, 12, F.G, F.bid);
            EpiStore<2> E{{(bf16_t*)(ws + WS_XA), 1024, 0}, {(bf16_t*)(ws + WS_NB) + 1024, LD_NB, 4}, {(bf16_t*)(ws + WS_GB), LD_GB, 8}, 4, 8, 0, 1.f, 0};
            gemm_phase<EpiStore<2>, true, StaticOrder>(F.lds, g, S, E, F.tid); } } break;
        case PH_BR: if constexpr (PH_ON(PH_BR)) { { bf16_t* MO = (bf16_t*)(ws + WS_GB) + 1024;
            BrOrder BS; BS.so.init(64, 4, F.G, F.bid); BS.a1 = (size_t)(WS_NB - WS_GA); BS.a2 = (size_t)(WS_GB + 2048 * 2 - WS_GA);
            Gemm g{(const bf16_t*)(ws + WS_GA), (const bf16_t*)(ws + W_BR), 1024, 1024, 1024, 128};
            EpiBranch E{(const bf16_t*)(ws + WS_XA), (const bf16_t*)(ws + WS_NB) + 1024, (const bf16_t*)(ws + WS_GB), 1024, LD_NB, LD_GB, MO, LD_GB};
            gemm_phase<EpiBranch, true, BrOrder>(F.lds, g, BS, E, F.tid); } } break;
        case PH_OUT: if constexpr (PH_ON(PH_OUT)) { { Gemm g{(const bf16_t*)(ws + WS_GB) + 1024, (const bf16_t*)(ws + W_OUT), LD_GB, 1024, 1024, 128}; S.init(64, 4, F.G, F.bid);
            EpiStore<0> E{{(bf16_t*)(ws + WS_XA), 1024, 0}, {nullptr, 0, 0}, {nullptr, 0, 0}, 1 << 30, 1 << 30, 0, 1.f, 0}; gemm_phase<EpiStore<0>, false, StaticOrder>(F.lds, g, S, E, F.tid); } } break;
        case PH_RES1: if constexpr (PH_ON(PH_RES1)) { ph_res<true>(F, F.xin, ng + 1 * ND, ng + 2 * ND); } break;
        case PH_FI: if constexpr (PH_ON(PH_FI)) { { Gemm g{(const bf16_t*)(ws + WS_H), (const bf16_t*)(ws + W_FI), 1024, 1024, 1024, 128}; S.init(64, 22, F.G, F.bid);
            EpiSwiGLU E{(bf16_t*)(ws + WS_NB), DFF}; gemm_phase<EpiSwiGLU, true, StaticOrder>(F.lds, g, S, E, F.tid); } } break;
        case PH_FO: if constexpr (PH_ON(PH_FO)) { { Gemm g{(const bf16_t*)(ws + WS_NB), (const bf16_t*)(ws + W_FO), DFF, DFF, DFF, 128}; S.init(64, 4, F.G, F.bid);
            EpiStore<0> E{{(bf16_t*)(ws + WS_XA), 1024, 0}, {nullptr, 0, 0}, {nullptr, 0, 0}, 1 << 30, 1 << 30, 0, 1.f, 0}; gemm_phase<EpiStore<0>, false, StaticOrder>(F.lds, g, S, E, F.tid); } } break;
        case PH_RES2: if constexpr (PH_ON(PH_RES2)) { if (L == 0) ph_res<true>(F, F.out, ng + 3 * ND, ng + 4 * ND); else ph_res<false>(F, F.out, ng + 3 * ND, nullptr); } break;
        }
}
constexpr int LDS_BYTES = 147456;
template <bool COOP> __global__ void __launch_bounds__(NTHR, 2) mk_fwd(Args args) {
    extern __shared__ __attribute__((aligned(16))) unsigned char lds_raw[];
    Ctx F; F.lds = (LAS unsigned char*)lds_raw; F.ldsg = lds_raw;
    F.tid = threadIdx.x; F.lane = F.tid & 63; F.wave = __builtin_amdgcn_readfirstlane(F.tid >> 6); F.G = gridDim.x; F.bid = blockIdx.x;
    const int lo = args.ph_lo, hi = args.ph_hi;
    volatile LAS unsigned* xst = (volatile LAS unsigned*)(F.lds + LDS_BYTES - 64);
    if (threadIdx.x < 16) xst[threadIdx.x] = 0u;
    __syncthreads();
    XcdBarrier xbar; xbar.bar = nullptr; xbar.x = 0; xbar.st = xst;
    if (COOP) xbar = xcd_barrier_post((unsigned*)(args.ws + WS_CTL + WS_BAR), xst);
#define MK_SEAM(IDX_) do { if (lo < 0) cg::this_grid().sync(); xcd_barrier(xbar); } while (0)
#define MK_PHASE(L_, P_) if (lo <= (L_) * NPH + (P_) && (L_) * NPH + (P_) < hi) { \
        { int bid_ = blockIdx.x; asm volatile("" : "+s"(bid_)); F.bid = bid_; \
          int tid_ = threadIdx.x; asm volatile("" : "+v"(tid_)); F.tid = tid_; F.lane = tid_ & 63; F.wave = __builtin_amdgcn_readfirstlane(tid_ >> 6); \
          unsigned long long apl_ = (unsigned long long)__builtin_amdgcn_kernarg_segment_ptr(); asm volatile("" : "+s"(apl_)); F.ap = (ArgsP)apl_; \
          F.ws = F.ap->ws; F.out = F.ap->out; F.G = gridDim.x; } \
        if constexpr (COOP && (((MK_DRY) >> (P_)) & 1u)) { F.dry = true; run_phase<P_>(F, L_); xcd_barrier(xbar); } \
        F.dry = false; run_phase<P_>(F, L_); \
        if constexpr (COOP && (((MK_DUP) >> (P_)) & 1u)) { xcd_barrier(xbar); run_phase<P_>(F, L_); } \
        if constexpr (COOP && MK_XSYNC > 0) { for (int x_ = 0; x_ < MK_XSYNC; ++x_) xcd_barrier(xbar); } \
        if (COOP) { if ((L_) * NPH + (P_) + 1 < hi) MK_SEAM((L_) * NPH + (P_)); } }
#define MK_LAYER(L_) MK_PHASE(L_, 0) MK_PHASE(L_, 1) MK_PHASE(L_, 2) MK_PHASE(L_, 3) MK_PHASE(L_, 4) MK_PHASE(L_, 5) MK_PHASE(L_, 6) MK_PHASE(L_, 7) MK_PHASE(L_, 8) \
        MK_PHASE(L_, 9) MK_PHASE(L_, 10) MK_PHASE(L_, 11) MK_PHASE(L_, 12) MK_PHASE(L_, 13) MK_PHASE(L_, 14) MK_PHASE(L_, 15) MK_PHASE(L_, 16)
    MK_LAYER(0)
    MK_LAYER(1)
}

extern "C" void kernel_launch(void* const* d_in, const int* in_sizes, int n_in, void* d_out, int out_size, void* d_ws, size_t ws_size, hipStream_t stream) {
    static int grid = 0;
    if (grid == 0) {
        if (n_in != 19 || out_size != NT * ND || ws_size < WS_END) { fprintf(stderr, "kernel_launch: unexpected shapes/workspace (n_in %d out %d ws %zu need %zu)\n", n_in, out_size, ws_size, (size_t)WS_END); grid = -1; return; }
        int dev = 0, cus = 0, per_cu = 0;
        hipGetDevice(&dev); hipDeviceGetAttribute(&cus, hipDeviceAttributeMultiprocessorCount, dev);
        hipFuncSetAttribute((const void*)mk_fwd<true>, hipFuncAttributeMaxDynamicSharedMemorySize, LDS_BYTES);
        hipFuncSetAttribute((const void*)mk_fwd<false>, hipFuncAttributeMaxDynamicSharedMemorySize, LDS_BYTES);
        hipOccupancyMaxActiveBlocksPerMultiprocessor(&per_cu, (const void*)mk_fwd<true>, NTHR, LDS_BYTES);
        if (per_cu < 1) { fprintf(stderr, "kernel_launch: occupancy query says %d blocks/CU\n", per_cu); per_cu = 1; }
        (void)hipGetLastError();
        grid = cus;
    }
    if (grid < 0) return;
    Args a{};
    for (int i = 0; i < 19; ++i) a.in[i] = (const float*)d_in[i];
    a.out = (float*)d_out; a.ws = (unsigned char*)d_ws;
#if MK_COOP
    a.ph_lo = 0; a.ph_hi = 2 * NPH;
    if (hipMemsetAsync((char*)d_ws + WS_CTL + WS_BAR, 0, 16384, stream) != hipSuccess) { fprintf(stderr, "kernel_launch: memset of barrier words failed\n"); return; }
    void* kargs[] = {&a};
    hipError_t e = hipLaunchCooperativeKernel((const void*)mk_fwd<true>, dim3(grid), dim3(NTHR), kargs, LDS_BYTES, stream);
    if (e != hipSuccess) fprintf(stderr, "cooperative launch failed: %s (grid %d)\n", hipGetErrorString(e), grid);
#else
    for (int ph = 0; ph < 2 * NPH; ++ph) {
        a.ph_lo = ph; a.ph_hi = ph + 1;
        hipLaunchKernelGGL(mk_fwd<false>, dim3(grid), dim3(NTHR), LDS_BYTES, stream, a);
    }
#endif
}
```
